# Optimizing an MI355X kernel written in HIP

```python
import numpy as np
import jax
import jax.numpy as jnp
from jax import lax


D_MODEL = 2048
BATCH = 4
SEQ = 2048
DEPTH = 1

GLA_HEADS = 4
GLA_DK = D_MODEL // 2
GLA_DV = D_MODEL
GLA_HK = GLA_DK // GLA_HEADS
GLA_HV = GLA_DV // GLA_HEADS
GLA_GATE_RANK = 16
GLA_TAU = 16.0
GLA_CHUNK = 64

NSA_HEADS = 16
NSA_KV_HEADS = 4
NSA_GROUP = NSA_HEADS // NSA_KV_HEADS
NSA_HD = D_MODEL // NSA_HEADS
CMP_STRIDE = 16
CMP_LEN = 2 * CMP_STRIDE
CMP_HIDDEN = 256
SLC_BLOCK = 64
SLC_TOPN = 16
WINDOW = 512
NSA_Q_BLOCK = 32

D_FF = ((8 * D_MODEL // 3 + 255) // 256) * 256

IN_SPLIT_SIZES = (GLA_DK, GLA_DK, GLA_DV, GLA_DV, GLA_GATE_RANK,
                  NSA_HEADS * NSA_HD, 6 * NSA_KV_HEADS * NSA_HD, 3 * NSA_HEADS,
                  2 * D_MODEL)
IN_WIDTH = sum(IN_SPLIT_SIZES)

NEG_INF = -1e30
RMS_EPS = 1e-6

kernel_name = 'hybrid_gla_nsa_block'


def rms_norm(x, g):
    xf = x.astype(jnp.float32)
    y = xf * lax.rsqrt(jnp.mean(xf * xf, axis=-1, keepdims=True) + RMS_EPS)
    return (y * g.astype(jnp.float32)).astype(x.dtype)


def masked_softmax(s, valid):
    s = jnp.where(valid, s.astype(jnp.float32), NEG_INF)
    return jnp.where(valid, jax.nn.softmax(s, axis=-1), 0.0)


def gla_mixer(q, k, v, r, gate_lr, w_gate, b_gate, norm_g):
    B, S, _ = q.shape
    C = GLA_CHUNK
    n = S // C
    H = GLA_HEADS
    f32 = jnp.float32
    log_a = jax.nn.log_sigmoid((gate_lr @ w_gate + b_gate).astype(f32)) / GLA_TAU

    def heads(t, d):
        return t.astype(f32).reshape(B, n, C, H, d).transpose(0, 3, 1, 2, 4)

    qh = heads(q, GLA_HK) * (GLA_HK ** -0.5)
    kh = heads(k, GLA_HK)
    vh = heads(v, GLA_HV)
    b = jnp.cumsum(heads(log_a, GLA_HK), axis=3)
    b_last = b[:, :, :, -1:]
    q_dec = qh * jnp.exp(b)
    k_dec = kh * jnp.exp(-b)
    k_end = kh * jnp.exp(b_last - b)
    causal = jnp.tril(jnp.ones((C, C), dtype=bool))
    attn = jnp.where(causal, jnp.einsum('bhncd,bhnsd->bhncs', q_dec, k_dec), 0.0)
    o_intra = jnp.einsum('bhncs,bhnse->bhnce', attn, vh)

    def step(state, inp):
        q_c, k_c, v_c, decay = inp
        o = jnp.einsum('bhcd,bhde->bhce', q_c, state)
        state = decay[..., None] * state + jnp.einsum('bhcd,bhce->bhde', k_c, v_c)
        return state, o

    xs = (jnp.moveaxis(q_dec, 2, 0), jnp.moveaxis(k_end, 2, 0), jnp.moveaxis(vh, 2, 0),
          jnp.moveaxis(jnp.exp(b_last[:, :, :, 0]), 2, 0))
    state0 = jnp.zeros((B, H, GLA_HK, GLA_HV), f32)
    _, o_inter = lax.scan(step, state0, xs)
    o = o_intra + jnp.moveaxis(o_inter, 0, 2)
    o = o.transpose(0, 2, 3, 1, 4).reshape(B, S, H, GLA_HV)
    o = rms_norm(o, norm_g) * jax.nn.silu(r.astype(f32).reshape(B, S, H, GLA_HV))
    return o.reshape(B, S, GLA_DV).astype(q.dtype)


def compress_blocks(t, pe, w1, w2):
    b, hk, s, hd = t.shape
    chunks = t.reshape(b, hk, s // CMP_STRIDE, CMP_STRIDE, hd)
    blocks = jnp.concatenate([chunks[:, :, :-1], chunks[:, :, 1:]], axis=3) + pe
    flat = blocks.reshape(b, hk, blocks.shape[2], CMP_LEN * hd)
    return jax.nn.silu(flat @ w1) @ w2


def cmp_to_slc_weights(n_cmp, n_slc):
    c0 = np.arange(n_cmp)[:, None] * CMP_STRIDE
    s0 = np.arange(n_slc)[None, :] * SLC_BLOCK
    ov = np.clip(np.minimum(c0 + CMP_LEN, s0 + SLC_BLOCK) - np.maximum(c0, s0), 0, None)
    return jnp.asarray(ov / CMP_LEN, dtype=jnp.float32)


def nsa_mixer(q, kv, gate_logits, pe_k, w_ck1, w_ck2, pe_v, w_cv1, w_cv2):
    B, S, _ = q.shape
    Hk, G, hd, Q = NSA_KV_HEADS, NSA_GROUP, NSA_HD, NSA_Q_BLOCK
    qh = q.reshape(B, S, Hk, G, hd).transpose(0, 2, 3, 1, 4) * (hd ** -0.5)
    kvh = kv.reshape(B, S, 6, Hk, hd).transpose(2, 0, 3, 1, 4)
    k_c_raw, v_c_raw, k_s, v_s, k_w, v_w = (kvh[i] for i in range(6))
    k_cmp = compress_blocks(k_c_raw, pe_k, w_ck1, w_ck2)
    v_cmp = compress_blocks(v_c_raw, pe_v, w_cv1, w_cv2)
    n_cmp = k_cmp.shape[2]
    n_slc = S // SLC_BLOCK
    top_n = min(SLC_TOPN, n_slc)
    m_cs = cmp_to_slc_weights(n_cmp, n_slc)
    cmp_end = jnp.arange(n_cmp) * CMP_STRIDE + CMP_LEN - 1
    blk = jnp.arange(n_slc)
    k_sb = k_s.reshape(B, Hk, n_slc, SLC_BLOCK, hd)
    v_sb = v_s.reshape(B, Hk, n_slc, SLC_BLOCK, hd)
    pad = ((0, 0), (0, 0), (WINDOW, 0), (0, 0))
    k_wp = jnp.pad(k_w, pad)
    v_wp = jnp.pad(v_w, pad)
    gates = jax.nn.sigmoid(gate_logits.astype(jnp.float32)).reshape(B, S, 3, Hk, G).transpose(2, 0, 3, 4, 1)
    gather = jax.vmap(jax.vmap(lambda blocks, idx: blocks[idx]))

    def block(i):
        start = i * Q
        t = start + jnp.arange(Q)
        qb = lax.dynamic_slice_in_dim(qh, start, Q, axis=3)
        s_c = jnp.einsum('bhgqd,bhcd->bhgqc', qb, k_cmp)
        p_c = masked_softmax(s_c, cmp_end[None, :] <= t[:, None])
        o_c = jnp.einsum('bhgqc,bhcd->bhgqd', p_c, v_cmp)
        imp = jnp.einsum('bhgqc,cn->bhqn', p_c, m_cs)
        cur = t[:, None] // SLC_BLOCK
        forced = (blk[None, :] == 0) | (blk[None, :] == cur) | (blk[None, :] == cur - 1)
        imp = jnp.where(forced, jnp.inf, imp)
        imp = jnp.where(blk[None, :] * SLC_BLOCK <= t[:, None], imp, -jnp.inf)
        _, idx = lax.top_k(imp, top_n)
        k_sel = gather(k_sb, idx)
        v_sel = gather(v_sb, idx)
        pos = idx[..., None] * SLC_BLOCK + jnp.arange(SLC_BLOCK)
        valid_sel = (pos <= t[:, None, None])[:, :, None].reshape(B, Hk, 1, Q, top_n * SLC_BLOCK)
        s_s = jnp.einsum('bhgqd,bhqnkd->bhgqnk', qb, k_sel).reshape(B, Hk, G, Q, top_n * SLC_BLOCK)
        p_s = masked_softmax(s_s, valid_sel)
        o_s = jnp.einsum('bhgqm,bhqmd->bhgqd', p_s, v_sel.reshape(B, Hk, Q, top_n * SLC_BLOCK, hd))
        k_win = lax.dynamic_slice_in_dim(k_wp, start, Q + WINDOW, axis=2)
        v_win = lax.dynamic_slice_in_dim(v_wp, start, Q + WINDOW, axis=2)
        kpos = start - WINDOW + jnp.arange(Q + WINDOW)
        valid_w = (kpos[None, :] <= t[:, None]) & (kpos[None, :] > t[:, None] - WINDOW) & (kpos[None, :] >= 0)
        s_w = jnp.einsum('bhgqd,bhkd->bhgqk', qb, k_win)
        p_w = masked_softmax(s_w, valid_w)
        o_w = jnp.einsum('bhgqk,bhkd->bhgqd', p_w, v_win)
        gb = lax.dynamic_slice_in_dim(gates, start, Q, axis=4)[..., None]
        return gb[0] * o_c + gb[1] * o_s + gb[2] * o_w

    out = lax.map(block, jnp.arange(S // Q))
    out = out.transpose(1, 0, 4, 2, 3, 5).reshape(B, S, NSA_HEADS * hd)
    return out.astype(q.dtype)


def setup_inputs(seed: int = 0) -> dict:
    key = jax.random.key(seed)
    ks = jax.random.split(key, 24)
    L = DEPTH
    f32 = jnp.float32

    def nrm(k, shape, fan_in):
        return jax.random.normal(k, shape, f32) * (fan_in ** -0.5)

    def gain(k, shape):
        return 1.0 + 0.02 * jax.random.normal(k, shape, f32)

    cin = CMP_LEN * NSA_HD
    return {
        'x': jax.random.normal(ks[0], (BATCH, SEQ, D_MODEL), f32),
        'g_mix': gain(ks[1], (L, D_MODEL)),
        'w_in': nrm(ks[2], (L, D_MODEL, IN_WIDTH), D_MODEL),
        'w_gla_gate': nrm(ks[3], (L, GLA_GATE_RANK, GLA_DK), GLA_GATE_RANK),
        'b_gla_gate': 0.1 * jax.random.normal(ks[4], (L, GLA_DK), f32),
        'g_gla_out': gain(ks[5], (L, GLA_HV)),
        'pe_cmp_k': 0.1 * jax.random.normal(ks[6], (L, CMP_LEN, NSA_HD), f32),
        'w_cmp_k1': nrm(ks[7], (L, cin, CMP_HIDDEN), cin),
        'w_cmp_k2': nrm(ks[8], (L, CMP_HIDDEN, NSA_HD), CMP_HIDDEN),
        'pe_cmp_v': 0.1 * jax.random.normal(ks[9], (L, CMP_LEN, NSA_HD), f32),
        'w_cmp_v1': nrm(ks[10], (L, cin, CMP_HIDDEN), cin),
        'w_cmp_v2': nrm(ks[11], (L, CMP_HIDDEN, NSA_HD), CMP_HIDDEN),
        'w_proj_gla': nrm(ks[12], (L, GLA_DV, D_MODEL), GLA_DV),
        'w_proj_nsa': nrm(ks[13], (L, NSA_HEADS * NSA_HD, D_MODEL), NSA_HEADS * NSA_HD),
        'w_out': nrm(ks[14], (L, D_MODEL, D_MODEL), D_MODEL),
        'g_ffn': gain(ks[15], (L, D_MODEL)),
        'w_ffn_gate': nrm(ks[16], (L, D_MODEL, D_FF), D_MODEL),
        'w_ffn_up': nrm(ks[17], (L, D_MODEL, D_FF), D_MODEL),
        'w_ffn_down': nrm(ks[18], (L, D_FF, D_MODEL), D_FF),
        'g_final': gain(ks[19], (D_MODEL,)),
    }


def reference(x, g_mix, w_in, w_gla_gate, b_gla_gate, g_gla_out, pe_cmp_k, w_cmp_k1, w_cmp_k2,
              pe_cmp_v, w_cmp_v1, w_cmp_v2, w_proj_gla, w_proj_nsa, w_out, g_ffn,
              w_ffn_gate, w_ffn_up, w_ffn_down, g_final):
    split_points = [int(v) for v in np.cumsum(IN_SPLIT_SIZES)[:-1]]
    for l in range(DEPTH):
        h = rms_norm(x, g_mix[l])
        z = h @ w_in[l]
        gq, gk, gv, gr, glr, nq, nkv, ngate, mgate = jnp.split(z, split_points, axis=-1)
        o_gla = gla_mixer(gq, gk, gv, gr, glr, w_gla_gate[l], b_gla_gate[l], g_gla_out[l])
        o_nsa = nsa_mixer(nq, nkv, ngate, pe_cmp_k[l], w_cmp_k1[l], w_cmp_k2[l],
                          pe_cmp_v[l], w_cmp_v1[l], w_cmp_v2[l])
        gate_a, gate_b = jnp.split(jax.nn.sigmoid(mgate), 2, axis=-1)
        merged = gate_a * (o_gla @ w_proj_gla[l]) + gate_b * (o_nsa @ w_proj_nsa[l])
        x = x + merged @ w_out[l]
        h = rms_norm(x, g_ffn[l])
        x = x + (jax.nn.silu(h @ w_ffn_gate[l]) * (h @ w_ffn_up[l])) @ w_ffn_down[l]
    return rms_norm(x, g_final)
```

```cpp
#include <hip/hip_runtime.h>
#include <hip/hip_cooperative_groups.h>
#include <cstdio>
#include <cstdint>
namespace cg = cooperative_groups;
#define MK_N_LAUNCHES 1
namespace pg8 {
#define PG8_LAS __attribute__((address_space(3)))
typedef unsigned short bf16_t;
typedef short bf16x8 __attribute__((ext_vector_type(8)));
typedef float f32x4 __attribute__((ext_vector_type(4)));
typedef unsigned u32x4 __attribute__((ext_vector_type(4)));
constexpr int BM = 256, BK = 64, HALF = 128, HTB = HALF * BK * 2  , STAGE_BYTES = 8 * HTB, NXCD = 8, WGM = 8;

__host__ __device__ __forceinline__ int lds_byte(int r, int c) { const int st = (r >> 4) * 2 + (c >> 5), rr = r & 15, cc = c & 31, ob = rr * 64 + cc * 2; return st * 1024 + (ob ^ (((ob >> 9) & 1) << 5)); }
__host__ __device__ __forceinline__ void stage_rc(int b, int& R, int& C) { const int st = b / 1024, sb = b % 1024, swz = sb ^ (((sb >> 9) & 1) << 5); R = (st >> 1) * 16 + swz / 64; C = (st & 1) * 32 + (swz % 64) / 2; }
__host__ __device__ __forceinline__ int perm32(int rho) { const int n = rho >> 4, i = rho & 15; return 8 * (i >> 2) + 4 * n + (i & 3); }

struct Unit { int pm, pn; };
struct Gemm { const bf16_t* A; const bf16_t* Bt; int M, N, K; };

struct StaticOrder {
    int nM, nN, nwg, G, c;
    __host__ __device__ void init(int M, int N, int G_, int c_) { nM = M / BM; nN = N / BM; nwg = nM * nN; G = G_; c = c_; }
    __host__ __device__ bool next(int i, Unit& u) const {
        const long L = (long)i * G + c; if (L >= nwg) return false;
        int wgid = (int)L; { const int q = nwg / NXCD, r = nwg % NXCD, xcd = wgid % NXCD, off = wgid / NXCD; wgid = (xcd < r ? xcd * (q + 1) : r * (q + 1) + (xcd - r) * q) + off; }
        const int nig = WGM * nN, gid = wgid / nig, fm = gid * WGM, gsz = (nM - fm) < WGM ? (nM - fm) : WGM;
        u.pm = fm + ((wgid % nig) % gsz); u.pn = (wgid % nig) / gsz; return true;
    }
    __device__ __forceinline__ void a_ready(const Unit&) const {}
    __device__ __forceinline__ void done(const Unit&) const {}
};

__device__ __forceinline__ unsigned cvt_pk_bf16(float lo, float hi) { unsigned r; asm volatile("v_cvt_pk_bf16_f32 %0, %1, %2" : "=v"(r) : "v"(lo), "v"(hi)); return r; }
__device__ __forceinline__ float bf_lo(unsigned w) { return __uint_as_float(w << 16); }
__device__ __forceinline__ float bf_hi(unsigned w) { return __uint_as_float(w & 0xffff0000u); }
__device__ __forceinline__ float sigmoidf_(float x) { return 1.0f / (1.0f + __expf(-x)); }

struct EpiBf16Plain {
    static constexpr bool PERM = true, AFTER_DRAIN = false;
    bf16_t* O; int ldc;
    __device__ __forceinline__ void operator()(const f32x4 (&acc)[2][2][4][2], const Unit& u, int wr, int wc, int fr, int fq) const {
        const int row0 = u.pm * BM + wr * 64 + fr; const int col0 = u.pn * BM + wc * 32 + 8 * fq;
#pragma unroll
        for (int ai = 0; ai < 2; ++ai)
#pragma unroll
            for (int m = 0; m < 4; ++m) { bf16_t* rowp = O + (size_t)(row0 + ai * HALF + m * 16) * ldc + col0;
#pragma unroll
                for (int bj = 0; bj < 2; ++bj) { const f32x4 v0 = acc[ai][bj][m][0], v1 = acc[ai][bj][m][1];
                    u32x4 w; w.x = cvt_pk_bf16(v0[0], v0[1]); w.y = cvt_pk_bf16(v0[2], v0[3]); w.z = cvt_pk_bf16(v1[0], v1[1]); w.w = cvt_pk_bf16(v1[2], v1[3]);
                    *(u32x4*)(rowp + bj * HALF) = w; } }
    }
};
template <bool ADD> struct EpiGate {
    static constexpr bool PERM = true, AFTER_DRAIN = false;
    bf16_t* O; const bf16_t* G; int ldo, ldg;
    __device__ __forceinline__ void operator()(const f32x4 (&acc)[2][2][4][2], const Unit& u, int wr, int wc, int fr, int fq) const {
        const int row0 = u.pm * BM + wr * 64 + fr; const int col0 = u.pn * BM + wc * 32 + 8 * fq;
#pragma unroll
        for (int ai = 0; ai < 2; ++ai)
#pragma unroll
            for (int m = 0; m < 4; ++m) { const size_t row = (size_t)(row0 + ai * HALF + m * 16);
#pragma unroll
                for (int bj = 0; bj < 2; ++bj) { const f32x4 v0 = acc[ai][bj][m][0], v1 = acc[ai][bj][m][1];
                    const u32x4 gw = *(const u32x4*)(G + row * ldg + col0 + bj * HALF);
                    float r[8];
                    r[0] = sigmoidf_(bf_lo(gw.x)) * v0[0]; r[1] = sigmoidf_(bf_hi(gw.x)) * v0[1]; r[2] = sigmoidf_(bf_lo(gw.y)) * v0[2]; r[3] = sigmoidf_(bf_hi(gw.y)) * v0[3];
                    r[4] = sigmoidf_(bf_lo(gw.z)) * v1[0]; r[5] = sigmoidf_(bf_hi(gw.z)) * v1[1]; r[6] = sigmoidf_(bf_lo(gw.w)) * v1[2]; r[7] = sigmoidf_(bf_hi(gw.w)) * v1[3];
                    bf16_t* op = O + row * ldo + col0 + bj * HALF;
                    if (ADD) { const u32x4 pw = *(const u32x4*)op;
                        r[0] += bf_lo(pw.x); r[1] += bf_hi(pw.x); r[2] += bf_lo(pw.y); r[3] += bf_hi(pw.y); r[4] += bf_lo(pw.z); r[5] += bf_hi(pw.z); r[6] += bf_lo(pw.w); r[7] += bf_hi(pw.w); }
                    u32x4 w; w.x = cvt_pk_bf16(r[0], r[1]); w.y = cvt_pk_bf16(r[2], r[3]); w.z = cvt_pk_bf16(r[4], r[5]); w.w = cvt_pk_bf16(r[6], r[7]);
                    *(u32x4*)op = w; } }
    }
};
struct EpiSwiGLU {
    static constexpr bool PERM = true, AFTER_DRAIN = false;
    bf16_t* O; int ldo;
    __device__ __forceinline__ void operator()(const f32x4 (&acc)[2][2][4][2], const Unit& u, int wr, int wc, int fr, int fq) const {
        const int row0 = u.pm * BM + wr * 64 + fr; const int col0 = u.pn * HALF + wc * 32 + 8 * fq;
#pragma unroll
        for (int ai = 0; ai < 2; ++ai)
#pragma unroll
            for (int m = 0; m < 4; ++m) { const size_t row = (size_t)(row0 + ai * HALF + m * 16);
                const f32x4 g0 = acc[ai][0][m][0], g1 = acc[ai][0][m][1], u0 = acc[ai][1][m][0], u1 = acc[ai][1][m][1];
                float r[8];
#pragma unroll
                for (int e = 0; e < 4; ++e) { r[e] = g0[e] * sigmoidf_(g0[e]) * u0[e]; r[4 + e] = g1[e] * sigmoidf_(g1[e]) * u1[e]; }
                u32x4 w; w.x = cvt_pk_bf16(r[0], r[1]); w.y = cvt_pk_bf16(r[2], r[3]); w.z = cvt_pk_bf16(r[4], r[5]); w.w = cvt_pk_bf16(r[6], r[7]);
                *(u32x4*)(O + row * ldo + col0) = w; }
    }
};
struct EpiResF32 {
    static constexpr bool PERM = false, AFTER_DRAIN = false;
    const float* base; float* out; int ldc;
    __device__ __forceinline__ void operator()(const f32x4 (&acc)[2][2][4][2], const Unit& u, int wr, int wc, int fr, int fq) const {
        const int row0 = u.pm * BM + wr * 64 + fr, col0 = u.pn * BM + wc * 32 + 4 * fq;
#pragma unroll
        for (int ai = 0; ai < 2; ++ai)
#pragma unroll
            for (int m = 0; m < 4; ++m) { const size_t off = (size_t)(row0 + ai * HALF + m * 16) * ldc + col0;
#pragma unroll
                for (int bj = 0; bj < 2; ++bj)
#pragma unroll
                    for (int n = 0; n < 2; ++n) { const f32x4 bs = *(const f32x4*)(base + off + bj * HALF + n * 16); *(f32x4*)(out + off + bj * HALF + n * 16) = bs + acc[ai][bj][m][n]; } }
    }
};
template <class Epi, class Sched, bool ALIGN_EPI = false, bool SP2 = false>
__device__ __forceinline__ void gemm_phase(PG8_LAS unsigned char* lds, const Gemm g, const Sched& S, const Epi& E) {
    const int tid = threadIdx.x, wid = __builtin_amdgcn_readfirstlane(tid >> 6), lane = tid & 63, wr = wid >> 2, wc = wid & 3, fr = lane & 15, fq = lane >> 4;
    const int K = g.K, nt = K / BK;
    unsigned voffA[2], voffB[2];
#pragma unroll
    for (int i = 0; i < 2; ++i) { int R, C; stage_rc(tid * 16 + i * 8192, R, C); const int Rb = Epi::PERM ? ((R & ~31) + perm32(R & 31)) : R;
        voffA[i] = (unsigned)(R * K + C) * 2u; voffB[i] = (unsigned)(Rb * K + C) * 2u; }
    const size_t kstep = (size_t)(BK * 2);
    const size_t hstep = (size_t)HALF * K * 2;
    const size_t tstep = 2 * hstep;
    const unsigned ldsw = (unsigned)wid * 1024u;
    const int aoff = lds_byte(wr * 64 + fr, fq * 8), boff = lds_byte(wc * 32 + fr, fq * 8);
#define PG8_SA(b, h) (((b) * 2 + (h)) * HTB)
#define PG8_SB(b, h) ((4 + (b) * 2 + (h)) * HTB)
#define PG8_STAGE(bufoff, gbase, voff) do { _Pragma("unroll") for (int _i = 0; _i < 2; ++_i) \
        __builtin_amdgcn_global_load_lds((const unsigned*)((const char*)(gbase) + (voff)[_i]), (PG8_LAS unsigned*)(lds + (bufoff) + ldsw + _i * 8192), 16, 0, 0); } while (0)
#define PG8_LDA(dst, b, h) do { _Pragma("unroll") for (int m = 0; m < 4; ++m) _Pragma("unroll") for (int k = 0; k < 2; ++k) dst[m][k] = *(const PG8_LAS bf16x8*)(lds + PG8_SA(b, h) + aoff + m * 2048 + k * 1024); } while (0)
#define PG8_LDB(dst, b, h) do { _Pragma("unroll") for (int n = 0; n < 2; ++n) _Pragma("unroll") for (int k = 0; k < 2; ++k) dst[n][k] = *(const PG8_LAS bf16x8*)(lds + PG8_SB(b, h) + boff + n * 2048 + k * 1024); } while (0)
#define PG8_MMA(ai, bj, At, Bt) do { __builtin_amdgcn_s_setprio(1); _Pragma("unroll") for (int m = 0; m < 4; ++m) _Pragma("unroll") for (int n = 0; n < 2; ++n) _Pragma("unroll") for (int k = 0; k < 2; ++k) \
        acc[ai][bj][m][n] = __builtin_amdgcn_mfma_f32_16x16x32_bf16(Bt[n][k], At[m][k], acc[ai][bj][m][n], 0, 0, 0); __builtin_amdgcn_s_setprio(0); } while (0)
#define PG8_WAIT_V(n) asm volatile("s_waitcnt vmcnt(" #n ")" ::: "memory")
#define PG8_WAIT_L(n) asm volatile("s_waitcnt lgkmcnt(" #n ")" ::: "memory")
#define PG8_BAR __builtin_amdgcn_s_barrier()
#define PG8_SCHED __builtin_amdgcn_sched_barrier(0)
    Unit cur, nxt; int ui = 0;
    if (!S.next(0, cur)) return;
    f32x4 acc[2][2][4][2];
#pragma unroll
    for (int a = 0; a < 2; ++a)
#pragma unroll
        for (int b = 0; b < 2; ++b)
#pragma unroll
            for (int m = 0; m < 4; ++m)
#pragma unroll
                for (int n = 0; n < 2; ++n) acc[a][b][m][n] = (f32x4){0.f, 0.f, 0.f, 0.f};
    bf16x8 At[4][2], B0[2][2], B1[2][2];
    const char* cA = (const char*)g.A + (size_t)cur.pm * tstep; const char* cB = (const char*)g.Bt + (size_t)cur.pn * tstep;
    S.a_ready(cur);
    if constexpr (SP2) {
        PG8_STAGE(PG8_SB(0, 0), cB, voffB); PG8_STAGE(PG8_SB(0, 1), cB + hstep, voffB); PG8_STAGE(PG8_SA(0, 0), cA, voffA); PG8_STAGE(PG8_SA(0, 1), cA + hstep, voffA);
        if (wr == 1) PG8_BAR;
        PG8_WAIT_V(2); PG8_BAR;
        PG8_STAGE(PG8_SB(1, 0), cB + kstep, voffB); PG8_STAGE(PG8_SA(1, 0), cA + kstep, voffA); PG8_STAGE(PG8_SB(1, 1), cB + hstep + kstep, voffB);
        PG8_WAIT_V(6); PG8_BAR;
    } else {
        PG8_STAGE(PG8_SB(0, 0), cB, voffB); PG8_STAGE(PG8_SA(0, 0), cA, voffA); PG8_STAGE(PG8_SB(0, 1), cB + hstep, voffB); PG8_STAGE(PG8_SA(0, 1), cA + hstep, voffA);
        if (wr == 1) PG8_BAR;
        PG8_WAIT_V(4); PG8_BAR;
        PG8_STAGE(PG8_SB(1, 0), cB + kstep, voffB); PG8_STAGE(PG8_SA(1, 0), cA + kstep, voffA); PG8_STAGE(PG8_SB(1, 1), cB + hstep + kstep, voffB);
        PG8_WAIT_V(6); PG8_BAR;
    }
    for (;;) {
        const bool has_next = S.next(ui + 1, nxt);
        const char* nA = has_next ? (const char*)g.A + (size_t)nxt.pm * tstep : cA; const char* nB = has_next ? (const char*)g.Bt + (size_t)nxt.pn * tstep : cB;
        for (int t = 0; t < nt; t += 2) {
            const bool last = (t == nt - 2);
            const char* a1 = cA + (size_t)(t + 1) * kstep;
            const char* a2 = last ? nA : cA + (size_t)(t + 2) * kstep; const char* b2 = last ? nB : cB + (size_t)(t + 2) * kstep;
            const char* a3 = a2 + kstep; const char* b3 = b2 + kstep;
            if (last && has_next) S.a_ready(nxt);
            if constexpr (SP2) {
            PG8_LDB(B0, 0, 0); PG8_LDB(B1, 0, 1); PG8_SCHED; PG8_LDA(At, 0, 0); PG8_STAGE(PG8_SA(1, 1), a1 + hstep, voffA);
            PG8_WAIT_V(8); PG8_WAIT_L(0); PG8_BAR; PG8_MMA(0, 0, At, B0); PG8_MMA(0, 1, At, B1); PG8_BAR; PG8_SCHED;
            PG8_LDA(At, 0, 1); PG8_STAGE(PG8_SB(0, 0), b2, voffB); PG8_STAGE(PG8_SB(0, 1), b2 + hstep, voffB); PG8_STAGE(PG8_SA(0, 0), a2, voffA);
            PG8_WAIT_V(8); PG8_WAIT_L(0); PG8_BAR; PG8_MMA(1, 0, At, B0); PG8_MMA(1, 1, At, B1); PG8_BAR; PG8_SCHED;
            PG8_LDB(B0, 1, 0); PG8_LDB(B1, 1, 1); PG8_SCHED; PG8_LDA(At, 1, 0); PG8_STAGE(PG8_SA(0, 1), a2 + hstep, voffA);
            PG8_WAIT_V(8); PG8_WAIT_L(0); PG8_BAR; PG8_MMA(0, 0, At, B0); PG8_MMA(0, 1, At, B1); PG8_BAR; PG8_SCHED;
            PG8_LDA(At, 1, 1); PG8_STAGE(PG8_SB(1, 0), b3, voffB); PG8_STAGE(PG8_SB(1, 1), b3 + hstep, voffB); PG8_STAGE(PG8_SA(1, 0), a3, voffA);
            PG8_WAIT_V(8); PG8_WAIT_L(0); PG8_BAR; PG8_MMA(1, 0, At, B0); PG8_MMA(1, 1, At, B1); PG8_BAR; PG8_SCHED;
            } else {
            PG8_LDB(B0, 0, 0); PG8_SCHED; PG8_LDA(At, 0, 0); PG8_STAGE(PG8_SA(1, 1), a1 + hstep, voffA);
            PG8_WAIT_L(8); PG8_BAR; PG8_WAIT_L(0); PG8_MMA(0, 0, At, B0); PG8_BAR; PG8_SCHED;
            PG8_LDB(B1, 0, 1); PG8_STAGE(PG8_SB(0, 0), b2, voffB);
            PG8_BAR; PG8_WAIT_L(0); PG8_MMA(0, 1, At, B1); PG8_BAR;
            PG8_LDA(At, 0, 1); PG8_STAGE(PG8_SA(0, 0), a2, voffA);
            PG8_BAR; PG8_WAIT_L(0); PG8_MMA(1, 0, At, B0); PG8_BAR; PG8_SCHED;
            PG8_STAGE(PG8_SB(0, 1), b2 + hstep, voffB);
            PG8_WAIT_V(6); PG8_BAR; PG8_MMA(1, 1, At, B1); PG8_BAR;
            PG8_LDB(B0, 1, 0); PG8_SCHED; PG8_LDA(At, 1, 0); PG8_STAGE(PG8_SA(0, 1), a2 + hstep, voffA);
            PG8_WAIT_L(8); PG8_BAR; PG8_WAIT_L(0); PG8_MMA(0, 0, At, B0); PG8_BAR; PG8_SCHED;
            PG8_LDB(B1, 1, 1); PG8_STAGE(PG8_SB(1, 0), b3, voffB);
            PG8_BAR; PG8_WAIT_L(0); PG8_MMA(0, 1, At, B1); PG8_BAR;
            PG8_LDA(At, 1, 1); PG8_STAGE(PG8_SA(1, 0), a3, voffA);
            PG8_BAR; PG8_WAIT_L(0); PG8_MMA(1, 0, At, B0); PG8_BAR; PG8_SCHED;
            PG8_STAGE(PG8_SB(1, 1), b3 + hstep, voffB);
            PG8_WAIT_V(6); PG8_BAR; PG8_MMA(1, 1, At, B1); PG8_BAR;
            }
        }
        if constexpr (ALIGN_EPI) { if (wr == 0) PG8_BAR; }
        if constexpr (!Epi::AFTER_DRAIN) { E(acc, cur, wr, wc, fr, fq); S.done(cur); }
        if (!has_next) break;
#pragma unroll
        for (int a = 0; a < 2; ++a)
#pragma unroll
            for (int b = 0; b < 2; ++b)
#pragma unroll
                for (int m = 0; m < 4; ++m)
#pragma unroll
                    for (int n = 0; n < 2; ++n) acc[a][b][m][n] = (f32x4){0.f, 0.f, 0.f, 0.f};
        cur = nxt; cA = nA; cB = nB; ++ui;
        if constexpr (ALIGN_EPI) { if (wr == 1) PG8_BAR; }
    }
    PG8_WAIT_V(0);
    if constexpr (!ALIGN_EPI) { if (wr == 0) PG8_BAR; }
    PG8_BAR;
    if constexpr (Epi::AFTER_DRAIN) { E.fused(acc, cur, wr, wc, fr, fq, lds, wid, lane); S.done(cur); }
#undef PG8_SA
#undef PG8_SB
#undef PG8_STAGE
#undef PG8_LDA
#undef PG8_LDB
#undef PG8_MMA
#undef PG8_WAIT_V
#undef PG8_WAIT_L
#undef PG8_BAR
#undef PG8_SCHED
}
}

constexpr int NB = 4, SEQ = 2048, DM = 2048, MTOK = NB * SEQ;
constexpr int INW = 15424, DFF = 5632;
constexpr int ZW = 15616;
constexpr int ZGQ = 0, ZGK = 1024, ZGV = 2048, ZGR = 4096, ZNQ = 6144, ZNKV = 8192, ZMG = 11264, ZGLR = 15360, ZNG = 15376;
constexpr float RMS_EPS = 1e-6f;
constexpr size_t MiB = 1u << 20;
constexpr size_t WS_CTL = 0, CTL_ZERO_BYTES = 1 * MiB;
constexpr size_t WS_BIAS1 = 4096;
constexpr size_t WS_WINT = 1 * MiB, WS_WPG = 62 * MiB, WS_WPN = 70 * MiB, WS_WOUT = 78 * MiB, WS_W1T = 86 * MiB, WS_W2T = 90 * MiB;
constexpr size_t WS_KC = 91 * MiB, WS_VCT = 91 * MiB + 512 * 1024, WS_DECAY = 92 * MiB, WS_VTS = 93 * MiB, WS_VTW = 101 * MiB, WS_ATT = 109 * MiB;
constexpr size_t WS_QD = 113 * MiB, WS_KET = 129 * MiB, WS_ON = 113 * MiB  ;
constexpr size_t WS_BUFA = 145 * MiB  , WS_BUFB = 177 * MiB  , WS_Z = 209 * MiB;
constexpr size_t WS_WGU = 209 * MiB, WS_WD = 253 * MiB, WS_ACT = 275 * MiB  ;
constexpr size_t WS_END = 453 * MiB;
constexpr int LDS_BYTES = 147456;

#define LAS __attribute__((address_space(3)))
#define DI __device__ __forceinline__
typedef unsigned short bf16;
typedef unsigned v4u __attribute__((ext_vector_type(4)));
typedef unsigned v2u __attribute__((ext_vector_type(2)));
typedef float f32x4 __attribute__((ext_vector_type(4)));
typedef float f32x16 __attribute__((ext_vector_type(16)));
typedef short bf16x8 __attribute__((ext_vector_type(8)));
typedef float f32x2_t __attribute__((ext_vector_type(2)));
typedef __bf16 bf16x2_t __attribute__((ext_vector_type(2)));
#define MFMA32(a, b, c) __builtin_amdgcn_mfma_f32_32x32x16_bf16((a), (b), (c), 0, 0, 0)
#define MFMA16(a, b, c) __builtin_amdgcn_mfma_f32_16x16x32_bf16((a), (b), (c), 0, 0, 0)
#define LDS_WAIT() asm volatile("s_waitcnt lgkmcnt(0)" ::: "memory")

DI unsigned f2bf(float f) { unsigned u = __builtin_bit_cast(unsigned, f); return (u + 0x7fffu + ((u >> 16) & 1u)) >> 16; }
DI unsigned pk2(float lo, float hi) { f32x2_t v = {lo, hi}; bf16x2_t b = __builtin_convertvector(v, bf16x2_t); return __builtin_bit_cast(unsigned, b); }
DI float bf2f(bf16 b) { return __uint_as_float(((unsigned)b) << 16); }
DI float blo(unsigned w) { return __uint_as_float(w << 16); }
DI float bhi(unsigned w) { return __uint_as_float(w & 0xffff0000u); }
DI float sigm(float x) { return 1.0f / (1.0f + __expf(-x)); }
DI float wave_sum(float v) {
#pragma unroll
    for (int o = 1; o < 64; o <<= 1) v += __shfl_xor(v, o);
    return v;
}
DI bf16x8 pack8(float a0, float a1, float a2, float a3, float a4, float a5, float a6, float a7) {
    v4u p; p.x = pk2(a0, a1); p.y = pk2(a2, a3); p.z = pk2(a4, a5); p.w = pk2(a6, a7); return __builtin_bit_cast(bf16x8, p);
}

struct Args {
    const float* in[20]; float* out; unsigned char* ws; int ph_lo, ph_hi;
};
struct Frame {
    LAS unsigned char* lds; int tid, lane, wave, G, bid;
    const float* x; const float* g_mix; const float* w_in; const float* w_gla_gate; const float* b_gla_gate; const float* g_gla_out;
    const float* pe_k; const float* w_ck1; const float* w_ck2; const float* pe_v; const float* w_cv1; const float* w_cv2;
    const float* w_pg; const float* w_pn; const float* w_out; const float* g_ffn; const float* w_fg; const float* w_fu; const float* w_fd; const float* g_final;
    float* out; unsigned char* ws;
};

struct MapId { DI int operator()(int n) const { return n; } };
struct MapOff { int off; DI int operator()(int n) const { return n + off; } };
struct MapWin { DI int operator()(int n) const {
    if (n < 6144) return n; if (n < 6160) return ZGLR + (n - 6144); if (n < 8208) return ZNQ + (n - 6160);
    if (n < 11280) return ZNKV + (n - 8208); if (n < 11328) return ZNG + (n - 11280); return ZMG + (n - 11328); } };
struct MapGU { int up; DI int operator()(int n) const { return (n >> 7) * 256 + up * 128 + (n & 127); } };

template <class Map>
DI void transpose_item(const float* __restrict__ W, int N, bf16* __restrict__ WT, int Kp, LAS float* scr, int item, int lane, const Map map) {
    const int nblk = N / 32, kb = item / nblk, nb = item - kb * nblk, k0 = 64 * kb, n0 = 32 * nb;
#pragma unroll 8
    for (int i = 0; i < 32; ++i) { const int kk = 2 * i + (lane >> 5); scr[kk * 33 + (lane & 31)] = W[(size_t)(k0 + kk) * N + n0 + (lane & 31)]; }
    LDS_WAIT();
    const int c = lane & 7;
#pragma unroll
    for (int j = 0; j < 4; ++j) { const int n = (lane >> 3) + 8 * j; const LAS float* s = scr + (8 * c) * 33 + n;
        v4u o; o.x = pk2(s[0 * 33], s[1 * 33]); o.y = pk2(s[2 * 33], s[3 * 33]); o.z = pk2(s[4 * 33], s[5 * 33]); o.w = pk2(s[6 * 33], s[7 * 33]);
        *(v4u*)(WT + (size_t)map(n0 + n) * Kp + k0 + 8 * c) = o; }
    LDS_WAIT();
}
template <bool TO_BF16>
DI void rms_row(const float* __restrict__ xrow, const float* __restrict__ g, void* orow, int lane) {
    const f32x4* xr = (const f32x4*)xrow + lane; const f32x4* gr = (const f32x4*)g + lane;
    f32x4 v[8]; float s = 0.f;
#pragma unroll
    for (int j = 0; j < 8; ++j) { v[j] = xr[64 * j]; s += (v[j].x * v[j].x + v[j].y * v[j].y) + (v[j].z * v[j].z + v[j].w * v[j].w); }
    const float rs = rsqrtf(wave_sum(s) * (1.f / DM) + RMS_EPS);
#pragma unroll
    for (int j = 0; j < 8; ++j) { const f32x4 gg = gr[64 * j]; const f32x4 o = v[j] * rs * gg;
        if (TO_BF16) { v2u w; w.x = pk2(o.x, o.y); w.y = pk2(o.z, o.w); ((v2u*)orow)[lane + 64 * j] = w; }
        else ((f32x4*)orow)[lane + 64 * j] = o; }
}

DI void p0_prologue(Frame& F) {
    LAS float* scr = (LAS float*)(F.lds + F.wave * 8448);
    const int gw = F.bid * 8 + F.wave, NGW = F.G * 8;
    bf16* WINT = (bf16*)(F.ws + WS_WINT); bf16* WPG = (bf16*)(F.ws + WS_WPG); bf16* WPN = (bf16*)(F.ws + WS_WPN); bf16* WOUT = (bf16*)(F.ws + WS_WOUT);
    bf16* W1T = (bf16*)(F.ws + WS_W1T); bf16* W2T = (bf16*)(F.ws + WS_W2T);
    constexpr int I_IN = (DM / 64) * (INW / 32), I_P = (DM / 64) * (DM / 32), I_C1 = (4096 / 64) * (256 / 32), I_C2 = (256 / 64) * (128 / 32);
    constexpr int NITEMS = I_IN + 3 * I_P + 2 * I_C1 + 2 * I_C2;
    for (int it = gw; it < NITEMS; it += NGW) {
        int r = it;
        if (r < I_IN) { transpose_item(F.w_in, INW, WINT, DM, scr, r, F.lane, MapWin{}); continue; } r -= I_IN;
        if (r < I_P) { transpose_item(F.w_pg, DM, WPG, DM, scr, r, F.lane, MapId{}); continue; } r -= I_P;
        if (r < I_P) { transpose_item(F.w_pn, DM, WPN, DM, scr, r, F.lane, MapId{}); continue; } r -= I_P;
        if (r < I_P) { transpose_item(F.w_out, DM, WOUT, DM, scr, r, F.lane, MapId{}); continue; } r -= I_P;
        if (r < I_C1) { transpose_item(F.w_ck1, 256, W1T, 4096, scr, r, F.lane, MapId{}); continue; } r -= I_C1;
        if (r < I_C1) { transpose_item(F.w_cv1, 256, W1T, 4096, scr, r, F.lane, MapOff{256}); continue; } r -= I_C1;
        if (r < I_C2) { transpose_item(F.w_ck2, 128, W2T, 256, scr, r, F.lane, MapId{}); continue; } r -= I_C2;
        transpose_item(F.w_cv2, 128, W2T, 256, scr, r, F.lane, MapOff{128});
    }
    bf16* H = (bf16*)(F.ws + WS_BUFA);
    for (int m = gw; m < MTOK; m += NGW) rms_row<true>(F.x + (size_t)m * DM, F.g_mix, H + (size_t)m * DM, F.lane);
    float* bias1 = (float*)(F.ws + WS_BIAS1);
    for (int it = gw; it < 128; it += NGW) {
        const int which = it >> 6, kc = it & 63; const float* pe = which ? F.pe_v : F.pe_k; const float* w1 = which ? F.w_cv1 : F.w_ck1;
        float a[4] = {0.f, 0.f, 0.f, 0.f};
        for (int kk = kc * 64; kk < kc * 64 + 64; ++kk) { const float p = pe[kk];
#pragma unroll
            for (int q = 0; q < 4; ++q) a[q] += p * w1[(size_t)kk * 256 + F.lane + 64 * q]; }
#pragma unroll
        for (int q = 0; q < 4; ++q) atomicAdd(bias1 + which * 256 + F.lane + 64 * q, a[q]);
    }
}
DI void p7_norm_ffnw(Frame& F) {
    LAS float* scr = (LAS float*)(F.lds + F.wave * 8448);
    const int gw = F.bid * 8 + F.wave, NGW = F.G * 8;
    bf16* WGU = (bf16*)(F.ws + WS_WGU); bf16* WD = (bf16*)(F.ws + WS_WD);
    constexpr int I_G = (DM / 64) * (DFF / 32), I_D = (DFF / 64) * (DM / 32);
    for (int it = gw; it < 2 * I_G + I_D; it += NGW) {
        int r = it;
        if (r < I_G) { transpose_item(F.w_fg, DFF, WGU, DM, scr, r, F.lane, MapGU{0}); continue; } r -= I_G;
        if (r < I_G) { transpose_item(F.w_fu, DFF, WGU, DM, scr, r, F.lane, MapGU{1}); continue; } r -= I_G;
        transpose_item(F.w_fd, DM, WD, DFF, scr, r, F.lane, MapId{});
    }
    bf16* H2 = (bf16*)(F.ws + WS_BUFB);
    for (int m = gw; m < MTOK; m += NGW) rms_row<true>(F.out + (size_t)m * DM, F.g_ffn, H2 + (size_t)m * DM, F.lane);
}
DI void p10_final(Frame& F) {
    const int gw = F.bid * 8 + F.wave, NGW = F.G * 8;
    for (int m = gw; m < MTOK; m += NGW) rms_row<false>(F.out + (size_t)m * DM, F.g_final, F.out + (size_t)m * DM, F.lane);
}

DI void g1_item(Frame& F, int item) {
    const bf16* Z = (const bf16*)(F.ws + WS_Z);
    bf16* QD = (bf16*)(F.ws + WS_QD); bf16* KET = (bf16*)(F.ws + WS_KET); bf16* ATT = (bf16*)(F.ws + WS_ATT); float* DECAY = (float*)(F.ws + WS_DECAY);
    const int bh = item >> 5, c = item & 31, b = bh >> 2, h = bh & 3;
    const size_t t0 = (size_t)b * SEQ + c * 64;
    LAS float* glr_s = (LAS float*)(F.lds);
    LAS float* tot_s = (LAS float*)(F.lds + 4096);
    LAS bf16* qd_s = (LAS bf16*)(F.lds + 8192);
    LAS bf16* kd_s = (LAS bf16*)(F.lds + 8192 + 33792);
    const int tid = F.tid, dk = tid & 255, half = tid >> 8;
    for (int e = tid; e < 1024; e += 512) { const int tok = e >> 4, r = e & 15; glr_s[e] = bf2f(Z[(t0 + tok) * ZW + ZGLR + r]); }
    float wg[16];
#pragma unroll
    for (int r = 0; r < 16; ++r) wg[r] = F.w_gla_gate[r * 1024 + h * 256 + dk];
    const float bg = F.b_gla_gate[h * 256 + dk];
    __syncthreads();
    float bc[32]; float run = 0.f;
#pragma unroll
    for (int i = 0; i < 32; ++i) { const int tok = half * 32 + i; float xg = bg;
        const LAS f32x4* gp = (const LAS f32x4*)(glr_s + tok * 16);
#pragma unroll
        for (int r4 = 0; r4 < 4; ++r4) { const f32x4 gv = gp[r4]; xg += gv.x * wg[4 * r4] + gv.y * wg[4 * r4 + 1] + gv.z * wg[4 * r4 + 2] + gv.w * wg[4 * r4 + 3]; }
        const float ls = fminf(xg, 0.f) - log1pf(__expf(-fabsf(xg)));
        run += ls * 0.0625f; bc[i] = run; }
    tot_s[half * 256 + dk] = run;
    __syncthreads();
    const float tot0 = tot_s[dk], tot1 = tot_s[256 + dk]; const float blast = tot0 + tot1, boff = half ? tot0 : 0.f;
    unsigned kep[16];
#pragma unroll
    for (int i = 0; i < 32; i += 2) { float ke2[2];
#pragma unroll
        for (int e = 0; e < 2; ++e) { const int tok = half * 32 + i + e; const float bb = bc[i + e] + boff;
            const float q = bf2f(Z[(t0 + tok) * ZW + ZGQ + h * 256 + dk]), k = bf2f(Z[(t0 + tok) * ZW + ZGK + h * 256 + dk]);
            const float qd = q * 0.0625f * __expf(bb), kd = k * __expf(-bb); ke2[e] = k * __expf(blast - bb);
            const bf16 qb = (bf16)f2bf(qd); qd_s[tok * 264 + dk] = qb; kd_s[tok * 264 + dk] = (bf16)f2bf(kd); QD[(t0 + tok) * 1024 + h * 256 + dk] = qb; }
        kep[i >> 1] = pk2(ke2[0], ke2[1]); }
    { v4u* kp = (v4u*)(KET + ((size_t)item * 256 + dk) * 64 + half * 32);
#pragma unroll
      for (int q = 0; q < 4; ++q) { v4u w; w.x = kep[4 * q]; w.y = kep[4 * q + 1]; w.z = kep[4 * q + 2]; w.w = kep[4 * q + 3]; kp[q] = w; } }
    if (half == 0) DECAY[(size_t)item * 256 + dk] = __expf(blast);
    __syncthreads();
    const int w = F.wave, fr = F.lane & 15, fq = F.lane >> 4, mt = w >> 1;
#pragma unroll
    for (int nn = 0; nn < 2; ++nn) { const int nt = (w & 1) * 2 + nn; f32x4 acc = {0.f, 0.f, 0.f, 0.f};
        if (nt <= mt) {
#pragma unroll
            for (int s = 0; s < 8; ++s) { const bf16x8 a = *(const LAS bf16x8*)(qd_s + (16 * mt + fr) * 264 + 32 * s + 8 * fq); const bf16x8 bb = *(const LAS bf16x8*)(kd_s + (16 * nt + fr) * 264 + 32 * s + 8 * fq);
                acc = MFMA16(a, bb, acc); } }
#pragma unroll
        for (int j = 0; j < 4; ++j) { const int row = 16 * mt + 4 * fq + j, col = 16 * nt + fr; const float v = (col <= row) ? acc[j] : 0.f;
            ATT[(size_t)item * 4096 + row * 64 + col] = (bf16)f2bf(v); } }
    __syncthreads();
}

DI void n1_item(Frame& F, int item) {
    const bf16* Z = (const bf16*)(F.ws + WS_Z);
    const bf16* W1T = (const bf16*)(F.ws + WS_W1T); const bf16* W2T = (const bf16*)(F.ws + WS_W2T); const float* bias1 = (const float*)(F.ws + WS_BIAS1);
    bf16* KC = (bf16*)(F.ws + WS_KC); bf16* VCT = (bf16*)(F.ws + WS_VCT);
    const int which = item >> 6, b = (item >> 4) & 3, hk = (item >> 2) & 3, j = item & 3;
    const int w = F.wave, r = F.lane & 31, hh = F.lane >> 5;
    LAS bf16* hid = (LAS bf16*)(F.lds);
    int crow_ = 32 * j + r; if (crow_ > 126) crow_ = 126;
    const bf16* ap = Z + ((size_t)b * SEQ + 16 * crow_) * ZW + ZNKV + which * 512 + hk * 128 + 8 * hh;
    const bf16* bp = W1T + ((size_t)which * 256 + 32 * w + r) * 4096 + 8 * hh;
    f32x16 acc; for (int i = 0; i < 16; ++i) acc[i] = 0.f;
    for (int tk = 0; tk < 32; ++tk) {
#pragma unroll
        for (int s = 0; s < 8; ++s) { const bf16x8 a = *(const bf16x8*)(ap + (size_t)tk * ZW + 16 * s); const bf16x8 bb = *(const bf16x8*)(bp + tk * 128 + 16 * s); acc = MFMA32(a, bb, acc); } }
    { const float bs = bias1[which * 256 + 32 * w + r];
#pragma unroll
      for (int i = 0; i < 16; ++i) { const int row = (i & 3) + 8 * (i >> 2) + 4 * hh; const float v = acc[i] + bs; hid[row * 264 + 32 * w + r] = (bf16)f2bf(v * sigm(v)); } }
    __syncthreads();
    if (w < 4) {
        f32x16 o; for (int i = 0; i < 16; ++i) o[i] = 0.f;
        const bf16* b2 = W2T + ((size_t)which * 128 + 32 * w + r) * 256 + 8 * hh;
#pragma unroll
        for (int s = 0; s < 16; ++s) { const bf16x8 a = *(const LAS bf16x8*)(hid + r * 264 + 16 * s + 8 * hh); const bf16x8 bb = *(const bf16x8*)(b2 + 16 * s); o = MFMA32(a, bb, o); }
        const int d = 32 * w + r;
        if (which == 0) {
#pragma unroll
            for (int i = 0; i < 16; ++i) { const int cc = 32 * j + (i & 3) + 8 * (i >> 2) + 4 * hh; KC[(((size_t)b * 4 + hk) * 128 + cc) * 128 + d] = (bf16)f2bf(o[i]); }
        } else {
#pragma unroll
            for (int a4 = 0; a4 < 4; ++a4) { v2u wv; wv.x = pk2(o[4 * a4], o[4 * a4 + 1]); wv.y = pk2(o[4 * a4 + 2], o[4 * a4 + 3]);
                *(v2u*)(VCT + (((size_t)b * 4 + hk) * 128 + d) * 128 + 32 * j + 8 * a4 + 4 * hh) = wv; }
        }
    }
    __syncthreads();
}
DI void vt_item(Frame& F, int item) {
    const bf16* Z = (const bf16*)(F.ws + WS_Z);
    const int dhalf = item & 1, tile = (item >> 1) & 31, hk = (item >> 6) & 3, b = (item >> 8) & 3, which = item >> 10;
    bf16* VT = (bf16*)(F.ws + (which ? WS_VTW : WS_VTS));
    LAS bf16* scr = (LAS bf16*)(F.lds + F.wave * 8448);
    const int lane = F.lane;
    const bf16* src = Z + ((size_t)b * SEQ + tile * 64) * ZW + ZNKV + (3 + 2 * which) * 512 + hk * 128 + dhalf * 64;
#pragma unroll
    for (int p = 0; p < 8; ++p) { const int tok = 8 * p + (lane >> 3), d8 = (lane & 7) * 8; const v4u v = *(const v4u*)(src + (size_t)tok * ZW + d8);
        LAS unsigned* dst = (LAS unsigned*)(scr + tok * 66 + d8); dst[0] = v.x; dst[1] = v.y; dst[2] = v.z; dst[3] = v.w; }
    LDS_WAIT();
#pragma unroll
    for (int p = 0; p < 8; ++p) { const int d = 8 * p + (lane >> 3), t8 = (lane & 7) * 8; unsigned short e[8];
#pragma unroll
        for (int q = 0; q < 8; ++q) e[q] = scr[(t8 + q) * 66 + d];
        v4u o; o.x = e[0] | ((unsigned)e[1] << 16); o.y = e[2] | ((unsigned)e[3] << 16); o.z = e[4] | ((unsigned)e[5] << 16); o.w = e[6] | ((unsigned)e[7] << 16);
        *(v4u*)(VT + (((size_t)b * 4 + hk) * 128 + dhalf * 64 + d) * SEQ + tile * 64 + t8) = o; }
    LDS_WAIT();
}
DI void p2_prep(Frame& F) {
    for (int it = F.bid; it < 128 + 512; it += F.G) { if (it < 128) n1_item(F, it); else g1_item(F, it - 128); }
    __syncthreads();
    const int gw = F.bid * 8 + F.wave, NGW = F.G * 8;
    for (int it = gw; it < 2048; it += NGW) vt_item(F, it);
}

DI void g2_item(Frame& F, int item) {
    const bf16* Z = (const bf16*)(F.ws + WS_Z);
    const bf16* QD = (const bf16*)(F.ws + WS_QD); const bf16* KET = (const bf16*)(F.ws + WS_KET); const bf16* ATT = (const bf16*)(F.ws + WS_ATT); const float* DECAY = (const float*)(F.ws + WS_DECAY);
    float* O = F.out;
    const int bh = item >> 4, js = item & 15, b = bh >> 2, h = bh & 3;
    LAS bf16* ST = (LAS bf16*)(F.lds);
    LAS bf16* VT = (LAS bf16*)(F.lds + 16896);
    const int tid = F.tid, w = F.wave, fr = F.lane & 15, fq = F.lane >> 4, mt = w >> 1, nt = w & 1;
    for (int e = tid; e < 4224; e += 512) ((LAS unsigned*)ST)[e] = 0u;
    f32x4 Sacc[2][2];
#pragma unroll
    for (int a = 0; a < 2; ++a)
#pragma unroll
        for (int c2 = 0; c2 < 2; ++c2) Sacc[a][c2] = (f32x4){0.f, 0.f, 0.f, 0.f};
    const int vtok = tid >> 3, vd4 = (tid & 7) * 4;
    const size_t vcol = ZGV + h * 512 + 32 * js;
    for (int c = 0; c < 32; ++c) {
        const size_t itemc = (size_t)bh * 32 + c, t0 = (size_t)b * SEQ + c * 64;
        const v2u vv = *(const v2u*)(Z + (t0 + vtok) * ZW + vcol + vd4);
        bf16x8 aatt[2], aqd[8], aket[2][2]; f32x4 dec[2];
#pragma unroll
        for (int s = 0; s < 2; ++s) aatt[s] = *(const bf16x8*)(ATT + itemc * 4096 + (16 * mt + fr) * 64 + 32 * s + 8 * fq);
#pragma unroll
        for (int s = 0; s < 8; ++s) aqd[s] = *(const bf16x8*)(QD + (t0 + 16 * mt + fr) * 1024 + h * 256 + 32 * s + 8 * fq);
#pragma unroll
        for (int mi = 0; mi < 2; ++mi) {
#pragma unroll
            for (int s = 0; s < 2; ++s) aket[mi][s] = *(const bf16x8*)(KET + (itemc * 256 + 32 * w + 16 * mi + fr) * 64 + 32 * s + 8 * fq);
            dec[mi] = *(const f32x4*)(DECAY + itemc * 256 + 32 * w + 16 * mi + 4 * fq); }
        VT[(vd4 + 0) * 72 + vtok] = (bf16)(vv.x & 0xffffu); VT[(vd4 + 1) * 72 + vtok] = (bf16)(vv.x >> 16);
        VT[(vd4 + 2) * 72 + vtok] = (bf16)(vv.y & 0xffffu); VT[(vd4 + 3) * 72 + vtok] = (bf16)(vv.y >> 16);
        __syncthreads();
        f32x4 o = {0.f, 0.f, 0.f, 0.f};
#pragma unroll
        for (int s = 0; s < 2; ++s) { const bf16x8 bb = *(const LAS bf16x8*)(VT + (16 * nt + fr) * 72 + 32 * s + 8 * fq); o = MFMA16(aatt[s], bb, o); }
#pragma unroll
        for (int s = 0; s < 8; ++s) { const bf16x8 bb = *(const LAS bf16x8*)(ST + (16 * nt + fr) * 264 + 32 * s + 8 * fq); o = MFMA16(aqd[s], bb, o); }
#pragma unroll
        for (int jj = 0; jj < 4; ++jj) O[(t0 + 16 * mt + 4 * fq + jj) * 2048 + h * 512 + 32 * js + 16 * nt + fr] = o[jj];
#pragma unroll
        for (int mi = 0; mi < 2; ++mi)
#pragma unroll
            for (int ni = 0; ni < 2; ++ni) { f32x4 a = Sacc[mi][ni] * dec[mi];
#pragma unroll
                for (int s = 0; s < 2; ++s) { const bf16x8 bb = *(const LAS bf16x8*)(VT + (16 * ni + fr) * 72 + 32 * s + 8 * fq); a = MFMA16(aket[mi][s], bb, a); }
                Sacc[mi][ni] = a; }
        __syncthreads();
#pragma unroll
        for (int mi = 0; mi < 2; ++mi)
#pragma unroll
            for (int ni = 0; ni < 2; ++ni) { v2u wv; wv.x = pk2(Sacc[mi][ni][0], Sacc[mi][ni][1]); wv.y = pk2(Sacc[mi][ni][2], Sacc[mi][ni][3]);
                *(LAS v2u*)(ST + (16 * ni + fr) * 264 + 32 * w + 16 * mi + 4 * fq) = wv; }
    }
    __syncthreads();
}
DI void p3_scan(Frame& F) { for (int it = F.bid; it < 256; it += F.G) g2_item(F, it); }

DI void gla_out_row(Frame& F, int rowh) {
    const bf16* Z = (const bf16*)(F.ws + WS_Z); bf16* OG = (bf16*)(F.ws + WS_BUFB);
    const int t = rowh >> 2, h = rowh & 3, lane = F.lane;
    const f32x4* op = (const f32x4*)(F.out + (size_t)t * 2048 + h * 512) + lane;
    const f32x4 a = op[0], bq = op[64];
    float s = (a.x * a.x + a.y * a.y) + (a.z * a.z + a.w * a.w) + (bq.x * bq.x + bq.y * bq.y) + (bq.z * bq.z + bq.w * bq.w);
    const float rs = rsqrtf(wave_sum(s) * (1.f / 512.f) + RMS_EPS);
#pragma unroll
    for (int q = 0; q < 2; ++q) { const f32x4 v = q ? bq : a; const f32x4 g = ((const f32x4*)F.g_gla_out)[lane + 64 * q];
        const v2u rw = *(const v2u*)(Z + (size_t)t * ZW + ZGR + h * 512 + 4 * lane + 256 * q);
        const float r0 = blo(rw.x), r1 = bhi(rw.x), r2 = blo(rw.y), r3 = bhi(rw.y);
        v2u w; w.x = pk2(v.x * rs * g.x * (r0 * sigm(r0)), v.y * rs * g.y * (r1 * sigm(r1))); w.y = pk2(v.z * rs * g.z * (r2 * sigm(r2)), v.w * rs * g.w * (r3 * sigm(r3)));
        *(v2u*)(OG + (size_t)t * 2048 + h * 512 + 4 * lane + 256 * q) = w; }
}
DI int pi_key(int r) { return (r & ~12) | ((r & 4) << 1) | ((r & 8) >> 1); }

constexpr int KB_PITCH = 272, VB_PITCH = 144, KB_BYTES = 64 * KB_PITCH, KV_BUF = KB_BYTES + 128 * VB_PITCH;
constexpr int NSA_X = 2 * KV_BUF;
constexpr int NSA_IMPR = KV_BUF  , NSA_MSK = NSA_X + 69632, NSA_END = NSA_MSK + 256;
static_assert(NSA_END <= LDS_BYTES, "NSA LDS map");
struct TileRegs { v4u k[2], v[2]; };
DI void tile_gload(TileRegs& R, const bf16* kg, size_t kpitch, const bf16* vg, size_t vpitch, int tid) {
#pragma unroll
    for (int j = 0; j < 2; ++j) { const int c = tid + 512 * j;
        R.k[j] = *(const v4u*)(kg + (size_t)(c >> 4) * kpitch + (c & 15) * 8); R.v[j] = *(const v4u*)(vg + (size_t)(c >> 3) * vpitch + (c & 7) * 8); }
}
DI void tile_sstore(const TileRegs& R, LAS unsigned char* buf, int tid) {
#pragma unroll
    for (int j = 0; j < 2; ++j) { const int c = tid + 512 * j;
        *(LAS v4u*)(buf + (c >> 4) * KB_PITCH + (c & 15) * 16) = R.k[j]; *(LAS v4u*)(buf + KB_BYTES + (c >> 3) * VB_PITCH + (c & 7) * 16) = R.v[j]; }
}
DI void qk_lds(f32x16& x0, f32x16& x1, const LAS unsigned char* kb, const bf16x8 (&qf)[8]) {
#pragma unroll
    for (int i = 0; i < 16; ++i) { x0[i] = 0.f; x1[i] = 0.f; }
#pragma unroll
    for (int s = 0; s < 8; ++s) { const bf16x8 a0 = *(const LAS bf16x8*)(kb + 32 * s); const bf16x8 a1 = *(const LAS bf16x8*)(kb + 32 * KB_PITCH + 32 * s);
        x0 = MFMA32(a0, qf[s], x0); x1 = MFMA32(a1, qf[s], x1); }
}
DI void pv_lds(f32x16 (&o)[4], const f32x16& p0, const f32x16& p1, const LAS unsigned char* vb) {
#pragma unroll
    for (int mt = 0; mt < 2; ++mt)
#pragma unroll
        for (int s2 = 0; s2 < 2; ++s2) { const f32x16& p = mt ? p1 : p0;
            const bf16x8 pf = pack8(p[8 * s2], p[8 * s2 + 1], p[8 * s2 + 2], p[8 * s2 + 3], p[8 * s2 + 4], p[8 * s2 + 5], p[8 * s2 + 6], p[8 * s2 + 7]);
#pragma unroll
            for (int dt = 0; dt < 4; ++dt) { const bf16x8 a = *(const LAS bf16x8*)(vb + (32 * dt) * VB_PITCH + (32 * mt + 16 * s2) * 2); o[dt] = MFMA32(a, pf, o[dt]); } }
}
DI void softmax_step(f32x16& x0, f32x16& x1, float& m, float& l, f32x16 (&o)[4]) {
    float mx = x0[0];
#pragma unroll
    for (int i = 1; i < 16; ++i) mx = fmaxf(mx, x0[i]);
#pragma unroll
    for (int i = 0; i < 16; ++i) mx = fmaxf(mx, x1[i]);
    mx = fmaxf(mx, __shfl_xor(mx, 32));
    const float mnew = fmaxf(m, mx); const float alpha = exp2f(m - mnew); m = mnew;
    float ps = 0.f;
#pragma unroll
    for (int i = 0; i < 16; ++i) { x0[i] = exp2f(x0[i] - mnew); x1[i] = exp2f(x1[i] - mnew); ps += x0[i] + x1[i]; }
    l = l * alpha + ps;
#pragma unroll
    for (int dt = 0; dt < 4; ++dt) o[dt] = o[dt] * alpha;
}

DI void nsa_item(Frame& F, int item) {
    const bf16* Z = (const bf16*)(F.ws + WS_Z);
    const bf16* KC = (const bf16*)(F.ws + WS_KC); const bf16* VCT = (const bf16*)(F.ws + WS_VCT); const bf16* VTS = (const bf16*)(F.ws + WS_VTS); const bf16* VTW = (const bf16*)(F.ws + WS_VTW);
    bf16* ON = (bf16*)(F.ws + WS_ON);
    const int qt = item & 31, hk = (item >> 5) & 3, b = item >> 7;
    int tid = F.tid; asm volatile("" : "+v"(tid));
    const int w = F.wave, lane = tid & 63, r = lane & 31, hh = lane >> 5, g = w >> 1, th = w & 1;
    const int head = hk * 4 + g, tl = 32 * th + r  , t = 64 * qt + tl;
    const size_t trow = (size_t)b * SEQ + t;
    LAS unsigned char* buf0 = F.lds; LAS unsigned char* buf1 = F.lds + KV_BUF;
    LAS float* part = (LAS float*)(F.lds + NSA_X);
    LAS unsigned* oacc = (LAS unsigned*)(F.lds + NSA_X);
    LAS float* impr = (LAS float*)(F.lds + NSA_IMPR);
    LAS unsigned* msk = (LAS unsigned*)(F.lds + NSA_MSK);
    constexpr float CS = 0.08838834764831845f * 1.4426950408889634f;
    int kboff = pi_key(r) * KB_PITCH + 16 * hh, vboff = KB_BYTES + r * VB_PITCH + 16 * hh;
    LAS unsigned* oacc_l = oacc + w * 2048 + lane;
    asm volatile("" : "+v"(kboff), "+v"(vboff), "+v"(oacc_l));
    const int nsel = qt + 1, wlo = qt > 8 ? qt - 8 : 0, ntile = nsel + (qt - wlo + 1);
    const bf16* ksel = Z + (size_t)b * SEQ * ZW + ZNKV + 2 * 512 + hk * 128; const bf16* kwin = ksel + 2 * 512;
    const bf16* vsel = VTS + ((size_t)b * 4 + hk) * 128 * SEQ; const bf16* vwin = VTW + ((size_t)b * 4 + hk) * 128 * SEQ;
    TileRegs R;
    {
        const bf16* kc = KC + ((size_t)b * 4 + hk) * 128 * 128; const bf16* vc = VCT + ((size_t)b * 4 + hk) * 128 * 128;
        TileRegs R1; tile_gload(R, kc, 128, vc, 128, tid); tile_gload(R1, kc + 64 * 128, 128, vc + 64, 128, tid);
        for (int e = tid; e < 17408; e += 512) part[e] = 0.f;
        if (tid < 64) msk[tid] = 0u;
        tile_sstore(R, buf0, tid); tile_sstore(R1, buf1, tid);
    }
    bf16x8 qf[8];
    { const bf16* qp = Z + trow * ZW + ZNQ + head * 128 + 8 * hh;
#pragma unroll
      for (int s = 0; s < 8; ++s) qf[s] = *(const bf16x8*)(qp + 16 * s); }
    const float gate_c = sigm(bf2f(Z[trow * ZW + ZNG + head])), gate_s = sigm(bf2f(Z[trow * ZW + ZNG + 16 + head])), gate_w = sigm(bf2f(Z[trow * ZW + ZNG + 32 + head]));
    tile_gload(R, ksel, ZW, vsel, SEQ, tid);
    f32x16 o[4];
#pragma unroll
    for (int dt = 0; dt < 4; ++dt)
#pragma unroll
        for (int i = 0; i < 16; ++i) o[dt][i] = 0.f;
    __syncthreads();
    {
        const int cmax = (t - 31) >> 4;
        float mx = -1e30f, ps = 0.f;
#pragma unroll 1
        for (int T = 0; T < 2; ++T) { f32x16 x0, x1; qk_lds(x0, x1, (T ? buf1 : buf0) + kboff, qf); float mm = -1e30f;
#pragma unroll
            for (int i = 0; i < 16; ++i) { const int cb = 64 * T + 16 * (i >> 3) + 8 * hh + (i & 7);
                x0[i] = (cb <= cmax) ? x0[i] * CS : -INFINITY; x1[i] = (cb + 32 <= cmax) ? x1[i] * CS : -INFINITY; mm = fmaxf(mm, fmaxf(x0[i], x1[i])); }
            mm = fmaxf(mm, __shfl_xor(mm, 32));
            const float mnew = fmaxf(mx, mm); float s = 0.f;
#pragma unroll
            for (int i = 0; i < 16; ++i) s += exp2f(x0[i] - mnew) + exp2f(x1[i] - mnew);
            ps = ps * exp2f(mx - mnew) + s; mx = mnew; }
        ps += __shfl_xor(ps, 32);
        const float inv = ps > 0.f ? 1.0f / ps : 0.f;
        LAS float* prow = part + ((size_t)(g * 64 + tl) * 34) * 2;
        asm volatile("" : "+v"(prow));
#pragma unroll 1
        for (int T = 0; T < 2; ++T) { f32x16 x0, x1; qk_lds(x0, x1, (T ? buf1 : buf0) + kboff, qf);
#pragma unroll
            for (int i = 0; i < 16; ++i) { const int cb = 64 * T + 16 * (i >> 3) + 8 * hh + (i & 7);
                const float s0 = (cb <= cmax) ? x0[i] * CS : -INFINITY, s1 = (cb + 32 <= cmax) ? x1[i] * CS : -INFINITY; x0[i] = exp2f(s0 - mx) * inv; x1[i] = exp2f(s1 - mx) * inv; }
#pragma unroll
            for (int mt = 0; mt < 2; ++mt)
#pragma unroll
                for (int s2 = 0; s2 < 2; ++s2) { const f32x16& p = mt ? x1 : x0;
                    const int n0 = 16 * T + 8 * mt + 4 * s2 + 2 * hh;
                    const float A = (p[8 * s2] + p[8 * s2 + 1]) + (p[8 * s2 + 2] + 0.5f * p[8 * s2 + 3]);
                    const float Bv = (0.5f * p[8 * s2 + 3] + p[8 * s2 + 4]) + (p[8 * s2 + 5] + p[8 * s2 + 6]) + 0.5f * p[8 * s2 + 7];
                    const float Cv = 0.5f * p[8 * s2 + 7];
                    prow[(n0) * 2] = A; prow[(n0 + 1) * 2] = Bv; prow[(n0 + 2) * 2 + 1] = Cv; }
            pv_lds(o, x0, x1, (T ? buf1 : buf0) + vboff); }
#pragma unroll
        for (int dt = 0; dt < 4; ++dt) o[dt] = o[dt] * gate_c;
    }
    __syncthreads();
    tile_sstore(R, buf0, tid);
#pragma unroll
    for (int k4 = 0; k4 < 4; ++k4) { const int e = tid + 512 * k4, tok = e >> 5, n = e & 31; float s = 0.f;
#pragma unroll
        for (int gg = 0; gg < 4; ++gg) { const LAS float* pp = part + ((size_t)(gg * 64 + tok) * 34 + n) * 2; s += pp[0] + pp[1]; }
        impr[tok * 33 + n] = s; }
    __syncthreads();
    if (qt < 16) { if (tid < 64) msk[tid] = (2u << qt) - 1u; }
    else {
#pragma unroll
        for (int k4 = 0; k4 < 4; ++k4) { const int e = tid + 512 * k4, tok = e >> 5, n = e & 31;
            if (n == 0) __hip_atomic_fetch_or(&msk[tok], 1u | (1u << qt) | (1u << (qt - 1)), __ATOMIC_RELAXED, __HIP_MEMORY_SCOPE_WORKGROUP);
            else if (n <= qt - 2) { const float v = impr[tok * 33 + n]; int rank = 0;
                for (int m2 = 1; m2 <= qt - 2; ++m2) { const float u = impr[tok * 33 + m2]; rank += (u > v || (u == v && m2 < n)) ? 1 : 0; }
                if (rank < 13) __hip_atomic_fetch_or(&msk[tok], 1u << n, __ATOMIC_RELAXED, __HIP_MEMORY_SCOPE_WORKGROUP); } }
    }
    __syncthreads();
    const unsigned mymask = msk[tl];
#pragma unroll
    for (int dt = 0; dt < 4; ++dt)
#pragma unroll
        for (int i = 0; i < 16; i += 2) oacc_l[(dt * 8 + (i >> 1)) * 64] = pk2(o[dt][i], o[dt][i + 1]);
#pragma unroll
    for (int dt = 0; dt < 4; ++dt)
#pragma unroll
        for (int i = 0; i < 16; ++i) o[dt][i] = 0.f;
    float m = -1e30f, l = 0.f;
    for (int i = 0; i < ntile; ++i) {
        if (i + 1 < ntile) { const int i1 = i + 1; const bool br = i1 >= nsel; const int n1 = br ? wlo + (i1 - nsel) : i1;
            tile_gload(R, (br ? kwin : ksel) + (size_t)(64 * n1) * ZW, ZW, (br ? vwin : vsel) + 64 * n1, SEQ, tid); }
        if (i == nsel) {
            l += __shfl_xor(l, 32);
            const float f = l > 0.f ? gate_s / l : 0.f;
#pragma unroll
            for (int dt = 0; dt < 4; ++dt)
#pragma unroll
                for (int i2 = 0; i2 < 16; i2 += 2) { LAS unsigned* ap = oacc_l + (dt * 8 + (i2 >> 1)) * 64; const unsigned pw = *ap;
                    *ap = pk2(blo(pw) + f * o[dt][i2], bhi(pw) + f * o[dt][i2 + 1]); o[dt][i2] = 0.f; o[dt][i2 + 1] = 0.f; }
            m = -1e30f; l = 0.f;
        }
        const bool win = i >= nsel; const int n = win ? wlo + (i - nsel) : i;
        LAS unsigned char* bufc = (i & 1) ? buf1 : buf0;
        f32x16 x0, x1; qk_lds(x0, x1, bufc + kboff, qf);
        const int lim = t - 64 * n;
        const bool rowok = win ? true : (((mymask >> n) & 1u) != 0u);
        const int lo_lim = win ? lim - 512 : -100000;
#pragma unroll
        for (int i2 = 0; i2 < 16; ++i2) { const int kk = 16 * (i2 >> 3) + 8 * hh + (i2 & 7);
            x0[i2] = (rowok && kk <= lim && kk > lo_lim) ? x0[i2] * CS : -INFINITY; x1[i2] = (rowok && kk + 32 <= lim && kk + 32 > lo_lim) ? x1[i2] * CS : -INFINITY; }
        softmax_step(x0, x1, m, l, o);
        pv_lds(o, x0, x1, bufc + vboff);
        if (i + 1 < ntile) tile_sstore(R, (i & 1) ? buf0 : buf1, tid);
        __syncthreads();
    }
    {
        l += __shfl_xor(l, 32);
        const float f = l > 0.f ? gate_w / l : 0.f;
        bf16* op = ON + trow * 2048 + head * 128 + 4 * hh;
#pragma unroll
        for (int dt = 0; dt < 4; ++dt)
#pragma unroll
            for (int a4 = 0; a4 < 4; ++a4) { const unsigned p0 = oacc_l[(dt * 8 + 2 * a4) * 64], p1 = oacc_l[(dt * 8 + 2 * a4 + 1) * 64];
                v2u wv; wv.x = pk2(blo(p0) + f * o[dt][4 * a4], bhi(p0) + f * o[dt][4 * a4 + 1]); wv.y = pk2(blo(p1) + f * o[dt][4 * a4 + 2], bhi(p1) + f * o[dt][4 * a4 + 3]);
                *(v2u*)(op + 32 * dt + 8 * a4) = wv; }
    }
    __syncthreads();
}
DI void p4_nsa(Frame& F) {
    const int gw = F.bid * 8 + F.wave, NGW = F.G * 8;
    for (int rh = gw; rh < MTOK * 4; rh += NGW) gla_out_row(F, rh);
    __syncthreads();
    for (int it = F.bid; it < 256; it += F.G) {
        const int bhk = it >> 4, q = it & 15;
#pragma unroll 1
        for (int k2 = 0; k2 < 2; ++k2) nsa_item(F, bhk * 32 + (k2 ? q : 31 - q));
    }
}

#ifndef MK_N_LAUNCHES
#define MK_N_LAUNCHES 1
#endif
constexpr int N_PHASES = 11;
__global__ void __launch_bounds__(512, 2) hybrid_fwd(Args args) {
    extern __shared__ __attribute__((aligned(16))) unsigned char lds_raw[];
    Frame F;
    F.lds = (LAS unsigned char*)lds_raw;
    F.tid = threadIdx.x; F.lane = F.tid & 63; F.wave = __builtin_amdgcn_readfirstlane(F.tid >> 6); F.G = gridDim.x; F.bid = blockIdx.x;
    F.x = args.in[0]; F.g_mix = args.in[1]; F.w_in = args.in[2]; F.w_gla_gate = args.in[3]; F.b_gla_gate = args.in[4]; F.g_gla_out = args.in[5];
    F.pe_k = args.in[6]; F.w_ck1 = args.in[7]; F.w_ck2 = args.in[8]; F.pe_v = args.in[9]; F.w_cv1 = args.in[10]; F.w_cv2 = args.in[11];
    F.w_pg = args.in[12]; F.w_pn = args.in[13]; F.w_out = args.in[14]; F.g_ffn = args.in[15]; F.w_fg = args.in[16]; F.w_fu = args.in[17]; F.w_fd = args.in[18]; F.g_final = args.in[19];
    F.out = args.out; F.ws = args.ws;
    const int lo = args.ph_lo, hi = args.ph_hi;
    typedef pg8::bf16_t pb;
#ifndef PH_MASK
#define PH_MASK 0x7ff
#endif
#define IN(k) (((PH_MASK >> (k)) & 1) && lo <= (k) && (k) < hi)
#define SEAM(k) do { if (IN(k) && IN((k) + 1)) { __threadfence(); cg::this_grid().sync(); } } while (0)
    if (IN(0)) { p0_prologue(F); } SEAM(0);
    if (IN(1)) {
        pg8::Gemm g{(const pb*)(F.ws + WS_BUFA), (const pb*)(F.ws + WS_WINT), MTOK, ZW, DM}; pg8::StaticOrder S; S.init(MTOK, ZW, F.G, F.bid);
        pg8::EpiBf16Plain E{(pb*)(F.ws + WS_Z), ZW};
        pg8::gemm_phase<pg8::EpiBf16Plain, pg8::StaticOrder, true, true>(F.lds, g, S, E);
    } SEAM(1);
    if (IN(2)) { p2_prep(F); } SEAM(2);
    if (IN(3)) { p3_scan(F); } SEAM(3);
    if (IN(4)) { p4_nsa(F); } SEAM(4);
    if (IN(5)) {
        { pg8::Gemm g{(const pb*)(F.ws + WS_BUFB), (const pb*)(F.ws + WS_WPG), MTOK, DM, DM}; pg8::StaticOrder S; S.init(MTOK, DM, F.G, F.bid);
          pg8::EpiGate<false> E{(pb*)(F.ws + WS_BUFA), (const pb*)(F.ws + WS_Z) + ZMG, DM, ZW};
          pg8::gemm_phase<pg8::EpiGate<false>, pg8::StaticOrder, true, true>(F.lds, g, S, E); }
        { pg8::Gemm g{(const pb*)(F.ws + WS_ON), (const pb*)(F.ws + WS_WPN), MTOK, DM, DM}; pg8::StaticOrder S; S.init(MTOK, DM, F.G, F.bid);
          pg8::EpiGate<true> E{(pb*)(F.ws + WS_BUFA), (const pb*)(F.ws + WS_Z) + ZMG + 2048, DM, ZW};
          pg8::gemm_phase<pg8::EpiGate<true>, pg8::StaticOrder, true, true>(F.lds, g, S, E); }
    } SEAM(5);
    if (IN(6)) {
        pg8::Gemm g{(const pb*)(F.ws + WS_BUFA), (const pb*)(F.ws + WS_WOUT), MTOK, DM, DM}; pg8::StaticOrder S; S.init(MTOK, DM, F.G, F.bid);
        pg8::EpiResF32 E{F.x, F.out, DM};
        pg8::gemm_phase<pg8::EpiResF32, pg8::StaticOrder, true, true>(F.lds, g, S, E);
    } SEAM(6);
    if (IN(7)) { p7_norm_ffnw(F); } SEAM(7);
    if (IN(8)) {
        pg8::Gemm g{(const pb*)(F.ws + WS_BUFB), (const pb*)(F.ws + WS_WGU), MTOK, 2 * DFF, DM}; pg8::StaticOrder S; S.init(MTOK, 2 * DFF, F.G, F.bid);
        pg8::EpiSwiGLU E{(pb*)(F.ws + WS_ACT), DFF};
        pg8::gemm_phase<pg8::EpiSwiGLU, pg8::StaticOrder, true, true>(F.lds, g, S, E);
    } SEAM(8);
    if (IN(9)) {
        pg8::Gemm g{(const pb*)(F.ws + WS_ACT), (const pb*)(F.ws + WS_WD), MTOK, DM, DFF}; pg8::StaticOrder S; S.init(MTOK, DM, F.G, F.bid);
        pg8::EpiResF32 E{F.out, F.out, DM};
        pg8::gemm_phase<pg8::EpiResF32, pg8::StaticOrder, true, true>(F.lds, g, S, E);
    } SEAM(9);
    if (IN(10)) { p10_final(F); }
#undef IN
#undef SEAM
}

extern "C" void kernel_launch(void* const* d_in, const int* in_sizes, int n_in, void* d_out, int out_size, void* d_ws, size_t ws_size, hipStream_t stream) {
    static int grid = 0;
    if (grid == 0) {
        if (n_in != 20 || in_sizes[0] != MTOK * DM || out_size != MTOK * DM || ws_size < WS_END) {
            fprintf(stderr, "kernel_launch: unexpected shapes (n_in %d, in0 %d, out %d, ws %zu < %zu); nothing launched\n", n_in, n_in > 0 ? in_sizes[0] : -1, out_size, ws_size, (size_t)WS_END); grid = -1; return; }
        int dev = 0, cus = 0, per_cu = 0;
        if (hipGetDevice(&dev) != hipSuccess || hipDeviceGetAttribute(&cus, hipDeviceAttributeMultiprocessorCount, dev) != hipSuccess) { grid = -1; return; }
        if (hipFuncSetAttribute((const void*)hybrid_fwd, hipFuncAttributeMaxDynamicSharedMemorySize, LDS_BYTES) != hipSuccess) { fprintf(stderr, "kernel_launch: hipFuncSetAttribute failed\n"); grid = -1; return; }
        if (hipOccupancyMaxActiveBlocksPerMultiprocessor(&per_cu, (const void*)hybrid_fwd, 512, LDS_BYTES) != hipSuccess || per_cu < 1) { fprintf(stderr, "kernel_launch: occupancy query says %d blocks per CU\n", per_cu); per_cu = 1; }
        (void)hipGetLastError();
        grid = cus * (per_cu > 1 ? 1 : per_cu);
    }
    if (grid < 0) return;
    (void)hipMemsetAsync((char*)d_ws + WS_CTL, 0, CTL_ZERO_BYTES, stream);
    Args a{};
    for (int i = 0; i < 20; ++i) a.in[i] = (const float*)d_in[i];
    a.out = (float*)d_out; a.ws = (unsigned char*)d_ws;
#if MK_N_LAUNCHES == 1
    a.ph_lo = 0; a.ph_hi = N_PHASES;
    void* kargs[] = {&a};
    hipError_t e = hipLaunchCooperativeKernel((const void*)hybrid_fwd, dim3(grid), dim3(512), kargs, LDS_BYTES, stream);
    if (e != hipSuccess) fprintf(stderr, "kernel_launch: cooperative launch failed: %s (grid %d)\n", hipGetErrorString(e), grid);
#else
    for (int p = 0; p < N_PHASES; ++p) { a.ph_lo = p; a.ph_hi = p + 1; hipLaunchKernelGGL(hybrid_fwd, dim3(grid), dim3(512), LDS_BYTES, stream, a); }
#endif
}
```

```cpp
#include <hip/hip_runtime.h>
#include <hip/hip_cooperative_groups.h>
#include <cstdio>
#include <cstdint>
namespace cg = cooperative_groups;
#define MK_N_LAUNCHES 1
namespace pg8 {
#define PG8_LAS __attribute__((address_space(3)))
typedef unsigned short bf16_t;
typedef short bf16x8 __attribute__((ext_vector_type(8)));
typedef float f32x4 __attribute__((ext_vector_type(4)));
typedef unsigned u32x4 __attribute__((ext_vector_type(4)));
constexpr int BM = 256, BK = 64, HALF = 128, HTB = HALF * BK * 2  , STAGE_BYTES = 8 * HTB, NXCD = 8, WGM = 8;

__host__ __device__ __forceinline__ int lds_byte(int r, int c) { const int st = (r >> 4) * 2 + (c >> 5), rr = r & 15, cc = c & 31, ob = rr * 64 + cc * 2; return st * 1024 + (ob ^ (((ob >> 9) & 1) << 5)); }
__host__ __device__ __forceinline__ void stage_rc(int b, int& R, int& C) { const int st = b / 1024, sb = b % 1024, swz = sb ^ (((sb >> 9) & 1) << 5); R = (st >> 1) * 16 + swz / 64; C = (st & 1) * 32 + (swz % 64) / 2; }
__host__ __device__ __forceinline__ int perm32(int rho) { const int n = rho >> 4, i = rho & 15; return 8 * (i >> 2) + 4 * n + (i & 3); }

struct Unit { int pm, pn; };
struct Gemm { const bf16_t* A; const bf16_t* Bt; int M, N, K; };

struct StaticOrder {
    int nM, nN, nwg, G, c;
    __host__ __device__ void init(int M, int N, int G_, int c_) { nM = M / BM; nN = N / BM; nwg = nM * nN; G = G_; c = c_; }
    __host__ __device__ bool next(int i, Unit& u) const {
        const long L = (long)i * G + c; if (L >= nwg) return false;
        int wgid = (int)L; { const int q = nwg / NXCD, r = nwg % NXCD, xcd = wgid % NXCD, off = wgid / NXCD; wgid = (xcd < r ? xcd * (q + 1) : r * (q + 1) + (xcd - r) * q) + off; }
        const int nig = WGM * nN, gid = wgid / nig, fm = gid * WGM, gsz = (nM - fm) < WGM ? (nM - fm) : WGM;
        u.pm = fm + ((wgid % nig) % gsz); u.pn = (wgid % nig) / gsz; return true;
    }
    __device__ __forceinline__ void a_ready(const Unit&) const {}
    __device__ __forceinline__ void done(const Unit&) const {}
};

__device__ __forceinline__ unsigned cvt_pk_bf16(float lo, float hi) { unsigned r; asm volatile("v_cvt_pk_bf16_f32 %0, %1, %2" : "=v"(r) : "v"(lo), "v"(hi)); return r; }
__device__ __forceinline__ float bf_lo(unsigned w) { return __uint_as_float(w << 16); }
__device__ __forceinline__ float bf_hi(unsigned w) { return __uint_as_float(w & 0xffff0000u); }
__device__ __forceinline__ float sigmoidf_(float x) { return 1.0f / (1.0f + __expf(-x)); }

struct EpiBf16Plain {
    static constexpr bool PERM = true, AFTER_DRAIN = false;
    bf16_t* O; int ldc;
    __device__ __forceinline__ void operator()(const f32x4 (&acc)[2][2][4][2], const Unit& u, int wr, int wc, int fr, int fq) const {
        const int row0 = u.pm * BM + wr * 64 + fr; const int col0 = u.pn * BM + wc * 32 + 8 * fq;
#pragma unroll
        for (int ai = 0; ai < 2; ++ai)
#pragma unroll
            for (int m = 0; m < 4; ++m) { bf16_t* rowp = O + (size_t)(row0 + ai * HALF + m * 16) * ldc + col0;
#pragma unroll
                for (int bj = 0; bj < 2; ++bj) { const f32x4 v0 = acc[ai][bj][m][0], v1 = acc[ai][bj][m][1];
                    u32x4 w; w.x = cvt_pk_bf16(v0[0], v0[1]); w.y = cvt_pk_bf16(v0[2], v0[3]); w.z = cvt_pk_bf16(v1[0], v1[1]); w.w = cvt_pk_bf16(v1[2], v1[3]);
                    *(u32x4*)(rowp + bj * HALF) = w; } }
    }
};
template <bool ADD> struct EpiGate {
    static constexpr bool PERM = true, AFTER_DRAIN = false;
    bf16_t* O; const bf16_t* G; int ldo, ldg;
    __device__ __forceinline__ void operator()(const f32x4 (&acc)[2][2][4][2], const Unit& u, int wr, int wc, int fr, int fq) const {
        const int row0 = u.pm * BM + wr * 64 + fr; const int col0 = u.pn * BM + wc * 32 + 8 * fq;
#pragma unroll
        for (int ai = 0; ai < 2; ++ai)
#pragma unroll
            for (int m = 0; m < 4; ++m) { const size_t row = (size_t)(row0 + ai * HALF + m * 16);
#pragma unroll
                for (int bj = 0; bj < 2; ++bj) { const f32x4 v0 = acc[ai][bj][m][0], v1 = acc[ai][bj][m][1];
                    const u32x4 gw = *(const u32x4*)(G + row * ldg + col0 + bj * HALF);
                    float r[8];
                    r[0] = sigmoidf_(bf_lo(gw.x)) * v0[0]; r[1] = sigmoidf_(bf_hi(gw.x)) * v0[1]; r[2] = sigmoidf_(bf_lo(gw.y)) * v0[2]; r[3] = sigmoidf_(bf_hi(gw.y)) * v0[3];
                    r[4] = sigmoidf_(bf_lo(gw.z)) * v1[0]; r[5] = sigmoidf_(bf_hi(gw.z)) * v1[1]; r[6] = sigmoidf_(bf_lo(gw.w)) * v1[2]; r[7] = sigmoidf_(bf_hi(gw.w)) * v1[3];
                    bf16_t* op = O + row * ldo + col0 + bj * HALF;
                    if (ADD) { const u32x4 pw = *(const u32x4*)op;
                        r[0] += bf_lo(pw.x); r[1] += bf_hi(pw.x); r[2] += bf_lo(pw.y); r[3] += bf_hi(pw.y); r[4] += bf_lo(pw.z); r[5] += bf_hi(pw.z); r[6] += bf_lo(pw.w); r[7] += bf_hi(pw.w); }
                    u32x4 w; w.x = cvt_pk_bf16(r[0], r[1]); w.y = cvt_pk_bf16(r[2], r[3]); w.z = cvt_pk_bf16(r[4], r[5]); w.w = cvt_pk_bf16(r[6], r[7]);
                    *(u32x4*)op = w; } }
    }
};
struct EpiSwiGLU {
    static constexpr bool PERM = true, AFTER_DRAIN = false;
    bf16_t* O; int ldo;
    __device__ __forceinline__ void operator()(const f32x4 (&acc)[2][2][4][2], const Unit& u, int wr, int wc, int fr, int fq) const {
        const int row0 = u.pm * BM + wr * 64 + fr; const int col0 = u.pn * HALF + wc * 32 + 8 * fq;
#pragma unroll
        for (int ai = 0; ai < 2; ++ai)
#pragma unroll
            for (int m = 0; m < 4; ++m) { const size_t row = (size_t)(row0 + ai * HALF + m * 16);
                const f32x4 g0 = acc[ai][0][m][0], g1 = acc[ai][0][m][1], u0 = acc[ai][1][m][0], u1 = acc[ai][1][m][1];
                float r[8];
#pragma unroll
                for (int e = 0; e < 4; ++e) { r[e] = g0[e] * sigmoidf_(g0[e]) * u0[e]; r[4 + e] = g1[e] * sigmoidf_(g1[e]) * u1[e]; }
                u32x4 w; w.x = cvt_pk_bf16(r[0], r[1]); w.y = cvt_pk_bf16(r[2], r[3]); w.z = cvt_pk_bf16(r[4], r[5]); w.w = cvt_pk_bf16(r[6], r[7]);
                *(u32x4*)(O + row * ldo + col0) = w; }
    }
};
struct EpiResF32 {
    static constexpr bool PERM = false, AFTER_DRAIN = false;
    const float* base; float* out; int ldc;
    __device__ __forceinline__ void operator()(const f32x4 (&acc)[2][2][4][2], const Unit& u, int wr, int wc, int fr, int fq) const {
        const int row0 = u.pm * BM + wr * 64 + fr, col0 = u.pn * BM + wc * 32 + 4 * fq;
#pragma unroll
        for (int ai = 0; ai < 2; ++ai)
#pragma unroll
            for (int m = 0; m < 4; ++m) { const size_t off = (size_t)(row0 + ai * HALF + m * 16) * ldc + col0;
#pragma unroll
                for (int bj = 0; bj < 2; ++bj)
#pragma unroll
                    for (int n = 0; n < 2; ++n) { const f32x4 bs = *(const f32x4*)(base + off + bj * HALF + n * 16); *(f32x4*)(out + off + bj * HALF + n * 16) = bs + acc[ai][bj][m][n]; } }
    }
};
template <class Epi, class Sched, bool ALIGN_EPI = false, bool SP2 = false>
__device__ __forceinline__ void gemm_phase(PG8_LAS unsigned char* lds, const Gemm g, const Sched& S, const Epi& E) {
    const int tid = threadIdx.x, wid = __builtin_amdgcn_readfirstlane(tid >> 6), lane = tid & 63, wr = wid >> 2, wc = wid & 3, fr = lane & 15, fq = lane >> 4;
    const int K = g.K, nt = K / BK;
    unsigned voffA[2], voffB[2];
#pragma unroll
    for (int i = 0; i < 2; ++i) { int R, C; stage_rc(tid * 16 + i * 8192, R, C); const int Rb = Epi::PERM ? ((R & ~31) + perm32(R & 31)) : R;
        voffA[i] = (unsigned)(R * K + C) * 2u; voffB[i] = (unsigned)(Rb * K + C) * 2u; }
    const size_t kstep = (size_t)(BK * 2);
    const size_t hstep = (size_t)HALF * K * 2;
    const size_t tstep = 2 * hstep;
    const unsigned ldsw = (unsigned)wid * 1024u;
    const int aoff = lds_byte(wr * 64 + fr, fq * 8), boff = lds_byte(wc * 32 + fr, fq * 8);
#define PG8_SA(b, h) (((b) * 2 + (h)) * HTB)
#define PG8_SB(b, h) ((4 + (b) * 2 + (h)) * HTB)
#define PG8_STAGE(bufoff, gbase, voff) do { _Pragma("unroll") for (int _i = 0; _i < 2; ++_i) \
        __builtin_amdgcn_global_load_lds((const unsigned*)((const char*)(gbase) + (voff)[_i]), (PG8_LAS unsigned*)(lds + (bufoff) + ldsw + _i * 8192), 16, 0, 0); } while (0)
#define PG8_LDA(dst, b, h) do { _Pragma("unroll") for (int m = 0; m < 4; ++m) _Pragma("unroll") for (int k = 0; k < 2; ++k) dst[m][k] = *(const PG8_LAS bf16x8*)(lds + PG8_SA(b, h) + aoff + m * 2048 + k * 1024); } while (0)
#define PG8_LDB(dst, b, h) do { _Pragma("unroll") for (int n = 0; n < 2; ++n) _Pragma("unroll") for (int k = 0; k < 2; ++k) dst[n][k] = *(const PG8_LAS bf16x8*)(lds + PG8_SB(b, h) + boff + n * 2048 + k * 1024); } while (0)
#define PG8_MMA(ai, bj, At, Bt) do { __builtin_amdgcn_s_setprio(1); _Pragma("unroll") for (int m = 0; m < 4; ++m) _Pragma("unroll") for (int n = 0; n < 2; ++n) _Pragma("unroll") for (int k = 0; k < 2; ++k) \
        acc[ai][bj][m][n] = __builtin_amdgcn_mfma_f32_16x16x32_bf16(Bt[n][k], At[m][k], acc[ai][bj][m][n], 0, 0, 0); __builtin_amdgcn_s_setprio(0); } while (0)
#define PG8_WAIT_V(n) asm volatile("s_waitcnt vmcnt(" #n ")" ::: "memory")
#define PG8_WAIT_L(n) asm volatile("s_waitcnt lgkmcnt(" #n ")" ::: "memory")
#define PG8_BAR __builtin_amdgcn_s_barrier()
#define PG8_SCHED __builtin_amdgcn_sched_barrier(0)
    Unit cur, nxt; int ui = 0;
    if (!S.next(0, cur)) return;
    f32x4 acc[2][2][4][2];
#pragma unroll
    for (int a = 0; a < 2; ++a)
#pragma unroll
        for (int b = 0; b < 2; ++b)
#pragma unroll
            for (int m = 0; m < 4; ++m)
#pragma unroll
                for (int n = 0; n < 2; ++n) acc[a][b][m][n] = (f32x4){0.f, 0.f, 0.f, 0.f};
    bf16x8 At[4][2], B0[2][2], B1[2][2];
    const char* cA = (const char*)g.A + (size_t)cur.pm * tstep; const char* cB = (const char*)g.Bt + (size_t)cur.pn * tstep;
    S.a_ready(cur);
    if constexpr (SP2) {
        PG8_STAGE(PG8_SB(0, 0), cB, voffB); PG8_STAGE(PG8_SB(0, 1), cB + hstep, voffB); PG8_STAGE(PG8_SA(0, 0), cA, voffA); PG8_STAGE(PG8_SA(0, 1), cA + hstep, voffA);
        if (wr == 1) PG8_BAR;
        PG8_WAIT_V(2); PG8_BAR;
        PG8_STAGE(PG8_SB(1, 0), cB + kstep, voffB); PG8_STAGE(PG8_SA(1, 0), cA + kstep, voffA); PG8_STAGE(PG8_SB(1, 1), cB + hstep + kstep, voffB);
        PG8_WAIT_V(6); PG8_BAR;
    } else {
        PG8_STAGE(PG8_SB(0, 0), cB, voffB); PG8_STAGE(PG8_SA(0, 0), cA, voffA); PG8_STAGE(PG8_SB(0, 1), cB + hstep, voffB); PG8_STAGE(PG8_SA(0, 1), cA + hstep, voffA);
        if (wr == 1) PG8_BAR;
        PG8_WAIT_V(4); PG8_BAR;
        PG8_STAGE(PG8_SB(1, 0), cB + kstep, voffB); PG8_STAGE(PG8_SA(1, 0), cA + kstep, voffA); PG8_STAGE(PG8_SB(1, 1), cB + hstep + kstep, voffB);
        PG8_WAIT_V(6); PG8_BAR;
    }
    for (;;) {
        const bool has_next = S.next(ui + 1, nxt);
        const char* nA = has_next ? (const char*)g.A + (size_t)nxt.pm * tstep : cA; const char* nB = has_next ? (const char*)g.Bt + (size_t)nxt.pn * tstep : cB;
        for (int t = 0; t < nt; t += 2) {
            const bool last = (t == nt - 2);
            const char* a1 = cA + (size_t)(t + 1) * kstep;
            const char* a2 = last ? nA : cA + (size_t)(t + 2) * kstep; const char* b2 = last ? nB : cB + (size_t)(t + 2) * kstep;
            const char* a3 = a2 + kstep; const char* b3 = b2 + kstep;
            if (last && has_next) S.a_ready(nxt);
            if constexpr (SP2) {
            PG8_LDB(B0, 0, 0); PG8_LDB(B1, 0, 1); PG8_SCHED; PG8_LDA(At, 0, 0); PG8_STAGE(PG8_SA(1, 1), a1 + hstep, voffA);
            PG8_WAIT_V(8); PG8_WAIT_L(0); PG8_BAR; PG8_MMA(0, 0, At, B0); PG8_MMA(0, 1, At, B1); PG8_BAR; PG8_SCHED;
            PG8_LDA(At, 0, 1); PG8_STAGE(PG8_SB(0, 0), b2, voffB); PG8_STAGE(PG8_SB(0, 1), b2 + hstep, voffB); PG8_STAGE(PG8_SA(0, 0), a2, voffA);
            PG8_WAIT_V(8); PG8_WAIT_L(0); PG8_BAR; PG8_MMA(1, 0, At, B0); PG8_MMA(1, 1, At, B1); PG8_BAR; PG8_SCHED;
            PG8_LDB(B0, 1, 0); PG8_LDB(B1, 1, 1); PG8_SCHED; PG8_LDA(At, 1, 0); PG8_STAGE(PG8_SA(0, 1), a2 + hstep, voffA);
            PG8_WAIT_V(8); PG8_WAIT_L(0); PG8_BAR; PG8_MMA(0, 0, At, B0); PG8_MMA(0, 1, At, B1); PG8_BAR; PG8_SCHED;
            PG8_LDA(At, 1, 1); PG8_STAGE(PG8_SB(1, 0), b3, voffB); PG8_STAGE(PG8_SB(1, 1), b3 + hstep, voffB); PG8_STAGE(PG8_SA(1, 0), a3, voffA);
            PG8_WAIT_V(8); PG8_WAIT_L(0); PG8_BAR; PG8_MMA(1, 0, At, B0); PG8_MMA(1, 1, At, B1); PG8_BAR; PG8_SCHED;
            } else {
            PG8_LDB(B0, 0, 0); PG8_SCHED; PG8_LDA(At, 0, 0); PG8_STAGE(PG8_SA(1, 1), a1 + hstep, voffA);
            PG8_WAIT_L(8); PG8_BAR; PG8_WAIT_L(0); PG8_MMA(0, 0, At, B0); PG8_BAR; PG8_SCHED;
            PG8_LDB(B1, 0, 1); PG8_STAGE(PG8_SB(0, 0), b2, voffB);
            PG8_BAR; PG8_WAIT_L(0); PG8_MMA(0, 1, At, B1); PG8_BAR;
            PG8_LDA(At, 0, 1); PG8_STAGE(PG8_SA(0, 0), a2, voffA);
            PG8_BAR; PG8_WAIT_L(0); PG8_MMA(1, 0, At, B0); PG8_BAR; PG8_SCHED;
            PG8_STAGE(PG8_SB(0, 1), b2 + hstep, voffB);
            PG8_WAIT_V(6); PG8_BAR; PG8_MMA(1, 1, At, B1); PG8_BAR;
            PG8_LDB(B0, 1, 0); PG8_SCHED; PG8_LDA(At, 1, 0); PG8_STAGE(PG8_SA(0, 1), a2 + hstep, voffA);
            PG8_WAIT_L(8); PG8_BAR; PG8_WAIT_L(0); PG8_MMA(0, 0, At, B0); PG8_BAR; PG8_SCHED;
            PG8_LDB(B1, 1, 1); PG8_STAGE(PG8_SB(1, 0), b3, voffB);
            PG8_BAR; PG8_WAIT_L(0); PG8_MMA(0, 1, At, B1); PG8_BAR;
            PG8_LDA(At, 1, 1); PG8_STAGE(PG8_SA(1, 0), a3, voffA);
            PG8_BAR; PG8_WAIT_L(0); PG8_MMA(1, 0, At, B0); PG8_BAR; PG8_SCHED;
            PG8_STAGE(PG8_SB(1, 1), b3 + hstep, voffB);
            PG8_WAIT_V(6); PG8_BAR; PG8_MMA(1, 1, At, B1); PG8_BAR;
            }
        }
        if constexpr (ALIGN_EPI) { if (wr == 0) PG8_BAR; }
        if constexpr (!Epi::AFTER_DRAIN) { E(acc, cur, wr, wc, fr, fq); S.done(cur); }
        if (!has_next) break;
#pragma unroll
        for (int a = 0; a < 2; ++a)
#pragma unroll
            for (int b = 0; b < 2; ++b)
#pragma unroll
                for (int m = 0; m < 4; ++m)
#pragma unroll
                    for (int n = 0; n < 2; ++n) acc[a][b][m][n] = (f32x4){0.f, 0.f, 0.f, 0.f};
        cur = nxt; cA = nA; cB = nB; ++ui;
        if constexpr (ALIGN_EPI) { if (wr == 1) PG8_BAR; }
    }
    PG8_WAIT_V(0);
    if constexpr (!ALIGN_EPI) { if (wr == 0) PG8_BAR; }
    PG8_BAR;
    if constexpr (Epi::AFTER_DRAIN) { E.fused(acc, cur, wr, wc, fr, fq, lds, wid, lane); S.done(cur); }
#undef PG8_SA
#undef PG8_SB
#undef PG8_STAGE
#undef PG8_LDA
#undef PG8_LDB
#undef PG8_MMA
#undef PG8_WAIT_V
#undef PG8_WAIT_L
#undef PG8_BAR
#undef PG8_SCHED
}
}

constexpr int NB = 4, SEQ = 2048, DM = 2048, MTOK = NB * SEQ;
constexpr int INW = 15424, DFF = 5632;
constexpr int ZW = 15616;
constexpr int ZGQ = 0, ZGK = 1024, ZGV = 2048, ZGR = 4096, ZNQ = 6144, ZNKV = 8192, ZMG = 11264, ZGLR = 15360, ZNG = 15376;
constexpr float RMS_EPS = 1e-6f;
constexpr size_t MiB = 1u << 20;
constexpr size_t WS_CTL = 0, CTL_ZERO_BYTES = 1 * MiB;
constexpr size_t WS_BIAS1 = 4096;
constexpr size_t WS_WINT = 1 * MiB, WS_WPG = 62 * MiB, WS_WPN = 70 * MiB, WS_WOUT = 78 * MiB, WS_W1T = 86 * MiB, WS_W2T = 90 * MiB;
constexpr size_t WS_KC = 91 * MiB, WS_VCT = 91 * MiB + 512 * 1024, WS_DECAY = 92 * MiB, WS_VTS = 93 * MiB, WS_VTW = 101 * MiB, WS_ATT = 109 * MiB;
constexpr size_t WS_QD = 113 * MiB, WS_KET = 129 * MiB, WS_ON = 113 * MiB  ;
constexpr size_t WS_BUFA = 145 * MiB  , WS_BUFB = 177 * MiB  , WS_Z = 209 * MiB;
constexpr size_t WS_WGU = 209 * MiB, WS_WD = 253 * MiB, WS_ACT = 275 * MiB  ;
constexpr size_t WS_END = 453 * MiB;
constexpr int LDS_BYTES = 147456;

#define LAS __attribute__((address_space(3)))
#define DI __device__ __forceinline__
typedef unsigned short bf16;
typedef unsigned v4u __attribute__((ext_vector_type(4)));
typedef unsigned v2u __attribute__((ext_vector_type(2)));
typedef float f32x4 __attribute__((ext_vector_type(4)));
typedef float f32x16 __attribute__((ext_vector_type(16)));
typedef short bf16x8 __attribute__((ext_vector_type(8)));
typedef float f32x2_t __attribute__((ext_vector_type(2)));
typedef __bf16 bf16x2_t __attribute__((ext_vector_type(2)));
#define MFMA32(a, b, c) __builtin_amdgcn_mfma_f32_32x32x16_bf16((a), (b), (c), 0, 0, 0)
#define MFMA16(a, b, c) __builtin_amdgcn_mfma_f32_16x16x32_bf16((a), (b), (c), 0, 0, 0)
#define LDS_WAIT() asm volatile("s_waitcnt lgkmcnt(0)" ::: "memory")

DI unsigned f2bf(float f) { unsigned u = __builtin_bit_cast(unsigned, f); return (u + 0x7fffu + ((u >> 16) & 1u)) >> 16; }
DI unsigned pk2(float lo, float hi) { f32x2_t v = {lo, hi}; bf16x2_t b = __builtin_convertvector(v, bf16x2_t); return __builtin_bit_cast(unsigned, b); }
DI float bf2f(bf16 b) { return __uint_as_float(((unsigned)b) << 16); }
DI float blo(unsigned w) { return __uint_as_float(w << 16); }
DI float bhi(unsigned w) { return __uint_as_float(w & 0xffff0000u); }
DI float sigm(float x) { return 1.0f / (1.0f + __expf(-x)); }
DI float wave_sum(float v) {
#pragma unroll
    for (int o = 1; o < 64; o <<= 1) v += __shfl_xor(v, o);
    return v;
}
DI bf16x8 pack8(float a0, float a1, float a2, float a3, float a4, float a5, float a6, float a7) {
    v4u p; p.x = pk2(a0, a1); p.y = pk2(a2, a3); p.z = pk2(a4, a5); p.w = pk2(a6, a7); return __builtin_bit_cast(bf16x8, p);
}

struct Args {
    const float* in[20]; float* out; unsigned char* ws; int ph_lo, ph_hi;
};
struct Frame {
    LAS unsigned char* lds; int tid, lane, wave, G, bid;
    const float* x; const float* g_mix; const float* w_in; const float* w_gla_gate; const float* b_gla_gate; const float* g_gla_out;
    const float* pe_k; const float* w_ck1; const float* w_ck2; const float* pe_v; const float* w_cv1; const float* w_cv2;
    const float* w_pg; const float* w_pn; const float* w_out; const float* g_ffn; const float* w_fg; const float* w_fu; const float* w_fd; const float* g_final;
    float* out; unsigned char* ws;
};

struct MapId { DI int operator()(int n) const { return n; } };
struct MapOff { int off; DI int operator()(int n) const { return n + off; } };
struct MapWin { DI int operator()(int n) const {
    if (n < 6144) return n; if (n < 6160) return ZGLR + (n - 6144); if (n < 8208) return ZNQ + (n - 6160);
    if (n < 11280) return ZNKV + (n - 8208); if (n < 11328) return ZNG + (n - 11280); return ZMG + (n - 11328); } };
struct MapGU { int up; DI int operator()(int n) const { return (n >> 7) * 256 + up * 128 + (n & 127); } };

template <class Map>
DI void transpose_item(const float* __restrict__ W, int N, bf16* __restrict__ WT, int Kp, LAS float* scr, int item, int lane, const Map map) {
    const int nblk = N / 32, kb = item / nblk, nb = item - kb * nblk, k0 = 64 * kb, n0 = 32 * nb;
#pragma unroll 8
    for (int i = 0; i < 32; ++i) { const int kk = 2 * i + (lane >> 5); scr[kk * 33 + (lane & 31)] = W[(size_t)(k0 + kk) * N + n0 + (lane & 31)]; }
    LDS_WAIT();
    const int c = lane & 7;
#pragma unroll
    for (int j = 0; j < 4; ++j) { const int n = (lane >> 3) + 8 * j; const LAS float* s = scr + (8 * c) * 33 + n;
        v4u o; o.x = pk2(s[0 * 33], s[1 * 33]); o.y = pk2(s[2 * 33], s[3 * 33]); o.z = pk2(s[4 * 33], s[5 * 33]); o.w = pk2(s[6 * 33], s[7 * 33]);
        *(v4u*)(WT + (size_t)map(n0 + n) * Kp + k0 + 8 * c) = o; }
    LDS_WAIT();
}
template <bool TO_BF16>
DI void rms_row(const float* __restrict__ xrow, const float* __restrict__ g, void* orow, int lane) {
    const f32x4* xr = (const f32x4*)xrow + lane; const f32x4* gr = (const f32x4*)g + lane;
    f32x4 v[8]; float s = 0.f;
#pragma unroll
    for (int j = 0; j < 8; ++j) { v[j] = xr[64 * j]; s += (v[j].x * v[j].x + v[j].y * v[j].y) + (v[j].z * v[j].z + v[j].w * v[j].w); }
    const float rs = rsqrtf(wave_sum(s) * (1.f / DM) + RMS_EPS);
#pragma unroll
    for (int j = 0; j < 8; ++j) { const f32x4 gg = gr[64 * j]; const f32x4 o = v[j] * rs * gg;
        if (TO_BF16) { v2u w; w.x = pk2(o.x, o.y); w.y = pk2(o.z, o.w); ((v2u*)orow)[lane + 64 * j] = w; }
        else ((f32x4*)orow)[lane + 64 * j] = o; }
}

DI void p0_prologue(Frame& F) {
    LAS float* scr = (LAS float*)(F.lds + F.wave * 8448);
    const int gw = F.bid * 8 + F.wave, NGW = F.G * 8;
    bf16* WINT = (bf16*)(F.ws + WS_WINT); bf16* WPG = (bf16*)(F.ws + WS_WPG); bf16* WPN = (bf16*)(F.ws + WS_WPN); bf16* WOUT = (bf16*)(F.ws + WS_WOUT);
    bf16* W1T = (bf16*)(F.ws + WS_W1T); bf16* W2T = (bf16*)(F.ws + WS_W2T);
    constexpr int I_IN = (DM / 64) * (INW / 32), I_P = (DM / 64) * (DM / 32), I_C1 = (4096 / 64) * (256 / 32), I_C2 = (256 / 64) * (128 / 32);
    constexpr int NITEMS = I_IN + 3 * I_P + 2 * I_C1 + 2 * I_C2;
    for (int it = gw; it < NITEMS; it += NGW) {
        int r = it;
        if (r < I_IN) { transpose_item(F.w_in, INW, WINT, DM, scr, r, F.lane, MapWin{}); continue; } r -= I_IN;
        if (r < I_P) { transpose_item(F.w_pg, DM, WPG, DM, scr, r, F.lane, MapId{}); continue; } r -= I_P;
        if (r < I_P) { transpose_item(F.w_pn, DM, WPN, DM, scr, r, F.lane, MapId{}); continue; } r -= I_P;
        if (r < I_P) { transpose_item(F.w_out, DM, WOUT, DM, scr, r, F.lane, MapId{}); continue; } r -= I_P;
        if (r < I_C1) { transpose_item(F.w_ck1, 256, W1T, 4096, scr, r, F.lane, MapId{}); continue; } r -= I_C1;
        if (r < I_C1) { transpose_item(F.w_cv1, 256, W1T, 4096, scr, r, F.lane, MapOff{256}); continue; } r -= I_C1;
        if (r < I_C2) { transpose_item(F.w_ck2, 128, W2T, 256, scr, r, F.lane, MapId{}); continue; } r -= I_C2;
        transpose_item(F.w_cv2, 128, W2T, 256, scr, r, F.lane, MapOff{128});
    }
    bf16* H = (bf16*)(F.ws + WS_BUFA);
    for (int m = gw; m < MTOK; m += NGW) rms_row<true>(F.x + (size_t)m * DM, F.g_mix, H + (size_t)m * DM, F.lane);
    float* bias1 = (float*)(F.ws + WS_BIAS1);
    for (int it = gw; it < 128; it += NGW) {
        const int which = it >> 6, kc = it & 63; const float* pe = which ? F.pe_v : F.pe_k; const float* w1 = which ? F.w_cv1 : F.w_ck1;
        float a[4] = {0.f, 0.f, 0.f, 0.f};
        for (int kk = kc * 64; kk < kc * 64 + 64; ++kk) { const float p = pe[kk];
#pragma unroll
            for (int q = 0; q < 4; ++q) a[q] += p * w1[(size_t)kk * 256 + F.lane + 64 * q]; }
#pragma unroll
        for (int q = 0; q < 4; ++q) atomicAdd(bias1 + which * 256 + F.lane + 64 * q, a[q]);
    }
}
DI void p7_norm_ffnw(Frame& F) {
    LAS float* scr = (LAS float*)(F.lds + F.wave * 8448);
    const int gw = F.bid * 8 + F.wave, NGW = F.G * 8;
    bf16* WGU = (bf16*)(F.ws + WS_WGU); bf16* WD = (bf16*)(F.ws + WS_WD);
    constexpr int I_G = (DM / 64) * (DFF / 32), I_D = (DFF / 64) * (DM / 32);
    for (int it = gw; it < 2 * I_G + I_D; it += NGW) {
        int r = it;
        if (r < I_G) { transpose_item(F.w_fg, DFF, WGU, DM, scr, r, F.lane, MapGU{0}); continue; } r -= I_G;
        if (r < I_G) { transpose_item(F.w_fu, DFF, WGU, DM, scr, r, F.lane, MapGU{1}); continue; } r -= I_G;
        transpose_item(F.w_fd, DM, WD, DFF, scr, r, F.lane, MapId{});
    }
    bf16* H2 = (bf16*)(F.ws + WS_BUFB);
    for (int m = gw; m < MTOK; m += NGW) rms_row<true>(F.out + (size_t)m * DM, F.g_ffn, H2 + (size_t)m * DM, F.lane);
}
DI void p10_final(Frame& F) {
    const int gw = F.bid * 8 + F.wave, NGW = F.G * 8;
    for (int m = gw; m < MTOK; m += NGW) rms_row<false>(F.out + (size_t)m * DM, F.g_final, F.out + (size_t)m * DM, F.lane);
}

DI void g1_item(Frame& F, int item) {
    const bf16* Z = (const bf16*)(F.ws + WS_Z);
    bf16* QD = (bf16*)(F.ws + WS_QD); bf16* KET = (bf16*)(F.ws + WS_KET); bf16* ATT = (bf16*)(F.ws + WS_ATT); float* DECAY = (float*)(F.ws + WS_DECAY);
    const int bh = item >> 5, c = item & 31, b = bh >> 2, h = bh & 3;
    const size_t t0 = (size_t)b * SEQ + c * 64;
    LAS float* glr_s = (LAS float*)(F.lds);
    LAS float* tot_s = (LAS float*)(F.lds + 4096);
    LAS bf16* qd_s = (LAS bf16*)(F.lds + 8192);
    LAS bf16* kd_s = (LAS bf16*)(F.lds + 8192 + 33792);
    const int tid = F.tid, dk = tid & 255, half = tid >> 8;
    for (int e = tid; e < 1024; e += 512) { const int tok = e >> 4, r = e & 15; glr_s[e] = bf2f(Z[(t0 + tok) * ZW + ZGLR + r]); }
    float wg[16];
#pragma unroll
    for (int r = 0; r < 16; ++r) wg[r] = F.w_gla_gate[r * 1024 + h * 256 + dk];
    const float bg = F.b_gla_gate[h * 256 + dk];
    __syncthreads();
    float bc[32]; float run = 0.f;
#pragma unroll
    for (int i = 0; i < 32; ++i) { const int tok = half * 32 + i; float xg = bg;
        const LAS f32x4* gp = (const LAS f32x4*)(glr_s + tok * 16);
#pragma unroll
        for (int r4 = 0; r4 < 4; ++r4) { const f32x4 gv = gp[r4]; xg += gv.x * wg[4 * r4] + gv.y * wg[4 * r4 + 1] + gv.z * wg[4 * r4 + 2] + gv.w * wg[4 * r4 + 3]; }
        const float ls = fminf(xg, 0.f) - log1pf(__expf(-fabsf(xg)));
        run += ls * 0.0625f; bc[i] = run; }
    tot_s[half * 256 + dk] = run;
    __syncthreads();
    const float tot0 = tot_s[dk], tot1 = tot_s[256 + dk]; const float blast = tot0 + tot1, boff = half ? tot0 : 0.f;
    unsigned kep[16];
#pragma unroll
    for (int i = 0; i < 32; i += 2) { float ke2[2];
#pragma unroll
        for (int e = 0; e < 2; ++e) { const int tok = half * 32 + i + e; const float bb = bc[i + e] + boff;
            const float q = bf2f(Z[(t0 + tok) * ZW + ZGQ + h * 256 + dk]), k = bf2f(Z[(t0 + tok) * ZW + ZGK + h * 256 + dk]);
            const float qd = q * 0.0625f * __expf(bb), kd = k * __expf(-bb); ke2[e] = k * __expf(blast - bb);
            const bf16 qb = (bf16)f2bf(qd); qd_s[tok * 264 + dk] = qb; kd_s[tok * 264 + dk] = (bf16)f2bf(kd); QD[(t0 + tok) * 1024 + h * 256 + dk] = qb; }
        kep[i >> 1] = pk2(ke2[0], ke2[1]); }
    { v4u* kp = (v4u*)(KET + ((size_t)item * 256 + dk) * 64 + half * 32);
#pragma unroll
      for (int q = 0; q < 4; ++q) { v4u w; w.x = kep[4 * q]; w.y = kep[4 * q + 1]; w.z = kep[4 * q + 2]; w.w = kep[4 * q + 3]; kp[q] = w; } }
    if (half == 0) DECAY[(size_t)item * 256 + dk] = __expf(blast);
    __syncthreads();
    const int w = F.wave, fr = F.lane & 15, fq = F.lane >> 4, mt = w >> 1;
#pragma unroll
    for (int nn = 0; nn < 2; ++nn) { const int nt = (w & 1) * 2 + nn; f32x4 acc = {0.f, 0.f, 0.f, 0.f};
        if (nt <= mt) {
#pragma unroll
            for (int s = 0; s < 8; ++s) { const bf16x8 a = *(const LAS bf16x8*)(qd_s + (16 * mt + fr) * 264 + 32 * s + 8 * fq); const bf16x8 bb = *(const LAS bf16x8*)(kd_s + (16 * nt + fr) * 264 + 32 * s + 8 * fq);
                acc = MFMA16(a, bb, acc); } }
#pragma unroll
        for (int j = 0; j < 4; ++j) { const int row = 16 * mt + 4 * fq + j, col = 16 * nt + fr; const float v = (col <= row) ? acc[j] : 0.f;
            ATT[(size_t)item * 4096 + row * 64 + col] = (bf16)f2bf(v); } }
    __syncthreads();
}

DI void n1_item(Frame& F, int item) {
    const bf16* Z = (const bf16*)(F.ws + WS_Z);
    const bf16* W1T = (const bf16*)(F.ws + WS_W1T); const bf16* W2T = (const bf16*)(F.ws + WS_W2T); const float* bias1 = (const float*)(F.ws + WS_BIAS1);
    bf16* KC = (bf16*)(F.ws + WS_KC); bf16* VCT = (bf16*)(F.ws + WS_VCT);
    const int which = item >> 6, b = (item >> 4) & 3, hk = (item >> 2) & 3, j = item & 3;
    const int w = F.wave, r = F.lane & 31, hh = F.lane >> 5;
    LAS bf16* hid = (LAS bf16*)(F.lds);
    int crow_ = 32 * j + r; if (crow_ > 126) crow_ = 126;
    const bf16* ap = Z + ((size_t)b * SEQ + 16 * crow_) * ZW + ZNKV + which * 512 + hk * 128 + 8 * hh;
    const bf16* bp = W1T + ((size_t)which * 256 + 32 * w + r) * 4096 + 8 * hh;
    f32x16 acc; for (int i = 0; i < 16; ++i) acc[i] = 0.f;
    for (int tk = 0; tk < 32; ++tk) {
#pragma unroll
        for (int s = 0; s < 8; ++s) { const bf16x8 a = *(const bf16x8*)(ap + (size_t)tk * ZW + 16 * s); const bf16x8 bb = *(const bf16x8*)(bp + tk * 128 + 16 * s); acc = MFMA32(a, bb, acc); } }
    { const float bs = bias1[which * 256 + 32 * w + r];
#pragma unroll
      for (int i = 0; i < 16; ++i) { const int row = (i & 3) + 8 * (i >> 2) + 4 * hh; const float v = acc[i] + bs; hid[row * 264 + 32 * w + r] = (bf16)f2bf(v * sigm(v)); } }
    __syncthreads();
    if (w < 4) {
        f32x16 o; for (int i = 0; i < 16; ++i) o[i] = 0.f;
        const bf16* b2 = W2T + ((size_t)which * 128 + 32 * w + r) * 256 + 8 * hh;
#pragma unroll
        for (int s = 0; s < 16; ++s) { const bf16x8 a = *(const LAS bf16x8*)(hid + r * 264 + 16 * s + 8 * hh); const bf16x8 bb = *(const bf16x8*)(b2 + 16 * s); o = MFMA32(a, bb, o); }
        const int d = 32 * w + r;
        if (which == 0) {
#pragma unroll
            for (int i = 0; i < 16; ++i) { const int cc = 32 * j + (i & 3) + 8 * (i >> 2) + 4 * hh; KC[(((size_t)b * 4 + hk) * 128 + cc) * 128 + d] = (bf16)f2bf(o[i]); }
        } else {
#pragma unroll
            for (int a4 = 0; a4 < 4; ++a4) { v2u wv; wv.x = pk2(o[4 * a4], o[4 * a4 + 1]); wv.y = pk2(o[4 * a4 + 2], o[4 * a4 + 3]);
                *(v2u*)(VCT + (((size_t)b * 4 + hk) * 128 + d) * 128 + 32 * j + 8 * a4 + 4 * hh) = wv; }
        }
    }
    __syncthreads();
}
DI void vt_item(Frame& F, int item) {
    const bf16* Z = (const bf16*)(F.ws + WS_Z);
    const int dhalf = item & 1, tile = (item >> 1) & 31, hk = (item >> 6) & 3, b = (item >> 8) & 3, which = item >> 10;
    bf16* VT = (bf16*)(F.ws + (which ? WS_VTW : WS_VTS));
    LAS bf16* scr = (LAS bf16*)(F.lds + F.wave * 8448);
    const int lane = F.lane;
    const bf16* src = Z + ((size_t)b * SEQ + tile * 64) * ZW + ZNKV + (3 + 2 * which) * 512 + hk * 128 + dhalf * 64;
#pragma unroll
    for (int p = 0; p < 8; ++p) { const int tok = 8 * p + (lane >> 3), d8 = (lane & 7) * 8; const v4u v = *(const v4u*)(src + (size_t)tok * ZW + d8);
        LAS unsigned* dst = (LAS unsigned*)(scr + tok * 66 + d8); dst[0] = v.x; dst[1] = v.y; dst[2] = v.z; dst[3] = v.w; }
    LDS_WAIT();
#pragma unroll
    for (int p = 0; p < 8; ++p) { const int d = 8 * p + (lane >> 3), t8 = (lane & 7) * 8; unsigned short e[8];
#pragma unroll
        for (int q = 0; q < 8; ++q) e[q] = scr[(t8 + q) * 66 + d];
        v4u o; o.x = e[0] | ((unsigned)e[1] << 16); o.y = e[2] | ((unsigned)e[3] << 16); o.z = e[4] | ((unsigned)e[5] << 16); o.w = e[6] | ((unsigned)e[7] << 16);
        *(v4u*)(VT + (((size_t)b * 4 + hk) * 128 + dhalf * 64 + d) * SEQ + tile * 64 + t8) = o; }
    LDS_WAIT();
}
DI void p2_prep(Frame& F) {
    for (int it = F.bid; it < 128 + 512; it += F.G) { if (it < 128) n1_item(F, it); else g1_item(F, it - 128); }
    __syncthreads();
    const int gw = F.bid * 8 + F.wave, NGW = F.G * 8;
    for (int it = gw; it < 2048; it += NGW) vt_item(F, it);
}

DI void g2_item(Frame& F, int item) {
    const bf16* Z = (const bf16*)(F.ws + WS_Z);
    const bf16* QD = (const bf16*)(F.ws + WS_QD); const bf16* KET = (const bf16*)(F.ws + WS_KET); const bf16* ATT = (const bf16*)(F.ws + WS_ATT); const float* DECAY = (const float*)(F.ws + WS_DECAY);
    float* O = F.out;
    const int bh = item >> 4, js = item & 15, b = bh >> 2, h = bh & 3;
    LAS bf16* ST = (LAS bf16*)(F.lds);
    LAS bf16* VT = (LAS bf16*)(F.lds + 16896);
    const int tid = F.tid, w = F.wave, fr = F.lane & 15, fq = F.lane >> 4, mt = w >> 1, nt = w & 1;
    for (int e = tid; e < 4224; e += 512) ((LAS unsigned*)ST)[e] = 0u;
    f32x4 Sacc[2][2];
#pragma unroll
    for (int a = 0; a < 2; ++a)
#pragma unroll
        for (int c2 = 0; c2 < 2; ++c2) Sacc[a][c2] = (f32x4){0.f, 0.f, 0.f, 0.f};
    const int vtok = tid >> 3, vd4 = (tid & 7) * 4;
    const size_t vcol = ZGV + h * 512 + 32 * js;
    for (int c = 0; c < 32; ++c) {
        const size_t itemc = (size_t)bh * 32 + c, t0 = (size_t)b * SEQ + c * 64;
        const v2u vv = *(const v2u*)(Z + (t0 + vtok) * ZW + vcol + vd4);
        bf16x8 aatt[2], aqd[8], aket[2][2]; f32x4 dec[2];
#pragma unroll
        for (int s = 0; s < 2; ++s) aatt[s] = *(const bf16x8*)(ATT + itemc * 4096 + (16 * mt + fr) * 64 + 32 * s + 8 * fq);
#pragma unroll
        for (int s = 0; s < 8; ++s) aqd[s] = *(const bf16x8*)(QD + (t0 + 16 * mt + fr) * 1024 + h * 256 + 32 * s + 8 * fq);
#pragma unroll
        for (int mi = 0; mi < 2; ++mi) {
#pragma unroll
            for (int s = 0; s < 2; ++s) aket[mi][s] = *(const bf16x8*)(KET + (itemc * 256 + 32 * w + 16 * mi + fr) * 64 + 32 * s + 8 * fq);
            dec[mi] = *(const f32x4*)(DECAY + itemc * 256 + 32 * w + 16 * mi + 4 * fq); }
        VT[(vd4 + 0) * 72 + vtok] = (bf16)(vv.x & 0xffffu); VT[(vd4 + 1) * 72 + vtok] = (bf16)(vv.x >> 16);
        VT[(vd4 + 2) * 72 + vtok] = (bf16)(vv.y & 0xffffu); VT[(vd4 + 3) * 72 + vtok] = (bf16)(vv.y >> 16);
        __syncthreads();
        f32x4 o = {0.f, 0.f, 0.f, 0.f};
#pragma unroll
        for (int s = 0; s < 2; ++s) { const bf16x8 bb = *(const LAS bf16x8*)(VT + (16 * nt + fr) * 72 + 32 * s + 8 * fq); o = MFMA16(aatt[s], bb, o); }
#pragma unroll
        for (int s = 0; s < 8; ++s) { const bf16x8 bb = *(const LAS bf16x8*)(ST + (16 * nt + fr) * 264 + 32 * s + 8 * fq); o = MFMA16(aqd[s], bb, o); }
#pragma unroll
        for (int jj = 0; jj < 4; ++jj) O[(t0 + 16 * mt + 4 * fq + jj) * 2048 + h * 512 + 32 * js + 16 * nt + fr] = o[jj];
#pragma unroll
        for (int mi = 0; mi < 2; ++mi)
#pragma unroll
            for (int ni = 0; ni < 2; ++ni) { f32x4 a = Sacc[mi][ni] * dec[mi];
#pragma unroll
                for (int s = 0; s < 2; ++s) { const bf16x8 bb = *(const LAS bf16x8*)(VT + (16 * ni + fr) * 72 + 32 * s + 8 * fq); a = MFMA16(aket[mi][s], bb, a); }
                Sacc[mi][ni] = a; }
        __syncthreads();
#pragma unroll
        for (int mi = 0; mi < 2; ++mi)
#pragma unroll
            for (int ni = 0; ni < 2; ++ni) { v2u wv; wv.x = pk2(Sacc[mi][ni][0], Sacc[mi][ni][1]); wv.y = pk2(Sacc[mi][ni][2], Sacc[mi][ni][3]);
                *(LAS v2u*)(ST + (16 * ni + fr) * 264 + 32 * w + 16 * mi + 4 * fq) = wv; }
    }
    __syncthreads();
}
DI void p3_scan(Frame& F) { for (int it = F.bid; it < 256; it += F.G) g2_item(F, it); }

DI void gla_out_row(Frame& F, int rowh) {
    const bf16* Z = (const bf16*)(F.ws + WS_Z); bf16* OG = (bf16*)(F.ws + WS_BUFB);
    const int t = rowh >> 2, h = rowh & 3, lane = F.lane;
    const f32x4* op = (const f32x4*)(F.out + (size_t)t * 2048 + h * 512) + lane;
    const f32x4 a = op[0], bq = op[64];
    float s = (a.x * a.x + a.y * a.y) + (a.z * a.z + a.w * a.w) + (bq.x * bq.x + bq.y * bq.y) + (bq.z * bq.z + bq.w * bq.w);
    const float rs = rsqrtf(wave_sum(s) * (1.f / 512.f) + RMS_EPS);
#pragma unroll
    for (int q = 0; q < 2; ++q) { const f32x4 v = q ? bq : a; const f32x4 g = ((const f32x4*)F.g_gla_out)[lane + 64 * q];
        const v2u rw = *(const v2u*)(Z + (size_t)t * ZW + ZGR + h * 512 + 4 * lane + 256 * q);
        const float r0 = blo(rw.x), r1 = bhi(rw.x), r2 = blo(rw.y), r3 = bhi(rw.y);
        v2u w; w.x = pk2(v.x * rs * g.x * (r0 * sigm(r0)), v.y * rs * g.y * (r1 * sigm(r1))); w.y = pk2(v.z * rs * g.z * (r2 * sigm(r2)), v.w * rs * g.w * (r3 * sigm(r3)));
        *(v2u*)(OG + (size_t)t * 2048 + h * 512 + 4 * lane + 256 * q) = w; }
}
DI int pi_key(int r) { return (r & ~12) | ((r & 4) << 1) | ((r & 8) >> 1); }

constexpr int KB_PITCH = 272, VB_PITCH = 144, KB_BYTES = 64 * KB_PITCH, KV_BUF = KB_BYTES + 128 * VB_PITCH;
constexpr int NSA_X = 2 * KV_BUF;
constexpr int NSA_IMPR = KV_BUF  , NSA_MSK = NSA_X + 69632, NSA_END = NSA_MSK + 256;
static_assert(NSA_END <= LDS_BYTES, "NSA LDS map");
struct TileRegs { v4u k[2], v[2]; };
DI void tile_gload(TileRegs& R, const bf16* kg, size_t kpitch, const bf16* vg, size_t vpitch, int tid) {
#pragma unroll
    for (int j = 0; j < 2; ++j) { const int c = tid + 512 * j;
        R.k[j] = *(const v4u*)(kg + (size_t)(c >> 4) * kpitch + (c & 15) * 8); R.v[j] = *(const v4u*)(vg + (size_t)(c >> 3) * vpitch + (c & 7) * 8); }
}
DI void tile_sstore(const TileRegs& R, LAS unsigned char* buf, int tid) {
#pragma unroll
    for (int j = 0; j < 2; ++j) { const int c = tid + 512 * j;
        *(LAS v4u*)(buf + (c >> 4) * KB_PITCH + (c & 15) * 16) = R.k[j]; *(LAS v4u*)(buf + KB_BYTES + (c >> 3) * VB_PITCH + (c & 7) * 16) = R.v[j]; }
}
DI void qk_lds(f32x16& x0, f32x16& x1, const LAS unsigned char* kb, const bf16x8 (&qf)[8]) {
#pragma unroll
    for (int i = 0; i < 16; ++i) { x0[i] = 0.f; x1[i] = 0.f; }
#pragma unroll
    for (int s = 0; s < 8; ++s) { const bf16x8 a0 = *(const LAS bf16x8*)(kb + 32 * s); const bf16x8 a1 = *(const LAS bf16x8*)(kb + 32 * KB_PITCH + 32 * s);
        x0 = MFMA32(a0, qf[s], x0); x1 = MFMA32(a1, qf[s], x1); }
}
DI void pv_lds(f32x16 (&o)[4], const f32x16& p0, const f32x16& p1, const LAS unsigned char* vb) {
#pragma unroll
    for (int mt = 0; mt < 2; ++mt)
#pragma unroll
        for (int s2 = 0; s2 < 2; ++s2) { const f32x16& p = mt ? p1 : p0;
            const bf16x8 pf = pack8(p[8 * s2], p[8 * s2 + 1], p[8 * s2 + 2], p[8 * s2 + 3], p[8 * s2 + 4], p[8 * s2 + 5], p[8 * s2 + 6], p[8 * s2 + 7]);
#pragma unroll
            for (int dt = 0; dt < 4; ++dt) { const bf16x8 a = *(const LAS bf16x8*)(vb + (32 * dt) * VB_PITCH + (32 * mt + 16 * s2) * 2); o[dt] = MFMA32(a, pf, o[dt]); } }
}
DI void softmax_step(f32x16& x0, f32x16& x1, float& m, float& l, f32x16 (&o)[4]) {
    float mx = x0[0];
#pragma unroll
    for (int i = 1; i < 16; ++i) mx = fmaxf(mx, x0[i]);
#pragma unroll
    for (int i = 0; i < 16; ++i) mx = fmaxf(mx, x1[i]);
    mx = fmaxf(mx, __shfl_xor(mx, 32));
    const float mnew = fmaxf(m, mx); const float alpha = exp2f(m - mnew); m = mnew;
    float ps = 0.f;
#pragma unroll
    for (int i = 0; i < 16; ++i) { x0[i] = exp2f(x0[i] - mnew); x1[i] = exp2f(x1[i] - mnew); ps += x0[i] + x1[i]; }
    l = l * alpha + ps;
#pragma unroll
    for (int dt = 0; dt < 4; ++dt) o[dt] = o[dt] * alpha;
}

DI void nsa_item(Frame& F, int item) {
    const bf16* Z = (const bf16*)(F.ws + WS_Z);
    const bf16* KC = (const bf16*)(F.ws + WS_KC); const bf16* VCT = (const bf16*)(F.ws + WS_VCT); const bf16* VTS = (const bf16*)(F.ws + WS_VTS); const bf16* VTW = (const bf16*)(F.ws + WS_VTW);
    bf16* ON = (bf16*)(F.ws + WS_ON);
    const int qt = item & 31, hk = (item >> 5) & 3, b = item >> 7;
    int tid = F.tid; asm volatile("" : "+v"(tid));
    const int w = F.wave, lane = tid & 63, r = lane & 31, hh = lane >> 5, g = w >> 1, th = w & 1;
    const int head = hk * 4 + g, tl = 32 * th + r  , t = 64 * qt + tl;
    const size_t trow = (size_t)b * SEQ + t;
    LAS unsigned char* buf0 = F.lds; LAS unsigned char* buf1 = F.lds + KV_BUF;
    LAS float* part = (LAS float*)(F.lds + NSA_X);
    LAS unsigned* oacc = (LAS unsigned*)(F.lds + NSA_X);
    LAS float* impr = (LAS float*)(F.lds + NSA_IMPR);
    LAS unsigned* msk = (LAS unsigned*)(F.lds + NSA_MSK);
    constexpr float CS = 0.08838834764831845f * 1.4426950408889634f;
    int kboff = pi_key(r) * KB_PITCH + 16 * hh, vboff = KB_BYTES + r * VB_PITCH + 16 * hh;
    LAS unsigned* oacc_l = oacc + w * 2048 + lane;
    asm volatile("" : "+v"(kboff), "+v"(vboff), "+v"(oacc_l));
    const int nsel = qt + 1, wlo = qt > 8 ? qt - 8 : 0, ntile = nsel + (qt - wlo + 1);
    const bf16* ksel = Z + (size_t)b * SEQ * ZW + ZNKV + 2 * 512 + hk * 128; const bf16* kwin = ksel + 2 * 512;
    const bf16* vsel = VTS + ((size_t)b * 4 + hk) * 128 * SEQ; const bf16* vwin = VTW + ((size_t)b * 4 + hk) * 128 * SEQ;
    TileRegs R;
    {
        const bf16* kc = KC + ((size_t)b * 4 + hk) * 128 * 128; const bf16* vc = VCT + ((size_t)b * 4 + hk) * 128 * 128;
        TileRegs R1; tile_gload(R, kc, 128, vc, 128, tid); tile_gload(R1, kc + 64 * 128, 128, vc + 64, 128, tid);
        for (int e = tid; e < 17408; e += 512) part[e] = 0.f;
        if (tid < 64) msk[tid] = 0u;
        tile_sstore(R, buf0, tid); tile_sstore(R1, buf1, tid);
    }
    bf16x8 qf[8];
    { const bf16* qp = Z + trow * ZW + ZNQ + head * 128 + 8 * hh;
#pragma unroll
      for (int s = 0; s < 8; ++s) qf[s] = *(const bf16x8*)(qp + 16 * s); }
    const float gate_c = sigm(bf2f(Z[trow * ZW + ZNG + head])), gate_s = sigm(bf2f(Z[trow * ZW + ZNG + 16 + head])), gate_w = sigm(bf2f(Z[trow * ZW + ZNG + 32 + head]));
    tile_gload(R, ksel, ZW, vsel, SEQ, tid);
    f32x16 o[4];
#pragma unroll
    for (int dt = 0; dt < 4; ++dt)
#pragma unroll
        for (int i = 0; i < 16; ++i) o[dt][i] = 0.f;
    __syncthreads();
    {
        const int cmax = (t - 31) >> 4;
        float mx = -1e30f, ps = 0.f;
#pragma unroll 1
        for (int T = 0; T < 2; ++T) { f32x16 x0, x1; qk_lds(x0, x1, (T ? buf1 : buf0) + kboff, qf); float mm = -1e30f;
#pragma unroll
            for (int i = 0; i < 16; ++i) { const int cb = 64 * T + 16 * (i >> 3) + 8 * hh + (i & 7);
                x0[i] = (cb <= cmax) ? x0[i] * CS : -INFINITY; x1[i] = (cb + 32 <= cmax) ? x1[i] * CS : -INFINITY; mm = fmaxf(mm, fmaxf(x0[i], x1[i])); }
            mm = fmaxf(mm, __shfl_xor(mm, 32));
            const float mnew = fmaxf(mx, mm); float s = 0.f;
#pragma unroll
            for (int i = 0; i < 16; ++i) s += exp2f(x0[i] - mnew) + exp2f(x1[i] - mnew);
            ps = ps * exp2f(mx - mnew) + s; mx = mnew; }
        ps += __shfl_xor(ps, 32);
        const float inv = ps > 0.f ? 1.0f / ps : 0.f;
        LAS float* prow = part + ((size_t)(g * 64 + tl) * 34) * 2;
        asm volatile("" : "+v"(prow));
#pragma unroll 1
        for (int T = 0; T < 2; ++T) { f32x16 x0, x1; qk_lds(x0, x1, (T ? buf1 : buf0) + kboff, qf);
#pragma unroll
            for (int i = 0; i < 16; ++i) { const int cb = 64 * T + 16 * (i >> 3) + 8 * hh + (i & 7);
                const float s0 = (cb <= cmax) ? x0[i] * CS : -INFINITY, s1 = (cb + 32 <= cmax) ? x1[i] * CS : -INFINITY; x0[i] = exp2f(s0 - mx) * inv; x1[i] = exp2f(s1 - mx) * inv; }
#pragma unroll
            for (int mt = 0; mt < 2; ++mt)
#pragma unroll
                for (int s2 = 0; s2 < 2; ++s2) { const f32x16& p = mt ? x1 : x0;
                    const int n0 = 16 * T + 8 * mt + 4 * s2 + 2 * hh;
                    const float A = (p[8 * s2] + p[8 * s2 + 1]) + (p[8 * s2 + 2] + 0.5f * p[8 * s2 + 3]);
                    const float Bv = (0.5f * p[8 * s2 + 3] + p[8 * s2 + 4]) + (p[8 * s2 + 5] + p[8 * s2 + 6]) + 0.5f * p[8 * s2 + 7];
                    const float Cv = 0.5f * p[8 * s2 + 7];
                    prow[(n0) * 2] = A; prow[(n0 + 1) * 2] = Bv; prow[(n0 + 2) * 2 + 1] = Cv; }
            pv_lds(o, x0, x1, (T ? buf1 : buf0) + vboff); }
#pragma unroll
        for (int dt = 0; dt < 4; ++dt) o[dt] = o[dt] * gate_c;
    }
    __syncthreads();
    tile_sstore(R, buf0, tid);
#pragma unroll
    for (int k4 = 0; k4 < 4; ++k4) { const int e = tid + 512 * k4, tok = e >> 5, n = e & 31; float s = 0.f;
#pragma unroll
        for (int gg = 0; gg < 4; ++gg) { const LAS float* pp = part + ((size_t)(gg * 64 + tok) * 34 + n) * 2; s += pp[0] + pp[1]; }
        impr[tok * 33 + n] = s; }
    __syncthreads();
    if (qt < 16) { if (tid < 64) msk[tid] = (2u << qt) - 1u; }
    else {
#pragma unroll
        for (int k4 = 0; k4 < 4; ++k4) { const int e = tid + 512 * k4, tok = e >> 5, n = e & 31;
            if (n == 0) __hip_atomic_fetch_or(&msk[tok], 1u | (1u << qt) | (1u << (qt - 1)), __ATOMIC_RELAXED, __HIP_MEMORY_SCOPE_WORKGROUP);
            else if (n <= qt - 2) { const float v = impr[tok * 33 + n]; int rank = 0;
                for (int m2 = 1; m2 <= qt - 2; ++m2) { const float u = impr[tok * 33 + m2]; rank += (u > v || (u == v && m2 < n)) ? 1 : 0; }
                if (rank < 13) __hip_atomic_fetch_or(&msk[tok], 1u << n, __ATOMIC_RELAXED, __HIP_MEMORY_SCOPE_WORKGROUP); } }
    }
    __syncthreads();
    const unsigned mymask = msk[tl];
#pragma unroll
    for (int dt = 0; dt < 4; ++dt)
#pragma unroll
        for (int i = 0; i < 16; i += 2) oacc_l[(dt * 8 + (i >> 1)) * 64] = pk2(o[dt][i], o[dt][i + 1]);
#pragma unroll
    for (int dt = 0; dt < 4; ++dt)
#pragma unroll
        for (int i = 0; i < 16; ++i) o[dt][i] = 0.f;
    float m = -1e30f, l = 0.f;
    for (int i = 0; i < ntile; ++i) {
        if (i + 1 < ntile) { const int i1 = i + 1; const bool br = i1 >= nsel; const int n1 = br ? wlo + (i1 - nsel) : i1;
            tile_gload(R, (br ? kwin : ksel) + (size_t)(64 * n1) * ZW, ZW, (br ? vwin : vsel) + 64 * n1, SEQ, tid); }
        if (i == nsel) {
            l += __shfl_xor(l, 32);
            const float f = l > 0.f ? gate_s / l : 0.f;
#pragma unroll
            for (int dt = 0; dt < 4; ++dt)
#pragma unroll
                for (int i2 = 0; i2 < 16; i2 += 2) { LAS unsigned* ap = oacc_l + (dt * 8 + (i2 >> 1)) * 64; const unsigned pw = *ap;
                    *ap = pk2(blo(pw) + f * o[dt][i2], bhi(pw) + f * o[dt][i2 + 1]); o[dt][i2] = 0.f; o[dt][i2 + 1] = 0.f; }
            m = -1e30f; l = 0.f;
        }
        const bool win = i >= nsel; const int n = win ? wlo + (i - nsel) : i;
        LAS unsigned char* bufc = (i & 1) ? buf1 : buf0;
        f32x16 x0, x1; qk_lds(x0, x1, bufc + kboff, qf);
        const int lim = t - 64 * n;
        const bool rowok = win ? true : (((mymask >> n) & 1u) != 0u);
        const int lo_lim = win ? lim - 512 : -100000;
#pragma unroll
        for (int i2 = 0; i2 < 16; ++i2) { const int kk = 16 * (i2 >> 3) + 8 * hh + (i2 & 7);
            x0[i2] = (rowok && kk <= lim && kk > lo_lim) ? x0[i2] * CS : -INFINITY; x1[i2] = (rowok && kk + 32 <= lim && kk + 32 > lo_lim) ? x1[i2] * CS : -INFINITY; }
        softmax_step(x0, x1, m, l, o);
        pv_lds(o, x0, x1, bufc + vboff);
        if (i + 1 < ntile) tile_sstore(R, (i & 1) ? buf0 : buf1, tid);
        __syncthreads();
    }
    {
        l += __shfl_xor(l, 32);
        const float f = l > 0.f ? gate_w / l : 0.f;
        bf16* op = ON + trow * 2048 + head * 128 + 4 * hh;
#pragma unroll
        for (int dt = 0; dt < 4; ++dt)
#pragma unroll
            for (int a4 = 0; a4 < 4; ++a4) { const unsigned p0 = oacc_l[(dt * 8 + 2 * a4) * 64], p1 = oacc_l[(dt * 8 + 2 * a4 + 1) * 64];
                v2u wv; wv.x = pk2(blo(p0) + f * o[dt][4 * a4], bhi(p0) + f * o[dt][4 * a4 + 1]); wv.y = pk2(blo(p1) + f * o[dt][4 * a4 + 2], bhi(p1) + f * o[dt][4 * a4 + 3]);
                *(v2u*)(op + 32 * dt + 8 * a4) = wv; }
    }
    __syncthreads();
}
DI void p4_nsa(Frame& F) {
    const int gw = F.bid * 8 + F.wave, NGW = F.G * 8;
    for (int rh = gw; rh < MTOK * 4; rh += NGW) gla_out_row(F, rh);
    __syncthreads();
    for (int it = F.bid; it < 256; it += F.G) {
        const int bhk = it >> 4, q = it & 15;
#pragma unroll 1
        for (int k2 = 0; k2 < 2; ++k2) nsa_item(F, bhk * 32 + (k2 ? q : 31 - q));
    }
}

#ifndef MK_N_LAUNCHES
#define MK_N_LAUNCHES 1
#endif
constexpr int N_PHASES = 11;
__global__ void __launch_bounds__(512, 2) hybrid_fwd(Args args) {
    extern __shared__ __attribute__((aligned(16))) unsigned char lds_raw[];
    Frame F;
    F.lds = (LAS unsigned char*)lds_raw;
    F.tid = threadIdx.x; F.lane = F.tid & 63; F.wave = __builtin_amdgcn_readfirstlane(F.tid >> 6); F.G = gridDim.x; F.bid = blockIdx.x;
    F.x = args.in[0]; F.g_mix = args.in[1]; F.w_in = args.in[2]; F.w_gla_gate = args.in[3]; F.b_gla_gate = args.in[4]; F.g_gla_out = args.in[5];
    F.pe_k = args.in[6]; F.w_ck1 = args.in[7]; F.w_ck2 = args.in[8]; F.pe_v = args.in[9]; F.w_cv1 = args.in[10]; F.w_cv2 = args.in[11];
    F.w_pg = args.in[12]; F.w_pn = args.in[13]; F.w_out = args.in[14]; F.g_ffn = args.in[15]; F.w_fg = args.in[16]; F.w_fu = args.in[17]; F.w_fd = args.in[18]; F.g_final = args.in[19];
    F.out = args.out; F.ws = args.ws;
    const int lo = args.ph_lo, hi = args.ph_hi;
    typedef pg8::bf16_t pb;
#ifndef PH_MASK
#define PH_MASK 0x7ff
#endif
#define IN(k) (((PH_MASK >> (k)) & 1) && lo <= (k) && (k) < hi)
#define SEAM(k) do { if (IN(k) && IN((k) + 1)) { asm volatile("s_waitcnt vmcnt(0)" ::: "memory"); cg::this_grid().sync(); \
        if (F.wave == 0) { __builtin_amdgcn_fence(__ATOMIC_ACQUIRE, "agent"); asm volatile("s_waitcnt vmcnt(0)" ::: "memory"); } __syncthreads(); } } while (0)
    if (IN(0)) { p0_prologue(F); } SEAM(0);
    if (IN(1)) {
        pg8::Gemm g{(const pb*)(F.ws + WS_BUFA), (const pb*)(F.ws + WS_WINT), MTOK, ZW, DM}; pg8::StaticOrder S; S.init(MTOK, ZW, F.G, F.bid);
        pg8::EpiBf16Plain E{(pb*)(F.ws + WS_Z), ZW};
        pg8::gemm_phase<pg8::EpiBf16Plain, pg8::StaticOrder, true, true>(F.lds, g, S, E);
    } SEAM(1);
    if (IN(2)) { p2_prep(F); } SEAM(2);
    if (IN(3)) { p3_scan(F); } SEAM(3);
    if (IN(4)) { p4_nsa(F); } SEAM(4);
    if (IN(5)) {
        { pg8::Gemm g{(const pb*)(F.ws + WS_BUFB), (const pb*)(F.ws + WS_WPG), MTOK, DM, DM}; pg8::StaticOrder S; S.init(MTOK, DM, F.G, F.bid);
          pg8::EpiGate<false> E{(pb*)(F.ws + WS_BUFA), (const pb*)(F.ws + WS_Z) + ZMG, DM, ZW};
          pg8::gemm_phase<pg8::EpiGate<false>, pg8::StaticOrder, true, true>(F.lds, g, S, E); }
        { pg8::Gemm g{(const pb*)(F.ws + WS_ON), (const pb*)(F.ws + WS_WPN), MTOK, DM, DM}; pg8::StaticOrder S; S.init(MTOK, DM, F.G, F.bid);
          pg8::EpiGate<true> E{(pb*)(F.ws + WS_BUFA), (const pb*)(F.ws + WS_Z) + ZMG + 2048, DM, ZW};
          pg8::gemm_phase<pg8::EpiGate<true>, pg8::StaticOrder, true, true>(F.lds, g, S, E); }
    } SEAM(5);
    if (IN(6)) {
        pg8::Gemm g{(const pb*)(F.ws + WS_BUFA), (const pb*)(F.ws + WS_WOUT), MTOK, DM, DM}; pg8::StaticOrder S; S.init(MTOK, DM, F.G, F.bid);
        pg8::EpiResF32 E{F.x, F.out, DM};
        pg8::gemm_phase<pg8::EpiResF32, pg8::StaticOrder, true, true>(F.lds, g, S, E);
    } SEAM(6);
    if (IN(7)) { p7_norm_ffnw(F); } SEAM(7);
    if (IN(8)) {
        pg8::Gemm g{(const pb*)(F.ws + WS_BUFB), (const pb*)(F.ws + WS_WGU), MTOK, 2 * DFF, DM}; pg8::StaticOrder S; S.init(MTOK, 2 * DFF, F.G, F.bid);
        pg8::EpiSwiGLU E{(pb*)(F.ws + WS_ACT), DFF};
        pg8::gemm_phase<pg8::EpiSwiGLU, pg8::StaticOrder, true, true>(F.lds, g, S, E);
    } SEAM(8);
    if (IN(9)) {
        pg8::Gemm g{(const pb*)(F.ws + WS_ACT), (const pb*)(F.ws + WS_WD), MTOK, DM, DFF}; pg8::StaticOrder S; S.init(MTOK, DM, F.G, F.bid);
        pg8::EpiResF32 E{F.out, F.out, DM};
        pg8::gemm_phase<pg8::EpiResF32, pg8::StaticOrder, true, true>(F.lds, g, S, E);
    } SEAM(9);
    if (IN(10)) { p10_final(F); }
#undef IN
#undef SEAM
}

extern "C" void kernel_launch(void* const* d_in, const int* in_sizes, int n_in, void* d_out, int out_size, void* d_ws, size_t ws_size, hipStream_t stream) {
    static int grid = 0;
    if (grid == 0) {
        if (n_in != 20 || in_sizes[0] != MTOK * DM || out_size != MTOK * DM || ws_size < WS_END) {
            fprintf(stderr, "kernel_launch: unexpected shapes (n_in %d, in0 %d, out %d, ws %zu < %zu); nothing launched\n", n_in, n_in > 0 ? in_sizes[0] : -1, out_size, ws_size, (size_t)WS_END); grid = -1; return; }
        int dev = 0, cus = 0, per_cu = 0;
        if (hipGetDevice(&dev) != hipSuccess || hipDeviceGetAttribute(&cus, hipDeviceAttributeMultiprocessorCount, dev) != hipSuccess) { grid = -1; return; }
        if (hipFuncSetAttribute((const void*)hybrid_fwd, hipFuncAttributeMaxDynamicSharedMemorySize, LDS_BYTES) != hipSuccess) { fprintf(stderr, "kernel_launch: hipFuncSetAttribute failed\n"); grid = -1; return; }
        if (hipOccupancyMaxActiveBlocksPerMultiprocessor(&per_cu, (const void*)hybrid_fwd, 512, LDS_BYTES) != hipSuccess || per_cu < 1) { fprintf(stderr, "kernel_launch: occupancy query says %d blocks per CU\n", per_cu); per_cu = 1; }
        (void)hipGetLastError();
        grid = cus * (per_cu > 1 ? 1 : per_cu);
    }
    if (grid < 0) return;
    (void)hipMemsetAsync((char*)d_ws + WS_CTL, 0, CTL_ZERO_BYTES, stream);
    Args a{};
    for (int i = 0; i < 20; ++i) a.in[i] = (const float*)d_in[i];
    a.out = (float*)d_out; a.ws = (unsigned char*)d_ws;
#if MK_N_LAUNCHES == 1
    a.ph_lo = 0; a.ph_hi = N_PHASES;
    void* kargs[] = {&a};
    hipError_t e = hipLaunchCooperativeKernel((const void*)hybrid_fwd, dim3(grid), dim3(512), kargs, LDS_BYTES, stream);
    if (e != hipSuccess) fprintf(stderr, "kernel_launch: cooperative launch failed: %s (grid %d)\n", hipGetErrorString(e), grid);
#else
    for (int p = 0; p < N_PHASES; ++p) { a.ph_lo = p; a.ph_hi = p + 1; hipLaunchKernelGGL(hybrid_fwd, dim3(grid), dim3(512), LDS_BYTES, stream, a); }
#endif
}
```

```cpp
#include <hip/hip_runtime.h>
#include <hip/hip_cooperative_groups.h>
#include <cstdio>
#include <cstdint>
namespace cg = cooperative_groups;
#define MK_N_LAUNCHES 1
#define REPEAT_MASK 0
namespace pg8 {
#define PG8_LAS __attribute__((address_space(3)))
typedef unsigned short bf16_t;
typedef short bf16x8 __attribute__((ext_vector_type(8)));
typedef float f32x4 __attribute__((ext_vector_type(4)));
typedef unsigned u32x4 __attribute__((ext_vector_type(4)));
constexpr int BM = 256, BK = 64, HALF = 128, HTB = HALF * BK * 2  , STAGE_BYTES = 8 * HTB, NXCD = 8, WGM = 8;

__host__ __device__ __forceinline__ int lds_byte(int r, int c) { const int st = (r >> 4) * 2 + (c >> 5), rr = r & 15, cc = c & 31, ob = rr * 64 + cc * 2; return st * 1024 + (ob ^ (((ob >> 9) & 1) << 5)); }
__host__ __device__ __forceinline__ void stage_rc(int b, int& R, int& C) { const int st = b / 1024, sb = b % 1024, swz = sb ^ (((sb >> 9) & 1) << 5); R = (st >> 1) * 16 + swz / 64; C = (st & 1) * 32 + (swz % 64) / 2; }
__host__ __device__ __forceinline__ int perm32(int rho) { const int n = rho >> 4, i = rho & 15; return 8 * (i >> 2) + 4 * n + (i & 3); }

struct Unit { int pm, pn; };
struct Gemm { const bf16_t* A; const bf16_t* Bt; int M, N, K; };

struct StaticOrder {
    int nM, nN, nwg, G, c;
    __host__ __device__ void init(int M, int N, int G_, int c_) { nM = M / BM; nN = N / BM; nwg = nM * nN; G = G_; c = c_; }
    __host__ __device__ bool next(int i, Unit& u) const {
        const long L = (long)i * G + c; if (L >= nwg) return false;
        int wgid = (int)L; { const int q = nwg / NXCD, r = nwg % NXCD, xcd = wgid % NXCD, off = wgid / NXCD; wgid = (xcd < r ? xcd * (q + 1) : r * (q + 1) + (xcd - r) * q) + off; }
        const int nig = WGM * nN, gid = wgid / nig, fm = gid * WGM, gsz = (nM - fm) < WGM ? (nM - fm) : WGM;
        u.pm = fm + ((wgid % nig) % gsz); u.pn = (wgid % nig) / gsz; return true;
    }
    __device__ __forceinline__ void a_ready(const Unit&) const {}
    __device__ __forceinline__ void done(const Unit&) const {}
};

__device__ __forceinline__ unsigned cvt_pk_bf16(float lo, float hi) { unsigned r; asm volatile("v_cvt_pk_bf16_f32 %0, %1, %2" : "=v"(r) : "v"(lo), "v"(hi)); return r; }
__device__ __forceinline__ float bf_lo(unsigned w) { return __uint_as_float(w << 16); }
__device__ __forceinline__ float bf_hi(unsigned w) { return __uint_as_float(w & 0xffff0000u); }
__device__ __forceinline__ float sigmoidf_(float x) { return 1.0f / (1.0f + __expf(-x)); }

struct EpiBf16Plain {
    static constexpr bool PERM = true, AFTER_DRAIN = false;
    bf16_t* O; int ldc;
    __device__ __forceinline__ void operator()(const f32x4 (&acc)[2][2][4][2], const Unit& u, int wr, int wc, int fr, int fq) const {
        const int row0 = u.pm * BM + wr * 64 + fr; const int col0 = u.pn * BM + wc * 32 + 8 * fq;
#pragma unroll
        for (int ai = 0; ai < 2; ++ai)
#pragma unroll
            for (int m = 0; m < 4; ++m) { bf16_t* rowp = O + (size_t)(row0 + ai * HALF + m * 16) * ldc + col0;
#pragma unroll
                for (int bj = 0; bj < 2; ++bj) { const f32x4 v0 = acc[ai][bj][m][0], v1 = acc[ai][bj][m][1];
                    u32x4 w; w.x = cvt_pk_bf16(v0[0], v0[1]); w.y = cvt_pk_bf16(v0[2], v0[3]); w.z = cvt_pk_bf16(v1[0], v1[1]); w.w = cvt_pk_bf16(v1[2], v1[3]);
                    *(u32x4*)(rowp + bj * HALF) = w; } }
    }
};
template <bool ADD> struct EpiGate {
    static constexpr bool PERM = true, AFTER_DRAIN = false;
    bf16_t* O; const bf16_t* G; int ldo, ldg;
    __device__ __forceinline__ void operator()(const f32x4 (&acc)[2][2][4][2], const Unit& u, int wr, int wc, int fr, int fq) const {
        const int row0 = u.pm * BM + wr * 64 + fr; const int col0 = u.pn * BM + wc * 32 + 8 * fq;
#pragma unroll
        for (int ai = 0; ai < 2; ++ai)
#pragma unroll
            for (int m = 0; m < 4; ++m) { const size_t row = (size_t)(row0 + ai * HALF + m * 16);
#pragma unroll
                for (int bj = 0; bj < 2; ++bj) { const f32x4 v0 = acc[ai][bj][m][0], v1 = acc[ai][bj][m][1];
                    const u32x4 gw = *(const u32x4*)(G + row * ldg + col0 + bj * HALF);
                    float r[8];
                    r[0] = sigmoidf_(bf_lo(gw.x)) * v0[0]; r[1] = sigmoidf_(bf_hi(gw.x)) * v0[1]; r[2] = sigmoidf_(bf_lo(gw.y)) * v0[2]; r[3] = sigmoidf_(bf_hi(gw.y)) * v0[3];
                    r[4] = sigmoidf_(bf_lo(gw.z)) * v1[0]; r[5] = sigmoidf_(bf_hi(gw.z)) * v1[1]; r[6] = sigmoidf_(bf_lo(gw.w)) * v1[2]; r[7] = sigmoidf_(bf_hi(gw.w)) * v1[3];
                    bf16_t* op = O + row * ldo + col0 + bj * HALF;
                    if (ADD) { const u32x4 pw = *(const u32x4*)op;
                        r[0] += bf_lo(pw.x); r[1] += bf_hi(pw.x); r[2] += bf_lo(pw.y); r[3] += bf_hi(pw.y); r[4] += bf_lo(pw.z); r[5] += bf_hi(pw.z); r[6] += bf_lo(pw.w); r[7] += bf_hi(pw.w); }
                    u32x4 w; w.x = cvt_pk_bf16(r[0], r[1]); w.y = cvt_pk_bf16(r[2], r[3]); w.z = cvt_pk_bf16(r[4], r[5]); w.w = cvt_pk_bf16(r[6], r[7]);
                    *(u32x4*)op = w; } }
    }
};
struct EpiSwiGLU {
    static constexpr bool PERM = true, AFTER_DRAIN = false;
    bf16_t* O; int ldo;
    __device__ __forceinline__ void operator()(const f32x4 (&acc)[2][2][4][2], const Unit& u, int wr, int wc, int fr, int fq) const {
        const int row0 = u.pm * BM + wr * 64 + fr; const int col0 = u.pn * HALF + wc * 32 + 8 * fq;
#pragma unroll
        for (int ai = 0; ai < 2; ++ai)
#pragma unroll
            for (int m = 0; m < 4; ++m) { const size_t row = (size_t)(row0 + ai * HALF + m * 16);
                const f32x4 g0 = acc[ai][0][m][0], g1 = acc[ai][0][m][1], u0 = acc[ai][1][m][0], u1 = acc[ai][1][m][1];
                float r[8];
#pragma unroll
                for (int e = 0; e < 4; ++e) { r[e] = g0[e] * sigmoidf_(g0[e]) * u0[e]; r[4 + e] = g1[e] * sigmoidf_(g1[e]) * u1[e]; }
                u32x4 w; w.x = cvt_pk_bf16(r[0], r[1]); w.y = cvt_pk_bf16(r[2], r[3]); w.z = cvt_pk_bf16(r[4], r[5]); w.w = cvt_pk_bf16(r[6], r[7]);
                *(u32x4*)(O + row * ldo + col0) = w; }
    }
};
struct EpiResF32 {
    static constexpr bool PERM = false, AFTER_DRAIN = false;
    const float* base; float* out; int ldc;
    __device__ __forceinline__ void operator()(const f32x4 (&acc)[2][2][4][2], const Unit& u, int wr, int wc, int fr, int fq) const {
        const int row0 = u.pm * BM + wr * 64 + fr, col0 = u.pn * BM + wc * 32 + 4 * fq;
#pragma unroll
        for (int ai = 0; ai < 2; ++ai)
#pragma unroll
            for (int m = 0; m < 4; ++m) { const size_t off = (size_t)(row0 + ai * HALF + m * 16) * ldc + col0;
#pragma unroll
                for (int bj = 0; bj < 2; ++bj)
#pragma unroll
                    for (int n = 0; n < 2; ++n) { const f32x4 bs = *(const f32x4*)(base + off + bj * HALF + n * 16); *(f32x4*)(out + off + bj * HALF + n * 16) = bs + acc[ai][bj][m][n]; } }
    }
};
template <class Epi, class Sched, bool ALIGN_EPI = false, bool SP2 = false>
__device__ __forceinline__ void gemm_phase(PG8_LAS unsigned char* lds, const Gemm g, const Sched& S, const Epi& E) {
    const int tid = threadIdx.x, wid = __builtin_amdgcn_readfirstlane(tid >> 6), lane = tid & 63, wr = wid >> 2, wc = wid & 3, fr = lane & 15, fq = lane >> 4;
    const int K = g.K, nt = K / BK;
    unsigned voffA[2], voffB[2];
#pragma unroll
    for (int i = 0; i < 2; ++i) { int R, C; stage_rc(tid * 16 + i * 8192, R, C); const int Rb = Epi::PERM ? ((R & ~31) + perm32(R & 31)) : R;
        voffA[i] = (unsigned)(R * K + C) * 2u; voffB[i] = (unsigned)(Rb * K + C) * 2u; }
    const size_t kstep = (size_t)(BK * 2);
    const size_t hstep = (size_t)HALF * K * 2;
    const size_t tstep = 2 * hstep;
    const unsigned ldsw = (unsigned)wid * 1024u;
    const int aoff = lds_byte(wr * 64 + fr, fq * 8), boff = lds_byte(wc * 32 + fr, fq * 8);
#define PG8_SA(b, h) (((b) * 2 + (h)) * HTB)
#define PG8_SB(b, h) ((4 + (b) * 2 + (h)) * HTB)
#define PG8_STAGE(bufoff, gbase, voff) do { _Pragma("unroll") for (int _i = 0; _i < 2; ++_i) \
        __builtin_amdgcn_global_load_lds((const unsigned*)((const char*)(gbase) + (voff)[_i]), (PG8_LAS unsigned*)(lds + (bufoff) + ldsw + _i * 8192), 16, 0, 0); } while (0)
#define PG8_LDA(dst, b, h) do { _Pragma("unroll") for (int m = 0; m < 4; ++m) _Pragma("unroll") for (int k = 0; k < 2; ++k) dst[m][k] = *(const PG8_LAS bf16x8*)(lds + PG8_SA(b, h) + aoff + m * 2048 + k * 1024); } while (0)
#define PG8_LDB(dst, b, h) do { _Pragma("unroll") for (int n = 0; n < 2; ++n) _Pragma("unroll") for (int k = 0; k < 2; ++k) dst[n][k] = *(const PG8_LAS bf16x8*)(lds + PG8_SB(b, h) + boff + n * 2048 + k * 1024); } while (0)
#define PG8_MMA(ai, bj, At, Bt) do { __builtin_amdgcn_s_setprio(1); _Pragma("unroll") for (int m = 0; m < 4; ++m) _Pragma("unroll") for (int n = 0; n < 2; ++n) _Pragma("unroll") for (int k = 0; k < 2; ++k) \
        acc[ai][bj][m][n] = __builtin_amdgcn_mfma_f32_16x16x32_bf16(Bt[n][k], At[m][k], acc[ai][bj][m][n], 0, 0, 0); __builtin_amdgcn_s_setprio(0); } while (0)
#define PG8_WAIT_V(n) asm volatile("s_waitcnt vmcnt(" #n ")" ::: "memory")
#define PG8_WAIT_L(n) asm volatile("s_waitcnt lgkmcnt(" #n ")" ::: "memory")
#define PG8_BAR __builtin_amdgcn_s_barrier()
#define PG8_SCHED __builtin_amdgcn_sched_barrier(0)
    Unit cur, nxt; int ui = 0;
    if (!S.next(0, cur)) return;
    f32x4 acc[2][2][4][2];
#pragma unroll
    for (int a = 0; a < 2; ++a)
#pragma unroll
        for (int b = 0; b < 2; ++b)
#pragma unroll
            for (int m = 0; m < 4; ++m)
#pragma unroll
                for (int n = 0; n < 2; ++n) acc[a][b][m][n] = (f32x4){0.f, 0.f, 0.f, 0.f};
    bf16x8 At[4][2], B0[2][2], B1[2][2];
    const char* cA = (const char*)g.A + (size_t)cur.pm * tstep; const char* cB = (const char*)g.Bt + (size_t)cur.pn * tstep;
    S.a_ready(cur);
    if constexpr (SP2) {
        PG8_STAGE(PG8_SB(0, 0), cB, voffB); PG8_STAGE(PG8_SB(0, 1), cB + hstep, voffB); PG8_STAGE(PG8_SA(0, 0), cA, voffA); PG8_STAGE(PG8_SA(0, 1), cA + hstep, voffA);
        if (wr == 1) PG8_BAR;
        PG8_WAIT_V(2); PG8_BAR;
        PG8_STAGE(PG8_SB(1, 0), cB + kstep, voffB); PG8_STAGE(PG8_SA(1, 0), cA + kstep, voffA); PG8_STAGE(PG8_SB(1, 1), cB + hstep + kstep, voffB);
        PG8_WAIT_V(6); PG8_BAR;
    } else {
        PG8_STAGE(PG8_SB(0, 0), cB, voffB); PG8_STAGE(PG8_SA(0, 0), cA, voffA); PG8_STAGE(PG8_SB(0, 1), cB + hstep, voffB); PG8_STAGE(PG8_SA(0, 1), cA + hstep, voffA);
        if (wr == 1) PG8_BAR;
        PG8_WAIT_V(4); PG8_BAR;
        PG8_STAGE(PG8_SB(1, 0), cB + kstep, voffB); PG8_STAGE(PG8_SA(1, 0), cA + kstep, voffA); PG8_STAGE(PG8_SB(1, 1), cB + hstep + kstep, voffB);
        PG8_WAIT_V(6); PG8_BAR;
    }
    for (;;) {
        const bool has_next = S.next(ui + 1, nxt);
        const char* nA = has_next ? (const char*)g.A + (size_t)nxt.pm * tstep : cA; const char* nB = has_next ? (const char*)g.Bt + (size_t)nxt.pn * tstep : cB;
        for (int t = 0; t < nt; t += 2) {
            const bool last = (t == nt - 2);
            const char* a1 = cA + (size_t)(t + 1) * kstep;
            const char* a2 = last ? nA : cA + (size_t)(t + 2) * kstep; const char* b2 = last ? nB : cB + (size_t)(t + 2) * kstep;
            const char* a3 = a2 + kstep; const char* b3 = b2 + kstep;
            if (last && has_next) S.a_ready(nxt);
            if constexpr (SP2) {
            PG8_LDB(B0, 0, 0); PG8_LDB(B1, 0, 1); PG8_SCHED; PG8_LDA(At, 0, 0); PG8_STAGE(PG8_SA(1, 1), a1 + hstep, voffA);
            PG8_WAIT_V(8); PG8_WAIT_L(0); PG8_BAR; PG8_MMA(0, 0, At, B0); PG8_MMA(0, 1, At, B1); PG8_BAR; PG8_SCHED;
            PG8_LDA(At, 0, 1); PG8_STAGE(PG8_SB(0, 0), b2, voffB); PG8_STAGE(PG8_SB(0, 1), b2 + hstep, voffB); PG8_STAGE(PG8_SA(0, 0), a2, voffA);
            PG8_WAIT_V(8); PG8_WAIT_L(0); PG8_BAR; PG8_MMA(1, 0, At, B0); PG8_MMA(1, 1, At, B1); PG8_BAR; PG8_SCHED;
            PG8_LDB(B0, 1, 0); PG8_LDB(B1, 1, 1); PG8_SCHED; PG8_LDA(At, 1, 0); PG8_STAGE(PG8_SA(0, 1), a2 + hstep, voffA);
            PG8_WAIT_V(8); PG8_WAIT_L(0); PG8_BAR; PG8_MMA(0, 0, At, B0); PG8_MMA(0, 1, At, B1); PG8_BAR; PG8_SCHED;
            PG8_LDA(At, 1, 1); PG8_STAGE(PG8_SB(1, 0), b3, voffB); PG8_STAGE(PG8_SB(1, 1), b3 + hstep, voffB); PG8_STAGE(PG8_SA(1, 0), a3, voffA);
            PG8_WAIT_V(8); PG8_WAIT_L(0); PG8_BAR; PG8_MMA(1, 0, At, B0); PG8_MMA(1, 1, At, B1); PG8_BAR; PG8_SCHED;
            } else {
            PG8_LDB(B0, 0, 0); PG8_SCHED; PG8_LDA(At, 0, 0); PG8_STAGE(PG8_SA(1, 1), a1 + hstep, voffA);
            PG8_WAIT_L(8); PG8_BAR; PG8_WAIT_L(0); PG8_MMA(0, 0, At, B0); PG8_BAR; PG8_SCHED;
            PG8_LDB(B1, 0, 1); PG8_STAGE(PG8_SB(0, 0), b2, voffB);
            PG8_BAR; PG8_WAIT_L(0); PG8_MMA(0, 1, At, B1); PG8_BAR;
            PG8_LDA(At, 0, 1); PG8_STAGE(PG8_SA(0, 0), a2, voffA);
            PG8_BAR; PG8_WAIT_L(0); PG8_MMA(1, 0, At, B0); PG8_BAR; PG8_SCHED;
            PG8_STAGE(PG8_SB(0, 1), b2 + hstep, voffB);
            PG8_WAIT_V(6); PG8_BAR; PG8_MMA(1, 1, At, B1); PG8_BAR;
            PG8_LDB(B0, 1, 0); PG8_SCHED; PG8_LDA(At, 1, 0); PG8_STAGE(PG8_SA(0, 1), a2 + hstep, voffA);
            PG8_WAIT_L(8); PG8_BAR; PG8_WAIT_L(0); PG8_MMA(0, 0, At, B0); PG8_BAR; PG8_SCHED;
            PG8_LDB(B1, 1, 1); PG8_STAGE(PG8_SB(1, 0), b3, voffB);
            PG8_BAR; PG8_WAIT_L(0); PG8_MMA(0, 1, At, B1); PG8_BAR;
            PG8_LDA(At, 1, 1); PG8_STAGE(PG8_SA(1, 0), a3, voffA);
            PG8_BAR; PG8_WAIT_L(0); PG8_MMA(1, 0, At, B0); PG8_BAR; PG8_SCHED;
            PG8_STAGE(PG8_SB(1, 1), b3 + hstep, voffB);
            PG8_WAIT_V(6); PG8_BAR; PG8_MMA(1, 1, At, B1); PG8_BAR;
            }
        }
        if constexpr (ALIGN_EPI) { if (wr == 0) PG8_BAR; }
        if constexpr (!Epi::AFTER_DRAIN) { E(acc, cur, wr, wc, fr, fq); S.done(cur); }
        if (!has_next) break;
#pragma unroll
        for (int a = 0; a < 2; ++a)
#pragma unroll
            for (int b = 0; b < 2; ++b)
#pragma unroll
                for (int m = 0; m < 4; ++m)
#pragma unroll
                    for (int n = 0; n < 2; ++n) acc[a][b][m][n] = (f32x4){0.f, 0.f, 0.f, 0.f};
        cur = nxt; cA = nA; cB = nB; ++ui;
        if constexpr (ALIGN_EPI) { if (wr == 1) PG8_BAR; }
    }
    PG8_WAIT_V(0);
    if constexpr (!ALIGN_EPI) { if (wr == 0) PG8_BAR; }
    PG8_BAR;
    if constexpr (Epi::AFTER_DRAIN) { E.fused(acc, cur, wr, wc, fr, fq, lds, wid, lane); S.done(cur); }
#undef PG8_SA
#undef PG8_SB
#undef PG8_STAGE
#undef PG8_LDA
#undef PG8_LDB
#undef PG8_MMA
#undef PG8_WAIT_V
#undef PG8_WAIT_L
#undef PG8_BAR
#undef PG8_SCHED
}
}

constexpr int NB = 4, SEQ = 2048, DM = 2048, MTOK = NB * SEQ;
constexpr int INW = 15424, DFF = 5632;
constexpr int ZW = 15616;
constexpr int ZGQ = 0, ZGK = 1024, ZGV = 2048, ZGR = 4096, ZNQ = 6144, ZNKV = 8192, ZMG = 11264, ZGLR = 15360, ZNG = 15376;
constexpr float RMS_EPS = 1e-6f;
constexpr size_t MiB = 1u << 20;
constexpr size_t WS_CTL = 0, CTL_ZERO_BYTES = 1 * MiB;
constexpr size_t WS_BIAS1 = 4096;
constexpr size_t WS_WINT = 1 * MiB, WS_WPG = 62 * MiB, WS_WPN = 70 * MiB, WS_WOUT = 78 * MiB, WS_W1T = 86 * MiB, WS_W2T = 90 * MiB;
constexpr size_t WS_KC = 91 * MiB, WS_VCT = 91 * MiB + 512 * 1024, WS_DECAY = 92 * MiB, WS_VTS = 93 * MiB, WS_VTW = 101 * MiB, WS_ATT = 109 * MiB;
constexpr size_t WS_QD = 113 * MiB, WS_KET = 129 * MiB, WS_ON = 113 * MiB  ;
constexpr size_t WS_BUFA = 145 * MiB  , WS_BUFB = 177 * MiB  , WS_Z = 209 * MiB;
constexpr size_t WS_WGU = 209 * MiB, WS_WD = 253 * MiB, WS_ACT = 275 * MiB  ;
constexpr size_t WS_END = 453 * MiB;
constexpr int LDS_BYTES = 147456;

#define LAS __attribute__((address_space(3)))
#define DI __device__ __forceinline__
typedef unsigned short bf16;
typedef unsigned v4u __attribute__((ext_vector_type(4)));
typedef unsigned v2u __attribute__((ext_vector_type(2)));
typedef float f32x4 __attribute__((ext_vector_type(4)));
typedef float f32x16 __attribute__((ext_vector_type(16)));
typedef short bf16x8 __attribute__((ext_vector_type(8)));
typedef float f32x2_t __attribute__((ext_vector_type(2)));
typedef __bf16 bf16x2_t __attribute__((ext_vector_type(2)));
#define MFMA32(a, b, c) __builtin_amdgcn_mfma_f32_32x32x16_bf16((a), (b), (c), 0, 0, 0)
#define MFMA16(a, b, c) __builtin_amdgcn_mfma_f32_16x16x32_bf16((a), (b), (c), 0, 0, 0)
#define LDS_WAIT() asm volatile("s_waitcnt lgkmcnt(0)" ::: "memory")

DI unsigned f2bf(float f) { unsigned u = __builtin_bit_cast(unsigned, f); return (u + 0x7fffu + ((u >> 16) & 1u)) >> 16; }
DI unsigned pk2(float lo, float hi) { f32x2_t v = {lo, hi}; bf16x2_t b = __builtin_convertvector(v, bf16x2_t); return __builtin_bit_cast(unsigned, b); }
DI float bf2f(bf16 b) { return __uint_as_float(((unsigned)b) << 16); }
DI float blo(unsigned w) { return __uint_as_float(w << 16); }
DI float bhi(unsigned w) { return __uint_as_float(w & 0xffff0000u); }
DI float sigm(float x) { return 1.0f / (1.0f + __expf(-x)); }
DI float wave_sum(float v) {
#pragma unroll
    for (int o = 1; o < 64; o <<= 1) v += __shfl_xor(v, o);
    return v;
}
DI bf16x8 pack8(float a0, float a1, float a2, float a3, float a4, float a5, float a6, float a7) {
    v4u p; p.x = pk2(a0, a1); p.y = pk2(a2, a3); p.z = pk2(a4, a5); p.w = pk2(a6, a7); return __builtin_bit_cast(bf16x8, p);
}

struct Args {
    const float* in[20]; float* out; unsigned char* ws; int ph_lo, ph_hi;
};
struct Frame {
    LAS unsigned char* lds; int tid, lane, wave, G, bid;
    const float* x; const float* g_mix; const float* w_in; const float* w_gla_gate; const float* b_gla_gate; const float* g_gla_out;
    const float* pe_k; const float* w_ck1; const float* w_ck2; const float* pe_v; const float* w_cv1; const float* w_cv2;
    const float* w_pg; const float* w_pn; const float* w_out; const float* g_ffn; const float* w_fg; const float* w_fu; const float* w_fd; const float* g_final;
    float* out; unsigned char* ws;
};

struct MapId { DI int operator()(int n) const { return n; } };
struct MapOff { int off; DI int operator()(int n) const { return n + off; } };
struct MapWin { DI int operator()(int n) const {
    if (n < 6144) return n; if (n < 6160) return ZGLR + (n - 6144); if (n < 8208) return ZNQ + (n - 6160);
    if (n < 11280) return ZNKV + (n - 8208); if (n < 11328) return ZNG + (n - 11280); return ZMG + (n - 11328); } };
struct MapGU { int up; DI int operator()(int n) const { return (n >> 7) * 256 + up * 128 + (n & 127); } };

template <class Map>
DI void transpose_item(const float* __restrict__ W, int N, bf16* __restrict__ WT, int Kp, LAS float* scr, int item, int lane, const Map map) {
    const int nblk = N / 32, kb = item / nblk, nb = item - kb * nblk, k0 = 64 * kb, n0 = 32 * nb;
#pragma unroll 8
    for (int i = 0; i < 32; ++i) { const int kk = 2 * i + (lane >> 5); scr[kk * 33 + (lane & 31)] = W[(size_t)(k0 + kk) * N + n0 + (lane & 31)]; }
    LDS_WAIT();
    const int c = lane & 7;
#pragma unroll
    for (int j = 0; j < 4; ++j) { const int n = (lane >> 3) + 8 * j; const LAS float* s = scr + (8 * c) * 33 + n;
        v4u o; o.x = pk2(s[0 * 33], s[1 * 33]); o.y = pk2(s[2 * 33], s[3 * 33]); o.z = pk2(s[4 * 33], s[5 * 33]); o.w = pk2(s[6 * 33], s[7 * 33]);
        *(v4u*)(WT + (size_t)map(n0 + n) * Kp + k0 + 8 * c) = o; }
    LDS_WAIT();
}
template <bool TO_BF16>
DI void rms_row(const float* __restrict__ xrow, const float* __restrict__ g, void* orow, int lane) {
    const f32x4* xr = (const f32x4*)xrow + lane; const f32x4* gr = (const f32x4*)g + lane;
    f32x4 v[8]; float s = 0.f;
#pragma unroll
    for (int j = 0; j < 8; ++j) { v[j] = xr[64 * j]; s += (v[j].x * v[j].x + v[j].y * v[j].y) + (v[j].z * v[j].z + v[j].w * v[j].w); }
    const float rs = rsqrtf(wave_sum(s) * (1.f / DM) + RMS_EPS);
#pragma unroll
    for (int j = 0; j < 8; ++j) { const f32x4 gg = gr[64 * j]; const f32x4 o = v[j] * rs * gg;
        if (TO_BF16) { v2u w; w.x = pk2(o.x, o.y); w.y = pk2(o.z, o.w); ((v2u*)orow)[lane + 64 * j] = w; }
        else ((f32x4*)orow)[lane + 64 * j] = o; }
}

DI void p0_prologue(Frame& F) {
    LAS float* scr = (LAS float*)(F.lds + F.wave * 8448);
    const int gw = F.bid * 8 + F.wave, NGW = F.G * 8;
    bf16* WINT = (bf16*)(F.ws + WS_WINT); bf16* WPG = (bf16*)(F.ws + WS_WPG); bf16* WPN = (bf16*)(F.ws + WS_WPN); bf16* WOUT = (bf16*)(F.ws + WS_WOUT);
    bf16* W1T = (bf16*)(F.ws + WS_W1T); bf16* W2T = (bf16*)(F.ws + WS_W2T);
    constexpr int I_IN = (DM / 64) * (INW / 32), I_P = (DM / 64) * (DM / 32), I_C1 = (4096 / 64) * (256 / 32), I_C2 = (256 / 64) * (128 / 32);
    constexpr int NITEMS = I_IN + 3 * I_P + 2 * I_C1 + 2 * I_C2;
    for (int it = gw; it < NITEMS; it += NGW) {
        int r = it;
        if (r < I_IN) { transpose_item(F.w_in, INW, WINT, DM, scr, r, F.lane, MapWin{}); continue; } r -= I_IN;
        if (r < I_P) { transpose_item(F.w_pg, DM, WPG, DM, scr, r, F.lane, MapId{}); continue; } r -= I_P;
        if (r < I_P) { transpose_item(F.w_pn, DM, WPN, DM, scr, r, F.lane, MapId{}); continue; } r -= I_P;
        if (r < I_P) { transpose_item(F.w_out, DM, WOUT, DM, scr, r, F.lane, MapId{}); continue; } r -= I_P;
        if (r < I_C1) { transpose_item(F.w_ck1, 256, W1T, 4096, scr, r, F.lane, MapId{}); continue; } r -= I_C1;
        if (r < I_C1) { transpose_item(F.w_cv1, 256, W1T, 4096, scr, r, F.lane, MapOff{256}); continue; } r -= I_C1;
        if (r < I_C2) { transpose_item(F.w_ck2, 128, W2T, 256, scr, r, F.lane, MapId{}); continue; } r -= I_C2;
        transpose_item(F.w_cv2, 128, W2T, 256, scr, r, F.lane, MapOff{128});
    }
    bf16* H = (bf16*)(F.ws + WS_BUFA);
    for (int m = gw; m < MTOK; m += NGW) rms_row<true>(F.x + (size_t)m * DM, F.g_mix, H + (size_t)m * DM, F.lane);
    float* bias1 = (float*)(F.ws + WS_BIAS1);
    for (int it = gw; it < 128; it += NGW) {
        const int which = it >> 6, kc = it & 63; const float* pe = which ? F.pe_v : F.pe_k; const float* w1 = which ? F.w_cv1 : F.w_ck1;
        float a[4] = {0.f, 0.f, 0.f, 0.f};
        for (int kk = kc * 64; kk < kc * 64 + 64; ++kk) { const float p = pe[kk];
#pragma unroll
            for (int q = 0; q < 4; ++q) a[q] += p * w1[(size_t)kk * 256 + F.lane + 64 * q]; }
#pragma unroll
        for (int q = 0; q < 4; ++q) atomicAdd(bias1 + which * 256 + F.lane + 64 * q, a[q]);
    }
}
DI void p7_norm_ffnw(Frame& F) {
    LAS float* scr = (LAS float*)(F.lds + F.wave * 8448);
    const int gw = F.bid * 8 + F.wave, NGW = F.G * 8;
    bf16* WGU = (bf16*)(F.ws + WS_WGU); bf16* WD = (bf16*)(F.ws + WS_WD);
    constexpr int I_G = (DM / 64) * (DFF / 32), I_D = (DFF / 64) * (DM / 32);
    for (int it = gw; it < 2 * I_G + I_D; it += NGW) {
        int r = it;
        if (r < I_G) { transpose_item(F.w_fg, DFF, WGU, DM, scr, r, F.lane, MapGU{0}); continue; } r -= I_G;
        if (r < I_G) { transpose_item(F.w_fu, DFF, WGU, DM, scr, r, F.lane, MapGU{1}); continue; } r -= I_G;
        transpose_item(F.w_fd, DM, WD, DFF, scr, r, F.lane, MapId{});
    }
    bf16* H2 = (bf16*)(F.ws + WS_BUFB);
    for (int m = gw; m < MTOK; m += NGW) rms_row<true>(F.out + (size_t)m * DM, F.g_ffn, H2 + (size_t)m * DM, F.lane);
}
DI void p10_final(Frame& F) {
    const int gw = F.bid * 8 + F.wave, NGW = F.G * 8;
    for (int m = gw; m < MTOK; m += NGW) rms_row<false>(F.out + (size_t)m * DM, F.g_final, F.out + (size_t)m * DM, F.lane);
}

DI void g1_item(Frame& F, int item) {
    const bf16* Z = (const bf16*)(F.ws + WS_Z);
    bf16* QD = (bf16*)(F.ws + WS_QD); bf16* KET = (bf16*)(F.ws + WS_KET); bf16* ATT = (bf16*)(F.ws + WS_ATT); float* DECAY = (float*)(F.ws + WS_DECAY);
    const int bh = item >> 5, c = item & 31, b = bh >> 2, h = bh & 3;
    const size_t t0 = (size_t)b * SEQ + c * 64;
    LAS float* glr_s = (LAS float*)(F.lds);
    LAS float* tot_s = (LAS float*)(F.lds + 4096);
    LAS bf16* qd_s = (LAS bf16*)(F.lds + 8192);
    LAS bf16* kd_s = (LAS bf16*)(F.lds + 8192 + 33792);
    const int tid = F.tid, dk = tid & 255, half = tid >> 8;
    for (int e = tid; e < 1024; e += 512) { const int tok = e >> 4, r = e & 15; glr_s[e] = bf2f(Z[(t0 + tok) * ZW + ZGLR + r]); }
    float wg[16];
#pragma unroll
    for (int r = 0; r < 16; ++r) wg[r] = F.w_gla_gate[r * 1024 + h * 256 + dk];
    const float bg = F.b_gla_gate[h * 256 + dk];
    __syncthreads();
    float bc[32]; float run = 0.f;
#pragma unroll
    for (int i = 0; i < 32; ++i) { const int tok = half * 32 + i; float xg = bg;
        const LAS f32x4* gp = (const LAS f32x4*)(glr_s + tok * 16);
#pragma unroll
        for (int r4 = 0; r4 < 4; ++r4) { const f32x4 gv = gp[r4]; xg += gv.x * wg[4 * r4] + gv.y * wg[4 * r4 + 1] + gv.z * wg[4 * r4 + 2] + gv.w * wg[4 * r4 + 3]; }
        const float ls = fminf(xg, 0.f) - __logf(1.0f + __expf(-fabsf(xg)));
        run += ls * 0.0625f; bc[i] = run; }
    tot_s[half * 256 + dk] = run;
    __syncthreads();
    const float tot0 = tot_s[dk], tot1 = tot_s[256 + dk]; const float blast = tot0 + tot1, boff = half ? tot0 : 0.f;
    unsigned kep[16];
#pragma unroll
    for (int i = 0; i < 32; i += 2) { float ke2[2];
#pragma unroll
        for (int e = 0; e < 2; ++e) { const int tok = half * 32 + i + e; const float bb = bc[i + e] + boff;
            const float q = bf2f(Z[(t0 + tok) * ZW + ZGQ + h * 256 + dk]), k = bf2f(Z[(t0 + tok) * ZW + ZGK + h * 256 + dk]);
            const float qd = q * 0.0625f * __expf(bb), kd = k * __expf(-bb); ke2[e] = k * __expf(blast - bb);
            const bf16 qb = (bf16)f2bf(qd); qd_s[tok * 264 + dk] = qb; kd_s[tok * 264 + dk] = (bf16)f2bf(kd); QD[(t0 + tok) * 1024 + h * 256 + dk] = qb; }
        kep[i >> 1] = pk2(ke2[0], ke2[1]); }
    { v4u* kp = (v4u*)(KET + ((size_t)item * 256 + dk) * 64 + half * 32);
#pragma unroll
      for (int q = 0; q < 4; ++q) { v4u w; w.x = kep[4 * q]; w.y = kep[4 * q + 1]; w.z = kep[4 * q + 2]; w.w = kep[4 * q + 3]; kp[q] = w; } }
    if (half == 0) DECAY[(size_t)item * 256 + dk] = __expf(blast);
    __syncthreads();
    const int w = F.wave, fr = F.lane & 15, fq = F.lane >> 4, mt = w >> 1;
#pragma unroll
    for (int nn = 0; nn < 2; ++nn) { const int nt = (w & 1) * 2 + nn; f32x4 acc = {0.f, 0.f, 0.f, 0.f};
        if (nt <= mt) {
#pragma unroll
            for (int s = 0; s < 8; ++s) { const bf16x8 a = *(const LAS bf16x8*)(qd_s + (16 * mt + fr) * 264 + 32 * s + 8 * fq); const bf16x8 bb = *(const LAS bf16x8*)(kd_s + (16 * nt + fr) * 264 + 32 * s + 8 * fq);
                acc = MFMA16(a, bb, acc); } }
#pragma unroll
        for (int j = 0; j < 4; ++j) { const int row = 16 * mt + 4 * fq + j, col = 16 * nt + fr; const float v = (col <= row) ? acc[j] : 0.f;
            ATT[(size_t)item * 4096 + row * 64 + col] = (bf16)f2bf(v); } }
    __syncthreads();
}

DI void n1_item(Frame& F, int item) {
    const bf16* Z = (const bf16*)(F.ws + WS_Z);
    const bf16* W1T = (const bf16*)(F.ws + WS_W1T); const bf16* W2T = (const bf16*)(F.ws + WS_W2T); const float* bias1 = (const float*)(F.ws + WS_BIAS1);
    bf16* KC = (bf16*)(F.ws + WS_KC); bf16* VCT = (bf16*)(F.ws + WS_VCT);
    const int which = item >> 6, b = (item >> 4) & 3, hk = (item >> 2) & 3, j = item & 3;
    const int w = F.wave, r = F.lane & 31, hh = F.lane >> 5;
    LAS bf16* hid = (LAS bf16*)(F.lds);
    int crow_ = 32 * j + r; if (crow_ > 126) crow_ = 126;
    const bf16* ap = Z + ((size_t)b * SEQ + 16 * crow_) * ZW + ZNKV + which * 512 + hk * 128 + 8 * hh;
    const bf16* bp = W1T + ((size_t)which * 256 + 32 * w + r) * 4096 + 8 * hh;
    f32x16 acc; for (int i = 0; i < 16; ++i) acc[i] = 0.f;
    bf16x8 fa[2][8], fb[2][8];
#pragma unroll
    for (int s = 0; s < 8; ++s) { fa[0][s] = *(const bf16x8*)(ap + 16 * s); fb[0][s] = *(const bf16x8*)(bp + 16 * s); }
#pragma unroll 1
    for (int tk = 0; tk < 32; tk += 2) {
#pragma unroll
        for (int s = 0; s < 8; ++s) { fa[1][s] = *(const bf16x8*)(ap + (size_t)(tk + 1) * ZW + 16 * s); fb[1][s] = *(const bf16x8*)(bp + (tk + 1) * 128 + 16 * s); }
#pragma unroll
        for (int s = 0; s < 8; ++s) acc = MFMA32(fa[0][s], fb[0][s], acc);
        const int t2 = (tk + 2 < 32) ? tk + 2 : 0;
#pragma unroll
        for (int s = 0; s < 8; ++s) { fa[0][s] = *(const bf16x8*)(ap + (size_t)t2 * ZW + 16 * s); fb[0][s] = *(const bf16x8*)(bp + t2 * 128 + 16 * s); }
#pragma unroll
        for (int s = 0; s < 8; ++s) acc = MFMA32(fa[1][s], fb[1][s], acc);
    }
    { const float bs = bias1[which * 256 + 32 * w + r];
#pragma unroll
      for (int i = 0; i < 16; ++i) { const int row = (i & 3) + 8 * (i >> 2) + 4 * hh; const float v = acc[i] + bs; hid[row * 264 + 32 * w + r] = (bf16)f2bf(v * sigm(v)); } }
    __syncthreads();
    if (w < 4) {
        f32x16 o; for (int i = 0; i < 16; ++i) o[i] = 0.f;
        const bf16* b2 = W2T + ((size_t)which * 128 + 32 * w + r) * 256 + 8 * hh;
#pragma unroll
        for (int s = 0; s < 16; ++s) { const bf16x8 a = *(const LAS bf16x8*)(hid + r * 264 + 16 * s + 8 * hh); const bf16x8 bb = *(const bf16x8*)(b2 + 16 * s); o = MFMA32(a, bb, o); }
        const int d = 32 * w + r;
        if (which == 0) {
#pragma unroll
            for (int i = 0; i < 16; ++i) { const int cc = 32 * j + (i & 3) + 8 * (i >> 2) + 4 * hh; KC[(((size_t)b * 4 + hk) * 128 + cc) * 128 + d] = (bf16)f2bf(o[i]); }
        } else {
#pragma unroll
            for (int a4 = 0; a4 < 4; ++a4) { v2u wv; wv.x = pk2(o[4 * a4], o[4 * a4 + 1]); wv.y = pk2(o[4 * a4 + 2], o[4 * a4 + 3]);
                *(v2u*)(VCT + (((size_t)b * 4 + hk) * 128 + d) * 128 + 32 * j + 8 * a4 + 4 * hh) = wv; }
        }
    }
    __syncthreads();
}
DI void vt_item(Frame& F, int item) {
    const bf16* Z = (const bf16*)(F.ws + WS_Z);
    const int dhalf = item & 1, tile = (item >> 1) & 31, hk = (item >> 6) & 3, b = (item >> 8) & 3, which = item >> 10;
    bf16* VT = (bf16*)(F.ws + (which ? WS_VTW : WS_VTS));
    LAS bf16* scr = (LAS bf16*)(F.lds + F.wave * 8448);
    const int lane = F.lane;
    const bf16* src = Z + ((size_t)b * SEQ + tile * 64) * ZW + ZNKV + (3 + 2 * which) * 512 + hk * 128 + dhalf * 64;
#pragma unroll
    for (int p = 0; p < 8; ++p) { const int tok = 8 * p + (lane >> 3), d8 = (lane & 7) * 8; const v4u v = *(const v4u*)(src + (size_t)tok * ZW + d8);
        LAS unsigned* dst = (LAS unsigned*)(scr + tok * 66 + d8); dst[0] = v.x; dst[1] = v.y; dst[2] = v.z; dst[3] = v.w; }
    LDS_WAIT();
#pragma unroll
    for (int p = 0; p < 8; ++p) { const int d = 8 * p + (lane >> 3), t8 = (lane & 7) * 8; unsigned short e[8];
#pragma unroll
        for (int q = 0; q < 8; ++q) e[q] = scr[(t8 + q) * 66 + d];
        v4u o; o.x = e[0] | ((unsigned)e[1] << 16); o.y = e[2] | ((unsigned)e[3] << 16); o.z = e[4] | ((unsigned)e[5] << 16); o.w = e[6] | ((unsigned)e[7] << 16);
        *(v4u*)(VT + (((size_t)b * 4 + hk) * 128 + dhalf * 64 + d) * SEQ + tile * 64 + t8) = o; }
    LDS_WAIT();
}
DI void p2_prep(Frame& F) {
    if (F.G == 256) {
        if (F.bid < 128) { n1_item(F, F.bid); g1_item(F, F.bid); }
        else { for (int k = 0; k < 3; ++k) g1_item(F, 128 + (F.bid - 128) * 3 + k); }
    } else { for (int it = F.bid; it < 128 + 512; it += F.G) { if (it < 128) n1_item(F, it); else g1_item(F, it - 128); } }
    __syncthreads();
    const int gw = F.bid * 8 + F.wave, NGW = F.G * 8;
    for (int it = gw; it < 2048; it += NGW) vt_item(F, it);
}

DI void g2_item(Frame& F, int item) {
    const bf16* Z = (const bf16*)(F.ws + WS_Z);
    const bf16* QD = (const bf16*)(F.ws + WS_QD); const bf16* KET = (const bf16*)(F.ws + WS_KET); const bf16* ATT = (const bf16*)(F.ws + WS_ATT); const float* DECAY = (const float*)(F.ws + WS_DECAY);
    float* O = F.out;
    const int bh = item >> 4, js = item & 15, b = bh >> 2, h = bh & 3;
    LAS bf16* ST = (LAS bf16*)(F.lds);
    LAS bf16* VT = (LAS bf16*)(F.lds + 16896);
    const int tid = F.tid, w = F.wave, fr = F.lane & 15, fq = F.lane >> 4, mt = w >> 1, nt = w & 1;
    for (int e = tid; e < 4224; e += 512) ((LAS unsigned*)ST)[e] = 0u;
    f32x4 Sacc[2][2];
#pragma unroll
    for (int a = 0; a < 2; ++a)
#pragma unroll
        for (int c2 = 0; c2 < 2; ++c2) Sacc[a][c2] = (f32x4){0.f, 0.f, 0.f, 0.f};
    const int vtok = tid >> 3, vd4 = (tid & 7) * 4;
    const size_t vcol = ZGV + h * 512 + 32 * js;
    v2u vv_n; bf16x8 aatt_n[2], aqd_n[8], aket_n[2][2]; f32x4 dec_n[2];
#define G2_LOAD(cc) do { const size_t itemc_ = (size_t)bh * 32 + (cc), t0_ = (size_t)b * SEQ + (cc) * 64; \
        vv_n = *(const v2u*)(Z + (t0_ + vtok) * ZW + vcol + vd4); \
        _Pragma("unroll") for (int s = 0; s < 2; ++s) aatt_n[s] = *(const bf16x8*)(ATT + itemc_ * 4096 + (16 * mt + fr) * 64 + 32 * s + 8 * fq); \
        _Pragma("unroll") for (int s = 0; s < 8; ++s) aqd_n[s] = *(const bf16x8*)(QD + (t0_ + 16 * mt + fr) * 1024 + h * 256 + 32 * s + 8 * fq); \
        _Pragma("unroll") for (int mi = 0; mi < 2; ++mi) { \
            _Pragma("unroll") for (int s = 0; s < 2; ++s) aket_n[mi][s] = *(const bf16x8*)(KET + (itemc_ * 256 + 32 * w + 16 * mi + fr) * 64 + 32 * s + 8 * fq); \
            dec_n[mi] = *(const f32x4*)(DECAY + itemc_ * 256 + 32 * w + 16 * mi + 4 * fq); } } while (0)
    G2_LOAD(0);
    for (int c = 0; c < 32; ++c) {
        const size_t t0 = (size_t)b * SEQ + c * 64;
        const v2u vv = vv_n;
        bf16x8 aatt[2], aqd[8], aket[2][2]; f32x4 dec[2];
#pragma unroll
        for (int s = 0; s < 2; ++s) aatt[s] = aatt_n[s];
#pragma unroll
        for (int s = 0; s < 8; ++s) aqd[s] = aqd_n[s];
#pragma unroll
        for (int mi = 0; mi < 2; ++mi) { aket[mi][0] = aket_n[mi][0]; aket[mi][1] = aket_n[mi][1]; dec[mi] = dec_n[mi]; }
        if (c + 1 < 32) G2_LOAD(c + 1);
        VT[(vd4 + 0) * 72 + vtok] = (bf16)(vv.x & 0xffffu); VT[(vd4 + 1) * 72 + vtok] = (bf16)(vv.x >> 16);
        VT[(vd4 + 2) * 72 + vtok] = (bf16)(vv.y & 0xffffu); VT[(vd4 + 3) * 72 + vtok] = (bf16)(vv.y >> 16);
        __syncthreads();
        f32x4 o = {0.f, 0.f, 0.f, 0.f};
#pragma unroll
        for (int s = 0; s < 2; ++s) { const bf16x8 bb = *(const LAS bf16x8*)(VT + (16 * nt + fr) * 72 + 32 * s + 8 * fq); o = MFMA16(aatt[s], bb, o); }
#pragma unroll
        for (int s = 0; s < 8; ++s) { const bf16x8 bb = *(const LAS bf16x8*)(ST + (16 * nt + fr) * 264 + 32 * s + 8 * fq); o = MFMA16(aqd[s], bb, o); }
#pragma unroll
        for (int jj = 0; jj < 4; ++jj) O[(t0 + 16 * mt + 4 * fq + jj) * 2048 + h * 512 + 32 * js + 16 * nt + fr] = o[jj];
#pragma unroll
        for (int mi = 0; mi < 2; ++mi)
#pragma unroll
            for (int ni = 0; ni < 2; ++ni) { f32x4 a = Sacc[mi][ni] * dec[mi];
#pragma unroll
                for (int s = 0; s < 2; ++s) { const bf16x8 bb = *(const LAS bf16x8*)(VT + (16 * ni + fr) * 72 + 32 * s + 8 * fq); a = MFMA16(aket[mi][s], bb, a); }
                Sacc[mi][ni] = a; }
        __syncthreads();
#pragma unroll
        for (int mi = 0; mi < 2; ++mi)
#pragma unroll
            for (int ni = 0; ni < 2; ++ni) { v2u wv; wv.x = pk2(Sacc[mi][ni][0], Sacc[mi][ni][1]); wv.y = pk2(Sacc[mi][ni][2], Sacc[mi][ni][3]);
                *(LAS v2u*)(ST + (16 * ni + fr) * 264 + 32 * w + 16 * mi + 4 * fq) = wv; }
    }
    __syncthreads();
}
#undef G2_LOAD
DI void p3_scan(Frame& F) { for (int it = F.bid; it < 256; it += F.G) g2_item(F, it); }

DI void gla_out_row(Frame& F, int rowh) {
    const bf16* Z = (const bf16*)(F.ws + WS_Z); bf16* OG = (bf16*)(F.ws + WS_BUFB);
    const int t = rowh >> 2, h = rowh & 3, lane = F.lane;
    const f32x4* op = (const f32x4*)(F.out + (size_t)t * 2048 + h * 512) + lane;
    const f32x4 a = op[0], bq = op[64];
    float s = (a.x * a.x + a.y * a.y) + (a.z * a.z + a.w * a.w) + (bq.x * bq.x + bq.y * bq.y) + (bq.z * bq.z + bq.w * bq.w);
    const float rs = rsqrtf(wave_sum(s) * (1.f / 512.f) + RMS_EPS);
#pragma unroll
    for (int q = 0; q < 2; ++q) { const f32x4 v = q ? bq : a; const f32x4 g = ((const f32x4*)F.g_gla_out)[lane + 64 * q];
        const v2u rw = *(const v2u*)(Z + (size_t)t * ZW + ZGR + h * 512 + 4 * lane + 256 * q);
        const float r0 = blo(rw.x), r1 = bhi(rw.x), r2 = blo(rw.y), r3 = bhi(rw.y);
        v2u w; w.x = pk2(v.x * rs * g.x * (r0 * sigm(r0)), v.y * rs * g.y * (r1 * sigm(r1))); w.y = pk2(v.z * rs * g.z * (r2 * sigm(r2)), v.w * rs * g.w * (r3 * sigm(r3)));
        *(v2u*)(OG + (size_t)t * 2048 + h * 512 + 4 * lane + 256 * q) = w; }
}
DI int pi_key(int r) { return (r & ~12) | ((r & 4) << 1) | ((r & 8) >> 1); }

constexpr int KB_PITCH = 272, VB_PITCH = 144, KB_BYTES = 64 * KB_PITCH, KV_BUF = KB_BYTES + 128 * VB_PITCH;
constexpr int NSA_X = 2 * KV_BUF;
constexpr int NSA_IMPR = KV_BUF  , NSA_MSK = NSA_X + 69632, NSA_END = NSA_MSK + 256;
static_assert(NSA_END <= LDS_BYTES, "NSA LDS map");
struct TileRegs { v4u k[2], v[2]; };
DI void tile_gload(TileRegs& R, const bf16* kg, size_t kpitch, const bf16* vg, size_t vpitch, int tid) {
#pragma unroll
    for (int j = 0; j < 2; ++j) { const int c = tid + 512 * j;
        R.k[j] = *(const v4u*)(kg + (size_t)(c >> 4) * kpitch + (c & 15) * 8); R.v[j] = *(const v4u*)(vg + (size_t)(c >> 3) * vpitch + (c & 7) * 8); }
}
DI void tile_sstore(const TileRegs& R, LAS unsigned char* buf, int tid) {
#pragma unroll
    for (int j = 0; j < 2; ++j) { const int c = tid + 512 * j;
        *(LAS v4u*)(buf + (c >> 4) * KB_PITCH + (c & 15) * 16) = R.k[j]; *(LAS v4u*)(buf + KB_BYTES + (c >> 3) * VB_PITCH + (c & 7) * 16) = R.v[j]; }
}
DI void qk_lds(f32x16& x0, f32x16& x1, const LAS unsigned char* kb, const bf16x8 (&qf)[8]) {
#pragma unroll
    for (int i = 0; i < 16; ++i) { x0[i] = 0.f; x1[i] = 0.f; }
#pragma unroll
    for (int s = 0; s < 8; ++s) { const bf16x8 a0 = *(const LAS bf16x8*)(kb + 32 * s); const bf16x8 a1 = *(const LAS bf16x8*)(kb + 32 * KB_PITCH + 32 * s);
        x0 = MFMA32(a0, qf[s], x0); x1 = MFMA32(a1, qf[s], x1); }
}
DI void pv_lds(f32x16 (&o)[4], const f32x16& p0, const f32x16& p1, const LAS unsigned char* vb) {
#pragma unroll
    for (int mt = 0; mt < 2; ++mt)
#pragma unroll
        for (int s2 = 0; s2 < 2; ++s2) { const f32x16& p = mt ? p1 : p0;
            const bf16x8 pf = pack8(p[8 * s2], p[8 * s2 + 1], p[8 * s2 + 2], p[8 * s2 + 3], p[8 * s2 + 4], p[8 * s2 + 5], p[8 * s2 + 6], p[8 * s2 + 7]);
#pragma unroll
            for (int dt = 0; dt < 4; ++dt) { const bf16x8 a = *(const LAS bf16x8*)(vb + (32 * dt) * VB_PITCH + (32 * mt + 16 * s2) * 2); o[dt] = MFMA32(a, pf, o[dt]); } }
}
DI void softmax_step(f32x16& x0, f32x16& x1, float& m, float& l, f32x16 (&o)[4], bool rowok, float CS) {
    float mx = fmaxf(x0[0], x1[0]);
#pragma unroll
    for (int i = 1; i < 16; ++i) mx = fmaxf(mx, fmaxf(x0[i], x1[i]));
    mx = rowok ? mx : -INFINITY;
    mx = fmaxf(mx, __shfl_xor(mx, 32));
    const float mnew = fmaxf(m, mx);
    const bool need = (mnew - m) > 62.0f;
    if (__any(need)) {
        const float m2 = need ? mnew : m; const float alpha = __builtin_amdgcn_exp2f((m - m2) * CS); m = m2; l *= alpha;
#pragma unroll
        for (int dt = 0; dt < 4; ++dt) o[dt] = o[dt] * alpha;
    }
    const float negmc = rowok ? -m * CS : -INFINITY;
    float ps0 = 0.f, ps1 = 0.f;
#pragma unroll
    for (int i = 0; i < 16; ++i) { x0[i] = __builtin_amdgcn_exp2f(__builtin_fmaf(x0[i], CS, negmc)); x1[i] = __builtin_amdgcn_exp2f(__builtin_fmaf(x1[i], CS, negmc)); ps0 += x0[i]; ps1 += x1[i]; }
    l += ps0 + ps1;
}

DI void nsa_item(Frame& F, int item) {
    const bf16* Z = (const bf16*)(F.ws + WS_Z);
    const bf16* KC = (const bf16*)(F.ws + WS_KC); const bf16* VCT = (const bf16*)(F.ws + WS_VCT); const bf16* VTS = (const bf16*)(F.ws + WS_VTS); const bf16* VTW = (const bf16*)(F.ws + WS_VTW);
    bf16* ON = (bf16*)(F.ws + WS_ON);
    const int qt = item & 31, hk = (item >> 5) & 3, b = item >> 7;
    int tid = F.tid; asm volatile("" : "+v"(tid));
    const int w = F.wave, lane = tid & 63, r = lane & 31, hh = lane >> 5, g = w >> 1, th = w & 1;
    const int head = hk * 4 + g, tl = 32 * th + r  , t = 64 * qt + tl;
    const size_t trow = (size_t)b * SEQ + t;
    LAS unsigned char* buf0 = F.lds; LAS unsigned char* buf1 = F.lds + KV_BUF;
    LAS float* part = (LAS float*)(F.lds + NSA_X);
    LAS unsigned* oacc = (LAS unsigned*)(F.lds + NSA_X);
    LAS float* impr = (LAS float*)(F.lds + NSA_IMPR);
    LAS unsigned* msk = (LAS unsigned*)(F.lds + NSA_MSK);
    constexpr float CS = 0.08838834764831845f * 1.4426950408889634f;
    int kboff = pi_key(r) * KB_PITCH + 16 * hh, vboff = KB_BYTES + r * VB_PITCH + 16 * hh;
    LAS unsigned* oacc_l = oacc + w * 2048 + lane;
    asm volatile("" : "+v"(kboff), "+v"(vboff), "+v"(oacc_l));
    const int nsel = qt + 1, wlo = qt > 8 ? qt - 8 : 0, ntile = nsel + (qt - wlo + 1);
    const bf16* ksel = Z + (size_t)b * SEQ * ZW + ZNKV + 2 * 512 + hk * 128; const bf16* kwin = ksel + 2 * 512;
    const bf16* vsel = VTS + ((size_t)b * 4 + hk) * 128 * SEQ; const bf16* vwin = VTW + ((size_t)b * 4 + hk) * 128 * SEQ;
    TileRegs R;
    {
        const bf16* kc = KC + ((size_t)b * 4 + hk) * 128 * 128; const bf16* vc = VCT + ((size_t)b * 4 + hk) * 128 * 128;
        TileRegs R1; tile_gload(R, kc, 128, vc, 128, tid); tile_gload(R1, kc + 64 * 128, 128, vc + 64, 128, tid);
        for (int e = tid; e < 17408; e += 512) part[e] = 0.f;
        if (tid < 64) msk[tid] = 0u;
        tile_sstore(R, buf0, tid); tile_sstore(R1, buf1, tid);
    }
    bf16x8 qf[8];
    { const bf16* qp = Z + trow * ZW + ZNQ + head * 128 + 8 * hh;
#pragma unroll
      for (int s = 0; s < 8; ++s) qf[s] = *(const bf16x8*)(qp + 16 * s); }
    const float gate_c = sigm(bf2f(Z[trow * ZW + ZNG + head])), gate_s = sigm(bf2f(Z[trow * ZW + ZNG + 16 + head])), gate_w = sigm(bf2f(Z[trow * ZW + ZNG + 32 + head]));
    tile_gload(R, ksel, ZW, vsel, SEQ, tid);
    f32x16 o[4];
#pragma unroll
    for (int dt = 0; dt < 4; ++dt)
#pragma unroll
        for (int i = 0; i < 16; ++i) o[dt][i] = 0.f;
    __syncthreads();
    {
        const int cmax = (t - 31) >> 4;
        float mx = -1e30f, ps = 0.f;
#pragma unroll 1
        for (int T = 0; T < 2; ++T) { f32x16 x0, x1; qk_lds(x0, x1, (T ? buf1 : buf0) + kboff, qf); float mm = -1e30f;
#pragma unroll
            for (int i = 0; i < 16; ++i) { const int cb = 64 * T + 16 * (i >> 3) + 8 * hh + (i & 7);
                x0[i] = (cb <= cmax) ? x0[i] * CS : -INFINITY; x1[i] = (cb + 32 <= cmax) ? x1[i] * CS : -INFINITY; mm = fmaxf(mm, fmaxf(x0[i], x1[i])); }
            mm = fmaxf(mm, __shfl_xor(mm, 32));
            const float mnew = fmaxf(mx, mm); float s = 0.f;
#pragma unroll
            for (int i = 0; i < 16; ++i) s += exp2f(x0[i] - mnew) + exp2f(x1[i] - mnew);
            ps = ps * exp2f(mx - mnew) + s; mx = mnew; }
        ps += __shfl_xor(ps, 32);
        const float inv = ps > 0.f ? 1.0f / ps : 0.f;
        LAS float* prow = part + ((size_t)(g * 64 + tl) * 34) * 2;
        asm volatile("" : "+v"(prow));
#pragma unroll 1
        for (int T = 0; T < 2; ++T) { f32x16 x0, x1; qk_lds(x0, x1, (T ? buf1 : buf0) + kboff, qf);
#pragma unroll
            for (int i = 0; i < 16; ++i) { const int cb = 64 * T + 16 * (i >> 3) + 8 * hh + (i & 7);
                const float s0 = (cb <= cmax) ? x0[i] * CS : -INFINITY, s1 = (cb + 32 <= cmax) ? x1[i] * CS : -INFINITY; x0[i] = exp2f(s0 - mx) * inv; x1[i] = exp2f(s1 - mx) * inv; }
#pragma unroll
            for (int mt = 0; mt < 2; ++mt)
#pragma unroll
                for (int s2 = 0; s2 < 2; ++s2) { const f32x16& p = mt ? x1 : x0;
                    const int n0 = 16 * T + 8 * mt + 4 * s2 + 2 * hh;
                    const float A = (p[8 * s2] + p[8 * s2 + 1]) + (p[8 * s2 + 2] + 0.5f * p[8 * s2 + 3]);
                    const float Bv = (0.5f * p[8 * s2 + 3] + p[8 * s2 + 4]) + (p[8 * s2 + 5] + p[8 * s2 + 6]) + 0.5f * p[8 * s2 + 7];
                    const float Cv = 0.5f * p[8 * s2 + 7];
                    prow[(n0) * 2] = A; prow[(n0 + 1) * 2] = Bv; prow[(n0 + 2) * 2 + 1] = Cv; }
            pv_lds(o, x0, x1, (T ? buf1 : buf0) + vboff); }
#pragma unroll
        for (int dt = 0; dt < 4; ++dt) o[dt] = o[dt] * gate_c;
    }
    __syncthreads();
    tile_sstore(R, buf0, tid);
#pragma unroll
    for (int k4 = 0; k4 < 4; ++k4) { const int e = tid + 512 * k4, tok = e >> 5, n = e & 31; float s = 0.f;
#pragma unroll
        for (int gg = 0; gg < 4; ++gg) { const LAS float* pp = part + ((size_t)(gg * 64 + tok) * 34 + n) * 2; s += pp[0] + pp[1]; }
        impr[tok * 33 + n] = s; }
    __syncthreads();
    if (qt < 16) { if (tid < 64) msk[tid] = (2u << qt) - 1u; }
    else {
#pragma unroll
        for (int k4 = 0; k4 < 4; ++k4) { const int e = tid + 512 * k4, tok = e >> 5, n = e & 31;
            if (n == 0) __hip_atomic_fetch_or(&msk[tok], 1u | (1u << qt) | (1u << (qt - 1)), __ATOMIC_RELAXED, __HIP_MEMORY_SCOPE_WORKGROUP);
            else if (n <= qt - 2) { const float v = impr[tok * 33 + n]; int rank = 0;
                for (int m2 = 1; m2 <= qt - 2; ++m2) { const float u = impr[tok * 33 + m2]; rank += (u > v || (u == v && m2 < n)) ? 1 : 0; }
                if (rank < 13) __hip_atomic_fetch_or(&msk[tok], 1u << n, __ATOMIC_RELAXED, __HIP_MEMORY_SCOPE_WORKGROUP); } }
    }
    __syncthreads();
    const unsigned mymask = msk[tl];
#pragma unroll
    for (int dt = 0; dt < 4; ++dt)
#pragma unroll
        for (int i = 0; i < 16; i += 2) oacc_l[(dt * 8 + (i >> 1)) * 64] = pk2(o[dt][i], o[dt][i + 1]);
#pragma unroll
    for (int dt = 0; dt < 4; ++dt)
#pragma unroll
        for (int i = 0; i < 16; ++i) o[dt][i] = 0.f;
    float m = -1e30f, l = 0.f;
    for (int i = 0; i < ntile; ++i) {
        if (i + 1 < ntile) { const int i1 = i + 1; const bool br = i1 >= nsel; const int n1 = br ? wlo + (i1 - nsel) : i1;
            tile_gload(R, (br ? kwin : ksel) + (size_t)(64 * n1) * ZW, ZW, (br ? vwin : vsel) + 64 * n1, SEQ, tid); }
        if (i == nsel) {
            l += __shfl_xor(l, 32);
            const float f = l > 0.f ? gate_s / l : 0.f;
#pragma unroll
            for (int dt = 0; dt < 4; ++dt)
#pragma unroll
                for (int i2 = 0; i2 < 16; i2 += 2) { LAS unsigned* ap = oacc_l + (dt * 8 + (i2 >> 1)) * 64; const unsigned pw = *ap;
                    *ap = pk2(blo(pw) + f * o[dt][i2], bhi(pw) + f * o[dt][i2 + 1]); o[dt][i2] = 0.f; o[dt][i2 + 1] = 0.f; }
            m = -1e30f; l = 0.f;
        }
        const bool win = i >= nsel; const int n = win ? wlo + (i - nsel) : i;
        LAS unsigned char* bufc = (i & 1) ? buf1 : buf0;
        f32x16 x0, x1; qk_lds(x0, x1, bufc + kboff, qf);
        const bool rowok = win ? true : (((mymask >> n) & 1u) != 0u);
        if (n == qt || (win && n == qt - 8)) {
            const int lim = t - 64 * n, lo_lim = win ? lim - 512 : -100000;
#pragma unroll
            for (int i2 = 0; i2 < 16; ++i2) { const int kk = 16 * (i2 >> 3) + 8 * hh + (i2 & 7);
                x0[i2] = (kk <= lim && kk > lo_lim) ? x0[i2] : -INFINITY; x1[i2] = (kk + 32 <= lim && kk + 32 > lo_lim) ? x1[i2] : -INFINITY; }
        }
        softmax_step(x0, x1, m, l, o, rowok, CS);
        pv_lds(o, x0, x1, bufc + vboff);
        if (i + 1 < ntile) tile_sstore(R, (i & 1) ? buf0 : buf1, tid);
        __syncthreads();
    }
    {
        l += __shfl_xor(l, 32);
        const float f = l > 0.f ? gate_w / l : 0.f;
        bf16* op = ON + trow * 2048 + head * 128 + 4 * hh;
#pragma unroll
        for (int dt = 0; dt < 4; ++dt)
#pragma unroll
            for (int a4 = 0; a4 < 4; ++a4) { const unsigned p0 = oacc_l[(dt * 8 + 2 * a4) * 64], p1 = oacc_l[(dt * 8 + 2 * a4 + 1) * 64];
                v2u wv; wv.x = pk2(blo(p0) + f * o[dt][4 * a4], bhi(p0) + f * o[dt][4 * a4 + 1]); wv.y = pk2(blo(p1) + f * o[dt][4 * a4 + 2], bhi(p1) + f * o[dt][4 * a4 + 3]);
                *(v2u*)(op + 32 * dt + 8 * a4) = wv; }
    }
    __syncthreads();
}
DI void p4_nsa(Frame& F) {
    const int gw = F.bid * 8 + F.wave, NGW = F.G * 8;
    for (int rh = gw; rh < MTOK * 4; rh += NGW) gla_out_row(F, rh);
    __syncthreads();
    for (int it = F.bid; it < 256; it += F.G) {
        const int bhk = it >> 4, q = it & 15;
#pragma unroll 1
        for (int k2 = 0; k2 < 2; ++k2) nsa_item(F, bhk * 32 + (k2 ? q : 31 - q));
    }
}

#ifndef MK_N_LAUNCHES
#define MK_N_LAUNCHES 1
#endif
constexpr int N_PHASES = 11;
__global__ void __launch_bounds__(512, 2) hybrid_fwd(Args args) {
    extern __shared__ __attribute__((aligned(16))) unsigned char lds_raw[];
    Frame F;
    F.lds = (LAS unsigned char*)lds_raw;
    F.tid = threadIdx.x; F.lane = F.tid & 63; F.wave = __builtin_amdgcn_readfirstlane(F.tid >> 6); F.G = gridDim.x; F.bid = blockIdx.x;
    F.x = args.in[0]; F.g_mix = args.in[1]; F.w_in = args.in[2]; F.w_gla_gate = args.in[3]; F.b_gla_gate = args.in[4]; F.g_gla_out = args.in[5];
    F.pe_k = args.in[6]; F.w_ck1 = args.in[7]; F.w_ck2 = args.in[8]; F.pe_v = args.in[9]; F.w_cv1 = args.in[10]; F.w_cv2 = args.in[11];
    F.w_pg = args.in[12]; F.w_pn = args.in[13]; F.w_out = args.in[14]; F.g_ffn = args.in[15]; F.w_fg = args.in[16]; F.w_fu = args.in[17]; F.w_fd = args.in[18]; F.g_final = args.in[19];
    F.out = args.out; F.ws = args.ws;
    const int lo = args.ph_lo, hi = args.ph_hi;
    typedef pg8::bf16_t pb;
#ifndef PH_MASK
#define PH_MASK 0x7ff
#endif
#define IN(k) (((PH_MASK >> (k)) & 1) && lo <= (k) && (k) < hi)
#define SEAM(k) do { if (IN(k) && IN((k) + 1)) { asm volatile("s_waitcnt vmcnt(0)" ::: "memory"); cg::this_grid().sync(); \
        if (F.wave == 0) { __builtin_amdgcn_fence(__ATOMIC_ACQUIRE, "agent"); asm volatile("s_waitcnt vmcnt(0)" ::: "memory"); } __syncthreads(); } } while (0)
    if (IN(0)) { p0_prologue(F); } SEAM(0);
    if (IN(1)) {
        pg8::Gemm g{(const pb*)(F.ws + WS_BUFA), (const pb*)(F.ws + WS_WINT), MTOK, ZW, DM}; pg8::StaticOrder S; S.init(MTOK, ZW, F.G, F.bid);
        pg8::EpiBf16Plain E{(pb*)(F.ws + WS_Z), ZW};
        pg8::gemm_phase<pg8::EpiBf16Plain, pg8::StaticOrder, true, true>(F.lds, g, S, E);
    } SEAM(1);
#ifndef REPEAT_MASK
#define REPEAT_MASK 0
#endif
#define NREP(k) (1 + ((REPEAT_MASK >> (k)) & 1))
    if (IN(2)) { for (int rep = 0; rep < NREP(2); ++rep) p2_prep(F); } SEAM(2);
    if (IN(3)) { for (int rep = 0; rep < NREP(3); ++rep) p3_scan(F); } SEAM(3);
    if (IN(4)) { for (int rep = 0; rep < NREP(4); ++rep) p4_nsa(F); } SEAM(4);
    if (IN(5)) {
        { pg8::Gemm g{(const pb*)(F.ws + WS_BUFB), (const pb*)(F.ws + WS_WPG), MTOK, DM, DM}; pg8::StaticOrder S; S.init(MTOK, DM, F.G, F.bid);
          pg8::EpiGate<false> E{(pb*)(F.ws + WS_BUFA), (const pb*)(F.ws + WS_Z) + ZMG, DM, ZW};
          pg8::gemm_phase<pg8::EpiGate<false>, pg8::StaticOrder, true, true>(F.lds, g, S, E); }
        { pg8::Gemm g{(const pb*)(F.ws + WS_ON), (const pb*)(F.ws + WS_WPN), MTOK, DM, DM}; pg8::StaticOrder S; S.init(MTOK, DM, F.G, F.bid);
          pg8::EpiGate<true> E{(pb*)(F.ws + WS_BUFA), (const pb*)(F.ws + WS_Z) + ZMG + 2048, DM, ZW};
          pg8::gemm_phase<pg8::EpiGate<true>, pg8::StaticOrder, true, true>(F.lds, g, S, E); }
    } SEAM(5);
    if (IN(6)) {
        pg8::Gemm g{(const pb*)(F.ws + WS_BUFA), (const pb*)(F.ws + WS_WOUT), MTOK, DM, DM}; pg8::StaticOrder S; S.init(MTOK, DM, F.G, F.bid);
        pg8::EpiResF32 E{F.x, F.out, DM};
        pg8::gemm_phase<pg8::EpiResF32, pg8::StaticOrder, true, true>(F.lds, g, S, E);
    } SEAM(6);
    if (IN(7)) { for (int rep = 0; rep < NREP(7); ++rep) p7_norm_ffnw(F); } SEAM(7);
    if (IN(8)) {
        pg8::Gemm g{(const pb*)(F.ws + WS_BUFB), (const pb*)(F.ws + WS_WGU), MTOK, 2 * DFF, DM}; pg8::StaticOrder S; S.init(MTOK, 2 * DFF, F.G, F.bid);
        pg8::EpiSwiGLU E{(pb*)(F.ws + WS_ACT), DFF};
        pg8::gemm_phase<pg8::EpiSwiGLU, pg8::StaticOrder, true, true>(F.lds, g, S, E);
    } SEAM(8);
    if (IN(9)) {
        pg8::Gemm g{(const pb*)(F.ws + WS_ACT), (const pb*)(F.ws + WS_WD), MTOK, DM, DFF}; pg8::StaticOrder S; S.init(MTOK, DM, F.G, F.bid);
        pg8::EpiResF32 E{F.out, F.out, DM};
        pg8::gemm_phase<pg8::EpiResF32, pg8::StaticOrder, true, true>(F.lds, g, S, E);
    } SEAM(9);
    if (IN(10)) { p10_final(F); }
#undef IN
#undef SEAM
}

extern "C" void kernel_launch(void* const* d_in, const int* in_sizes, int n_in, void* d_out, int out_size, void* d_ws, size_t ws_size, hipStream_t stream) {
    static int grid = 0;
    if (grid == 0) {
        if (n_in != 20 || in_sizes[0] != MTOK * DM || out_size != MTOK * DM || ws_size < WS_END) {
            fprintf(stderr, "kernel_launch: unexpected shapes (n_in %d, in0 %d, out %d, ws %zu < %zu); nothing launched\n", n_in, n_in > 0 ? in_sizes[0] : -1, out_size, ws_size, (size_t)WS_END); grid = -1; return; }
        int dev = 0, cus = 0, per_cu = 0;
        if (hipGetDevice(&dev) != hipSuccess || hipDeviceGetAttribute(&cus, hipDeviceAttributeMultiprocessorCount, dev) != hipSuccess) { grid = -1; return; }
        if (hipFuncSetAttribute((const void*)hybrid_fwd, hipFuncAttributeMaxDynamicSharedMemorySize, LDS_BYTES) != hipSuccess) { fprintf(stderr, "kernel_launch: hipFuncSetAttribute failed\n"); grid = -1; return; }
        if (hipOccupancyMaxActiveBlocksPerMultiprocessor(&per_cu, (const void*)hybrid_fwd, 512, LDS_BYTES) != hipSuccess || per_cu < 1) { fprintf(stderr, "kernel_launch: occupancy query says %d blocks per CU\n", per_cu); per_cu = 1; }
        (void)hipGetLastError();
        grid = cus * (per_cu > 1 ? 1 : per_cu);
    }
    if (grid < 0) return;
    (void)hipMemsetAsync((char*)d_ws + WS_CTL, 0, CTL_ZERO_BYTES, stream);
    Args a{};
    for (int i = 0; i < 20; ++i) a.in[i] = (const float*)d_in[i];
    a.out = (float*)d_out; a.ws = (unsigned char*)d_ws;
#if MK_N_LAUNCHES == 1
    a.ph_lo = 0; a.ph_hi = N_PHASES;
    void* kargs[] = {&a};
    hipError_t e = hipLaunchCooperativeKernel((const void*)hybrid_fwd, dim3(grid), dim3(512), kargs, LDS_BYTES, stream);
    if (e != hipSuccess) fprintf(stderr, "kernel_launch: cooperative launch failed: %s (grid %d)\n", hipGetErrorString(e), grid);
#else
    for (int p = 0; p < N_PHASES; ++p) { a.ph_lo = p; a.ph_hi = p + 1; hipLaunchKernelGGL(hybrid_fwd, dim3(grid), dim3(512), LDS_BYTES, stream, a); }
#endif
}
```

```cpp
#include <hip/hip_runtime.h>
#include <hip/hip_cooperative_groups.h>
#include <cstdio>
#include <cstdint>
namespace cg = cooperative_groups;
#define MK_N_LAUNCHES 1
#define REPEAT_MASK 0
namespace pg8 {
#define PG8_LAS __attribute__((address_space(3)))
typedef unsigned short bf16_t;
typedef short bf16x8 __attribute__((ext_vector_type(8)));
typedef float f32x4 __attribute__((ext_vector_type(4)));
typedef unsigned u32x4 __attribute__((ext_vector_type(4)));
constexpr int BM = 256, BK = 64, HALF = 128, HTB = HALF * BK * 2  , STAGE_BYTES = 8 * HTB, NXCD = 8, WGM = 8;

__host__ __device__ __forceinline__ int lds_byte(int r, int c) { const int st = (r >> 4) * 2 + (c >> 5), rr = r & 15, cc = c & 31, ob = rr * 64 + cc * 2; return st * 1024 + (ob ^ (((ob >> 9) & 1) << 5)); }
__host__ __device__ __forceinline__ void stage_rc(int b, int& R, int& C) { const int st = b / 1024, sb = b % 1024, swz = sb ^ (((sb >> 9) & 1) << 5); R = (st >> 1) * 16 + swz / 64; C = (st & 1) * 32 + (swz % 64) / 2; }
__host__ __device__ __forceinline__ int perm32(int rho) { const int n = rho >> 4, i = rho & 15; return 8 * (i >> 2) + 4 * n + (i & 3); }

struct Unit { int pm, pn; };
struct Gemm { const bf16_t* A; const bf16_t* Bt; int M, N, K; };

struct StaticOrder {
    int nM, nN, nwg, G, c;
    __host__ __device__ void init(int M, int N, int G_, int c_) { nM = M / BM; nN = N / BM; nwg = nM * nN; G = G_; c = c_; }
    __host__ __device__ bool next(int i, Unit& u) const {
        const long L = (long)i * G + c; if (L >= nwg) return false;
        int wgid = (int)L; { const int q = nwg / NXCD, r = nwg % NXCD, xcd = wgid % NXCD, off = wgid / NXCD; wgid = (xcd < r ? xcd * (q + 1) : r * (q + 1) + (xcd - r) * q) + off; }
        const int nig = WGM * nN, gid = wgid / nig, fm = gid * WGM, gsz = (nM - fm) < WGM ? (nM - fm) : WGM;
        u.pm = fm + ((wgid % nig) % gsz); u.pn = (wgid % nig) / gsz; return true;
    }
    __device__ __forceinline__ void a_ready(const Unit&) const {}
    __device__ __forceinline__ void done(const Unit&) const {}
};

__device__ __forceinline__ unsigned cvt_pk_bf16(float lo, float hi) { unsigned r; asm volatile("v_cvt_pk_bf16_f32 %0, %1, %2" : "=v"(r) : "v"(lo), "v"(hi)); return r; }
__device__ __forceinline__ float bf_lo(unsigned w) { return __uint_as_float(w << 16); }
__device__ __forceinline__ float bf_hi(unsigned w) { return __uint_as_float(w & 0xffff0000u); }
__device__ __forceinline__ float sigmoidf_(float x) { return 1.0f / (1.0f + __expf(-x)); }

struct EpiBf16Plain {
    static constexpr bool PERM = true, AFTER_DRAIN = false;
    bf16_t* O; int ldc;
    __device__ __forceinline__ void operator()(const f32x4 (&acc)[2][2][4][2], const Unit& u, int wr, int wc, int fr, int fq) const {
        const int row0 = u.pm * BM + wr * 64 + fr; const int col0 = u.pn * BM + wc * 32 + 8 * fq;
#pragma unroll
        for (int ai = 0; ai < 2; ++ai)
#pragma unroll
            for (int m = 0; m < 4; ++m) { bf16_t* rowp = O + (size_t)(row0 + ai * HALF + m * 16) * ldc + col0;
#pragma unroll
                for (int bj = 0; bj < 2; ++bj) { const f32x4 v0 = acc[ai][bj][m][0], v1 = acc[ai][bj][m][1];
                    u32x4 w; w.x = cvt_pk_bf16(v0[0], v0[1]); w.y = cvt_pk_bf16(v0[2], v0[3]); w.z = cvt_pk_bf16(v1[0], v1[1]); w.w = cvt_pk_bf16(v1[2], v1[3]);
                    *(u32x4*)(rowp + bj * HALF) = w; } }
    }
};
template <bool ADD> struct EpiGate {
    static constexpr bool PERM = true, AFTER_DRAIN = false;
    bf16_t* O; const bf16_t* G; int ldo, ldg;
    __device__ __forceinline__ void operator()(const f32x4 (&acc)[2][2][4][2], const Unit& u, int wr, int wc, int fr, int fq) const {
        const int row0 = u.pm * BM + wr * 64 + fr; const int col0 = u.pn * BM + wc * 32 + 8 * fq;
#pragma unroll
        for (int ai = 0; ai < 2; ++ai)
#pragma unroll
            for (int m = 0; m < 4; ++m) { const size_t row = (size_t)(row0 + ai * HALF + m * 16);
#pragma unroll
                for (int bj = 0; bj < 2; ++bj) { const f32x4 v0 = acc[ai][bj][m][0], v1 = acc[ai][bj][m][1];
                    const u32x4 gw = *(const u32x4*)(G + row * ldg + col0 + bj * HALF);
                    float r[8];
                    r[0] = sigmoidf_(bf_lo(gw.x)) * v0[0]; r[1] = sigmoidf_(bf_hi(gw.x)) * v0[1]; r[2] = sigmoidf_(bf_lo(gw.y)) * v0[2]; r[3] = sigmoidf_(bf_hi(gw.y)) * v0[3];
                    r[4] = sigmoidf_(bf_lo(gw.z)) * v1[0]; r[5] = sigmoidf_(bf_hi(gw.z)) * v1[1]; r[6] = sigmoidf_(bf_lo(gw.w)) * v1[2]; r[7] = sigmoidf_(bf_hi(gw.w)) * v1[3];
                    bf16_t* op = O + row * ldo + col0 + bj * HALF;
                    if (ADD) { const u32x4 pw = *(const u32x4*)op;
                        r[0] += bf_lo(pw.x); r[1] += bf_hi(pw.x); r[2] += bf_lo(pw.y); r[3] += bf_hi(pw.y); r[4] += bf_lo(pw.z); r[5] += bf_hi(pw.z); r[6] += bf_lo(pw.w); r[7] += bf_hi(pw.w); }
                    u32x4 w; w.x = cvt_pk_bf16(r[0], r[1]); w.y = cvt_pk_bf16(r[2], r[3]); w.z = cvt_pk_bf16(r[4], r[5]); w.w = cvt_pk_bf16(r[6], r[7]);
                    *(u32x4*)op = w; } }
    }
};
struct EpiSwiGLU {
    static constexpr bool PERM = true, AFTER_DRAIN = false;
    bf16_t* O; int ldo;
    __device__ __forceinline__ void operator()(const f32x4 (&acc)[2][2][4][2], const Unit& u, int wr, int wc, int fr, int fq) const {
        const int row0 = u.pm * BM + wr * 64 + fr; const int col0 = u.pn * HALF + wc * 32 + 8 * fq;
#pragma unroll
        for (int ai = 0; ai < 2; ++ai)
#pragma unroll
            for (int m = 0; m < 4; ++m) { const size_t row = (size_t)(row0 + ai * HALF + m * 16);
                const f32x4 g0 = acc[ai][0][m][0], g1 = acc[ai][0][m][1], u0 = acc[ai][1][m][0], u1 = acc[ai][1][m][1];
                float r[8];
#pragma unroll
                for (int e = 0; e < 4; ++e) { r[e] = g0[e] * sigmoidf_(g0[e]) * u0[e]; r[4 + e] = g1[e] * sigmoidf_(g1[e]) * u1[e]; }
                u32x4 w; w.x = cvt_pk_bf16(r[0], r[1]); w.y = cvt_pk_bf16(r[2], r[3]); w.z = cvt_pk_bf16(r[4], r[5]); w.w = cvt_pk_bf16(r[6], r[7]);
                *(u32x4*)(O + row * ldo + col0) = w; }
    }
};
struct EpiResF32 {
    static constexpr bool PERM = false, AFTER_DRAIN = false;
    const float* base; float* out; int ldc;
    __device__ __forceinline__ void operator()(const f32x4 (&acc)[2][2][4][2], const Unit& u, int wr, int wc, int fr, int fq) const {
        const int row0 = u.pm * BM + wr * 64 + fr, col0 = u.pn * BM + wc * 32 + 4 * fq;
#pragma unroll
        for (int ai = 0; ai < 2; ++ai)
#pragma unroll
            for (int m = 0; m < 4; ++m) { const size_t off = (size_t)(row0 + ai * HALF + m * 16) * ldc + col0;
#pragma unroll
                for (int bj = 0; bj < 2; ++bj)
#pragma unroll
                    for (int n = 0; n < 2; ++n) { const f32x4 bs = *(const f32x4*)(base + off + bj * HALF + n * 16); *(f32x4*)(out + off + bj * HALF + n * 16) = bs + acc[ai][bj][m][n]; } }
    }
};
template <class Epi, class Sched, bool ALIGN_EPI = false, bool SP2 = false>
__device__ __forceinline__ void gemm_phase(PG8_LAS unsigned char* lds, const Gemm g, const Sched& S, const Epi& E) {
    const int tid = threadIdx.x, wid = __builtin_amdgcn_readfirstlane(tid >> 6), lane = tid & 63, wr = wid >> 2, wc = wid & 3, fr = lane & 15, fq = lane >> 4;
    const int K = g.K, nt = K / BK;
    unsigned voffA[2], voffB[2];
#pragma unroll
    for (int i = 0; i < 2; ++i) { int R, C; stage_rc(tid * 16 + i * 8192, R, C); const int Rb = Epi::PERM ? ((R & ~31) + perm32(R & 31)) : R;
        voffA[i] = (unsigned)(R * K + C) * 2u; voffB[i] = (unsigned)(Rb * K + C) * 2u; }
    const size_t kstep = (size_t)(BK * 2);
    const size_t hstep = (size_t)HALF * K * 2;
    const size_t tstep = 2 * hstep;
    const unsigned ldsw = (unsigned)wid * 1024u;
    const int aoff = lds_byte(wr * 64 + fr, fq * 8), boff = lds_byte(wc * 32 + fr, fq * 8);
#define PG8_SA(b, h) (((b) * 2 + (h)) * HTB)
#define PG8_SB(b, h) ((4 + (b) * 2 + (h)) * HTB)
#define PG8_STAGE(bufoff, gbase, voff) do { _Pragma("unroll") for (int _i = 0; _i < 2; ++_i) \
        __builtin_amdgcn_global_load_lds((const unsigned*)((const char*)(gbase) + (voff)[_i]), (PG8_LAS unsigned*)(lds + (bufoff) + ldsw + _i * 8192), 16, 0, 0); } while (0)
#define PG8_LDA(dst, b, h) do { _Pragma("unroll") for (int m = 0; m < 4; ++m) _Pragma("unroll") for (int k = 0; k < 2; ++k) dst[m][k] = *(const PG8_LAS bf16x8*)(lds + PG8_SA(b, h) + aoff + m * 2048 + k * 1024); } while (0)
#define PG8_LDB(dst, b, h) do { _Pragma("unroll") for (int n = 0; n < 2; ++n) _Pragma("unroll") for (int k = 0; k < 2; ++k) dst[n][k] = *(const PG8_LAS bf16x8*)(lds + PG8_SB(b, h) + boff + n * 2048 + k * 1024); } while (0)
#define PG8_MMA(ai, bj, At, Bt) do { __builtin_amdgcn_s_setprio(1); _Pragma("unroll") for (int m = 0; m < 4; ++m) _Pragma("unroll") for (int n = 0; n < 2; ++n) _Pragma("unroll") for (int k = 0; k < 2; ++k) \
        acc[ai][bj][m][n] = __builtin_amdgcn_mfma_f32_16x16x32_bf16(Bt[n][k], At[m][k], acc[ai][bj][m][n], 0, 0, 0); __builtin_amdgcn_s_setprio(0); } while (0)
#define PG8_WAIT_V(n) asm volatile("s_waitcnt vmcnt(" #n ")" ::: "memory")
#define PG8_WAIT_L(n) asm volatile("s_waitcnt lgkmcnt(" #n ")" ::: "memory")
#define PG8_BAR __builtin_amdgcn_s_barrier()
#define PG8_SCHED __builtin_amdgcn_sched_barrier(0)
    Unit cur, nxt; int ui = 0;
    if (!S.next(0, cur)) return;
    f32x4 acc[2][2][4][2];
#pragma unroll
    for (int a = 0; a < 2; ++a)
#pragma unroll
        for (int b = 0; b < 2; ++b)
#pragma unroll
            for (int m = 0; m < 4; ++m)
#pragma unroll
                for (int n = 0; n < 2; ++n) acc[a][b][m][n] = (f32x4){0.f, 0.f, 0.f, 0.f};
    bf16x8 At[4][2], B0[2][2], B1[2][2];
    const char* cA = (const char*)g.A + (size_t)cur.pm * tstep; const char* cB = (const char*)g.Bt + (size_t)cur.pn * tstep;
    S.a_ready(cur);
    if constexpr (SP2) {
        PG8_STAGE(PG8_SB(0, 0), cB, voffB); PG8_STAGE(PG8_SB(0, 1), cB + hstep, voffB); PG8_STAGE(PG8_SA(0, 0), cA, voffA); PG8_STAGE(PG8_SA(0, 1), cA + hstep, voffA);
        if (wr == 1) PG8_BAR;
        PG8_WAIT_V(2); PG8_BAR;
        PG8_STAGE(PG8_SB(1, 0), cB + kstep, voffB); PG8_STAGE(PG8_SA(1, 0), cA + kstep, voffA); PG8_STAGE(PG8_SB(1, 1), cB + hstep + kstep, voffB);
        PG8_WAIT_V(6); PG8_BAR;
    } else {
        PG8_STAGE(PG8_SB(0, 0), cB, voffB); PG8_STAGE(PG8_SA(0, 0), cA, voffA); PG8_STAGE(PG8_SB(0, 1), cB + hstep, voffB); PG8_STAGE(PG8_SA(0, 1), cA + hstep, voffA);
        if (wr == 1) PG8_BAR;
        PG8_WAIT_V(4); PG8_BAR;
        PG8_STAGE(PG8_SB(1, 0), cB + kstep, voffB); PG8_STAGE(PG8_SA(1, 0), cA + kstep, voffA); PG8_STAGE(PG8_SB(1, 1), cB + hstep + kstep, voffB);
        PG8_WAIT_V(6); PG8_BAR;
    }
    for (;;) {
        const bool has_next = S.next(ui + 1, nxt);
        const char* nA = has_next ? (const char*)g.A + (size_t)nxt.pm * tstep : cA; const char* nB = has_next ? (const char*)g.Bt + (size_t)nxt.pn * tstep : cB;
        for (int t = 0; t < nt; t += 2) {
            const bool last = (t == nt - 2);
            const char* a1 = cA + (size_t)(t + 1) * kstep;
            const char* a2 = last ? nA : cA + (size_t)(t + 2) * kstep; const char* b2 = last ? nB : cB + (size_t)(t + 2) * kstep;
            const char* a3 = a2 + kstep; const char* b3 = b2 + kstep;
            if (last && has_next) S.a_ready(nxt);
            if constexpr (SP2) {
            PG8_LDB(B0, 0, 0); PG8_LDB(B1, 0, 1); PG8_SCHED; PG8_LDA(At, 0, 0); PG8_STAGE(PG8_SA(1, 1), a1 + hstep, voffA);
            PG8_WAIT_V(8); PG8_WAIT_L(0); PG8_BAR; PG8_MMA(0, 0, At, B0); PG8_MMA(0, 1, At, B1); PG8_BAR; PG8_SCHED;
            PG8_LDA(At, 0, 1); PG8_STAGE(PG8_SB(0, 0), b2, voffB); PG8_STAGE(PG8_SB(0, 1), b2 + hstep, voffB); PG8_STAGE(PG8_SA(0, 0), a2, voffA);
            PG8_WAIT_V(8); PG8_WAIT_L(0); PG8_BAR; PG8_MMA(1, 0, At, B0); PG8_MMA(1, 1, At, B1); PG8_BAR; PG8_SCHED;
            PG8_LDB(B0, 1, 0); PG8_LDB(B1, 1, 1); PG8_SCHED; PG8_LDA(At, 1, 0); PG8_STAGE(PG8_SA(0, 1), a2 + hstep, voffA);
            PG8_WAIT_V(8); PG8_WAIT_L(0); PG8_BAR; PG8_MMA(0, 0, At, B0); PG8_MMA(0, 1, At, B1); PG8_BAR; PG8_SCHED;
            PG8_LDA(At, 1, 1); PG8_STAGE(PG8_SB(1, 0), b3, voffB); PG8_STAGE(PG8_SB(1, 1), b3 + hstep, voffB); PG8_STAGE(PG8_SA(1, 0), a3, voffA);
            PG8_WAIT_V(8); PG8_WAIT_L(0); PG8_BAR; PG8_MMA(1, 0, At, B0); PG8_MMA(1, 1, At, B1); PG8_BAR; PG8_SCHED;
            } else {
            PG8_LDB(B0, 0, 0); PG8_SCHED; PG8_LDA(At, 0, 0); PG8_STAGE(PG8_SA(1, 1), a1 + hstep, voffA);
            PG8_WAIT_L(8); PG8_BAR; PG8_WAIT_L(0); PG8_MMA(0, 0, At, B0); PG8_BAR; PG8_SCHED;
            PG8_LDB(B1, 0, 1); PG8_STAGE(PG8_SB(0, 0), b2, voffB);
            PG8_BAR; PG8_WAIT_L(0); PG8_MMA(0, 1, At, B1); PG8_BAR;
            PG8_LDA(At, 0, 1); PG8_STAGE(PG8_SA(0, 0), a2, voffA);
            PG8_BAR; PG8_WAIT_L(0); PG8_MMA(1, 0, At, B0); PG8_BAR; PG8_SCHED;
            PG8_STAGE(PG8_SB(0, 1), b2 + hstep, voffB);
            PG8_WAIT_V(6); PG8_BAR; PG8_MMA(1, 1, At, B1); PG8_BAR;
            PG8_LDB(B0, 1, 0); PG8_SCHED; PG8_LDA(At, 1, 0); PG8_STAGE(PG8_SA(0, 1), a2 + hstep, voffA);
            PG8_WAIT_L(8); PG8_BAR; PG8_WAIT_L(0); PG8_MMA(0, 0, At, B0); PG8_BAR; PG8_SCHED;
            PG8_LDB(B1, 1, 1); PG8_STAGE(PG8_SB(1, 0), b3, voffB);
            PG8_BAR; PG8_WAIT_L(0); PG8_MMA(0, 1, At, B1); PG8_BAR;
            PG8_LDA(At, 1, 1); PG8_STAGE(PG8_SA(1, 0), a3, voffA);
            PG8_BAR; PG8_WAIT_L(0); PG8_MMA(1, 0, At, B0); PG8_BAR; PG8_SCHED;
            PG8_STAGE(PG8_SB(1, 1), b3 + hstep, voffB);
            PG8_WAIT_V(6); PG8_BAR; PG8_MMA(1, 1, At, B1); PG8_BAR;
            }
        }
        if constexpr (ALIGN_EPI) { if (wr == 0) PG8_BAR; }
        if constexpr (!Epi::AFTER_DRAIN) { E(acc, cur, wr, wc, fr, fq); S.done(cur); }
        if (!has_next) break;
#pragma unroll
        for (int a = 0; a < 2; ++a)
#pragma unroll
            for (int b = 0; b < 2; ++b)
#pragma unroll
                for (int m = 0; m < 4; ++m)
#pragma unroll
                    for (int n = 0; n < 2; ++n) acc[a][b][m][n] = (f32x4){0.f, 0.f, 0.f, 0.f};
        cur = nxt; cA = nA; cB = nB; ++ui;
        if constexpr (ALIGN_EPI) { if (wr == 1) PG8_BAR; }
    }
    PG8_WAIT_V(0);
    if constexpr (!ALIGN_EPI) { if (wr == 0) PG8_BAR; }
    PG8_BAR;
    if constexpr (Epi::AFTER_DRAIN) { E.fused(acc, cur, wr, wc, fr, fq, lds, wid, lane); S.done(cur); }
#undef PG8_SA
#undef PG8_SB
#undef PG8_STAGE
#undef PG8_LDA
#undef PG8_LDB
#undef PG8_MMA
#undef PG8_WAIT_V
#undef PG8_WAIT_L
#undef PG8_BAR
#undef PG8_SCHED
}
}

constexpr int NB = 4, SEQ = 2048, DM = 2048, MTOK = NB * SEQ;
constexpr int INW = 15424, DFF = 5632;
constexpr int ZW = 15616;
constexpr int ZGQ = 0, ZGK = 1024, ZGV = 2048, ZGR = 4096, ZNQ = 6144, ZNKV = 8192, ZMG = 11264, ZGLR = 15360, ZNG = 15376;
constexpr float RMS_EPS = 1e-6f;
constexpr size_t MiB = 1u << 20;
constexpr size_t WS_CTL = 0, CTL_ZERO_BYTES = 1 * MiB;
constexpr size_t WS_BIAS1 = 4096;
constexpr size_t WS_WINT = 1 * MiB, WS_WPG = 62 * MiB, WS_WPN = 70 * MiB, WS_WOUT = 78 * MiB, WS_W1T = 86 * MiB, WS_W2T = 90 * MiB;
constexpr size_t WS_KC = 91 * MiB, WS_VCT = 91 * MiB + 512 * 1024, WS_DECAY = 92 * MiB, WS_VTS = 93 * MiB, WS_VTW = 101 * MiB, WS_ATT = 109 * MiB;
constexpr size_t WS_QD = 113 * MiB, WS_KET = 129 * MiB, WS_ON = 113 * MiB  ;
constexpr size_t WS_BUFA = 145 * MiB  , WS_BUFB = 177 * MiB  , WS_Z = 209 * MiB;
constexpr size_t WS_WGU = 209 * MiB, WS_WD = 253 * MiB, WS_ACT = 275 * MiB  ;
constexpr size_t WS_END = 453 * MiB;
constexpr int LDS_BYTES = 147456;

#define LAS __attribute__((address_space(3)))
#define DI __device__ __forceinline__
typedef unsigned short bf16;
typedef unsigned v4u __attribute__((ext_vector_type(4)));
typedef unsigned v2u __attribute__((ext_vector_type(2)));
typedef float f32x4 __attribute__((ext_vector_type(4)));
typedef float f32x16 __attribute__((ext_vector_type(16)));
typedef short bf16x8 __attribute__((ext_vector_type(8)));
typedef float f32x2_t __attribute__((ext_vector_type(2)));
typedef __bf16 bf16x2_t __attribute__((ext_vector_type(2)));
#define MFMA32(a, b, c) __builtin_amdgcn_mfma_f32_32x32x16_bf16((a), (b), (c), 0, 0, 0)
#define MFMA16(a, b, c) __builtin_amdgcn_mfma_f32_16x16x32_bf16((a), (b), (c), 0, 0, 0)
#define LDS_WAIT() asm volatile("s_waitcnt lgkmcnt(0)" ::: "memory")
#define BAR_LDS() do { asm volatile("s_waitcnt lgkmcnt(0)" ::: "memory"); __builtin_amdgcn_s_barrier(); asm volatile("" ::: "memory"); } while (0)

DI unsigned f2bf(float f) { unsigned u = __builtin_bit_cast(unsigned, f); return (u + 0x7fffu + ((u >> 16) & 1u)) >> 16; }
DI unsigned pk2(float lo, float hi) { f32x2_t v = {lo, hi}; bf16x2_t b = __builtin_convertvector(v, bf16x2_t); return __builtin_bit_cast(unsigned, b); }
DI float bf2f(bf16 b) { return __uint_as_float(((unsigned)b) << 16); }
DI float blo(unsigned w) { return __uint_as_float(w << 16); }
DI float bhi(unsigned w) { return __uint_as_float(w & 0xffff0000u); }
DI float sigm(float x) { return 1.0f / (1.0f + __expf(-x)); }
DI float wave_sum(float v) {
#pragma unroll
    for (int o = 1; o < 64; o <<= 1) v += __shfl_xor(v, o);
    return v;
}
DI bf16x8 pack8(float a0, float a1, float a2, float a3, float a4, float a5, float a6, float a7) {
    v4u p; p.x = pk2(a0, a1); p.y = pk2(a2, a3); p.z = pk2(a4, a5); p.w = pk2(a6, a7); return __builtin_bit_cast(bf16x8, p);
}

struct Args {
    const float* in[20]; float* out; unsigned char* ws; int ph_lo, ph_hi;
};
struct Frame {
    LAS unsigned char* lds; int tid, lane, wave, G, bid;
    const float* x; const float* g_mix; const float* w_in; const float* w_gla_gate; const float* b_gla_gate; const float* g_gla_out;
    const float* pe_k; const float* w_ck1; const float* w_ck2; const float* pe_v; const float* w_cv1; const float* w_cv2;
    const float* w_pg; const float* w_pn; const float* w_out; const float* g_ffn; const float* w_fg; const float* w_fu; const float* w_fd; const float* g_final;
    float* out; unsigned char* ws;
};

struct MapId { DI int operator()(int n) const { return n; } };
struct MapOff { int off; DI int operator()(int n) const { return n + off; } };
struct MapWin { DI int operator()(int n) const {
    if (n < 6144) return n; if (n < 6160) return ZGLR + (n - 6144); if (n < 8208) return ZNQ + (n - 6160);
    if (n < 11280) return ZNKV + (n - 8208); if (n < 11328) return ZNG + (n - 11280); return ZMG + (n - 11328); } };
struct MapGU { int up; DI int operator()(int n) const { return (n >> 7) * 256 + up * 128 + (n & 127); } };

template <class Map>
DI void transpose_item(const float* __restrict__ W, int N, bf16* __restrict__ WT, int Kp, LAS float* scr, int item, int lane, const Map map) {
    const int nblk = N / 32, kb = item / nblk, nb = item - kb * nblk, k0 = 64 * kb, n0 = 32 * nb;
#pragma unroll 8
    for (int i = 0; i < 32; ++i) { const int kk = 2 * i + (lane >> 5); scr[kk * 33 + (lane & 31)] = W[(size_t)(k0 + kk) * N + n0 + (lane & 31)]; }
    LDS_WAIT();
    const int c = lane & 7;
#pragma unroll
    for (int j = 0; j < 4; ++j) { const int n = (lane >> 3) + 8 * j; const LAS float* s = scr + (8 * c) * 33 + n;
        v4u o; o.x = pk2(s[0 * 33], s[1 * 33]); o.y = pk2(s[2 * 33], s[3 * 33]); o.z = pk2(s[4 * 33], s[5 * 33]); o.w = pk2(s[6 * 33], s[7 * 33]);
        *(v4u*)(WT + (size_t)map(n0 + n) * Kp + k0 + 8 * c) = o; }
    LDS_WAIT();
}
template <bool TO_BF16>
DI void rms_row(const float* __restrict__ xrow, const float* __restrict__ g, void* orow, int lane) {
    const f32x4* xr = (const f32x4*)xrow + lane; const f32x4* gr = (const f32x4*)g + lane;
    f32x4 v[8]; float s = 0.f;
#pragma unroll
    for (int j = 0; j < 8; ++j) { v[j] = xr[64 * j]; s += (v[j].x * v[j].x + v[j].y * v[j].y) + (v[j].z * v[j].z + v[j].w * v[j].w); }
    const float rs = rsqrtf(wave_sum(s) * (1.f / DM) + RMS_EPS);
#pragma unroll
    for (int j = 0; j < 8; ++j) { const f32x4 gg = gr[64 * j]; const f32x4 o = v[j] * rs * gg;
        if (TO_BF16) { v2u w; w.x = pk2(o.x, o.y); w.y = pk2(o.z, o.w); ((v2u*)orow)[lane + 64 * j] = w; }
        else ((f32x4*)orow)[lane + 64 * j] = o; }
}

DI void p0_prologue(Frame& F) {
    LAS float* scr = (LAS float*)(F.lds + F.wave * 8448);
    const int gw = F.bid * 8 + F.wave, NGW = F.G * 8;
    bf16* WINT = (bf16*)(F.ws + WS_WINT); bf16* WPG = (bf16*)(F.ws + WS_WPG); bf16* WPN = (bf16*)(F.ws + WS_WPN); bf16* WOUT = (bf16*)(F.ws + WS_WOUT);
    bf16* W1T = (bf16*)(F.ws + WS_W1T); bf16* W2T = (bf16*)(F.ws + WS_W2T);
    constexpr int I_IN = (DM / 64) * (INW / 32), I_P = (DM / 64) * (DM / 32), I_C1 = (4096 / 64) * (256 / 32), I_C2 = (256 / 64) * (128 / 32);
    constexpr int NITEMS = I_IN + 3 * I_P + 2 * I_C1 + 2 * I_C2;
    for (int it = gw; it < NITEMS; it += NGW) {
        int r = it;
        if (r < I_IN) { transpose_item(F.w_in, INW, WINT, DM, scr, r, F.lane, MapWin{}); continue; } r -= I_IN;
        if (r < I_P) { transpose_item(F.w_pg, DM, WPG, DM, scr, r, F.lane, MapId{}); continue; } r -= I_P;
        if (r < I_P) { transpose_item(F.w_pn, DM, WPN, DM, scr, r, F.lane, MapId{}); continue; } r -= I_P;
        if (r < I_P) { transpose_item(F.w_out, DM, WOUT, DM, scr, r, F.lane, MapId{}); continue; } r -= I_P;
        if (r < I_C1) { transpose_item(F.w_ck1, 256, W1T, 4096, scr, r, F.lane, MapId{}); continue; } r -= I_C1;
        if (r < I_C1) { transpose_item(F.w_cv1, 256, W1T, 4096, scr, r, F.lane, MapOff{256}); continue; } r -= I_C1;
        if (r < I_C2) { transpose_item(F.w_ck2, 128, W2T, 256, scr, r, F.lane, MapId{}); continue; } r -= I_C2;
        transpose_item(F.w_cv2, 128, W2T, 256, scr, r, F.lane, MapOff{128});
    }
    bf16* H = (bf16*)(F.ws + WS_BUFA);
    for (int m = gw; m < MTOK; m += NGW) rms_row<true>(F.x + (size_t)m * DM, F.g_mix, H + (size_t)m * DM, F.lane);
    float* bias1 = (float*)(F.ws + WS_BIAS1);
    for (int it = gw; it < 128; it += NGW) {
        const int which = it >> 6, kc = it & 63; const float* pe = which ? F.pe_v : F.pe_k; const float* w1 = which ? F.w_cv1 : F.w_ck1;
        float a[4] = {0.f, 0.f, 0.f, 0.f};
        for (int kk = kc * 64; kk < kc * 64 + 64; ++kk) { const float p = pe[kk];
#pragma unroll
            for (int q = 0; q < 4; ++q) a[q] += p * w1[(size_t)kk * 256 + F.lane + 64 * q]; }
#pragma unroll
        for (int q = 0; q < 4; ++q) atomicAdd(bias1 + which * 256 + F.lane + 64 * q, a[q]);
    }
}
DI void p7_norm_ffnw(Frame& F) {
    LAS float* scr = (LAS float*)(F.lds + F.wave * 8448);
    const int gw = F.bid * 8 + F.wave, NGW = F.G * 8;
    bf16* WGU = (bf16*)(F.ws + WS_WGU); bf16* WD = (bf16*)(F.ws + WS_WD);
    constexpr int I_G = (DM / 64) * (DFF / 32), I_D = (DFF / 64) * (DM / 32);
    for (int it = gw; it < 2 * I_G + I_D; it += NGW) {
        int r = it;
        if (r < I_G) { transpose_item(F.w_fg, DFF, WGU, DM, scr, r, F.lane, MapGU{0}); continue; } r -= I_G;
        if (r < I_G) { transpose_item(F.w_fu, DFF, WGU, DM, scr, r, F.lane, MapGU{1}); continue; } r -= I_G;
        transpose_item(F.w_fd, DM, WD, DFF, scr, r, F.lane, MapId{});
    }
    bf16* H2 = (bf16*)(F.ws + WS_BUFB);
    for (int m = gw; m < MTOK; m += NGW) rms_row<true>(F.out + (size_t)m * DM, F.g_ffn, H2 + (size_t)m * DM, F.lane);
}
DI void p10_final(Frame& F) {
    const int gw = F.bid * 8 + F.wave, NGW = F.G * 8;
    for (int m = gw; m < MTOK; m += NGW) rms_row<false>(F.out + (size_t)m * DM, F.g_final, F.out + (size_t)m * DM, F.lane);
}

DI void g1_item(Frame& F, int item) {
    const bf16* Z = (const bf16*)(F.ws + WS_Z);
    bf16* QD = (bf16*)(F.ws + WS_QD); bf16* KET = (bf16*)(F.ws + WS_KET); bf16* ATT = (bf16*)(F.ws + WS_ATT); float* DECAY = (float*)(F.ws + WS_DECAY);
    const int bh = item >> 5, c = item & 31, b = bh >> 2, h = bh & 3;
    const size_t t0 = (size_t)b * SEQ + c * 64;
    LAS float* glr_s = (LAS float*)(F.lds);
    LAS float* tot_s = (LAS float*)(F.lds + 4096);
    LAS bf16* qd_s = (LAS bf16*)(F.lds + 8192);
    LAS bf16* kd_s = (LAS bf16*)(F.lds + 8192 + 33792);
    const int tid = F.tid, dk = tid & 255, half = tid >> 8;
    for (int e = tid; e < 1024; e += 512) { const int tok = e >> 4, r = e & 15; glr_s[e] = bf2f(Z[(t0 + tok) * ZW + ZGLR + r]); }
    float wg[16];
#pragma unroll
    for (int r = 0; r < 16; ++r) wg[r] = F.w_gla_gate[r * 1024 + h * 256 + dk];
    const float bg = F.b_gla_gate[h * 256 + dk];
    __syncthreads();
    float bc[32]; float run = 0.f;
#pragma unroll
    for (int i = 0; i < 32; ++i) { const int tok = half * 32 + i; float xg = bg;
        const LAS f32x4* gp = (const LAS f32x4*)(glr_s + tok * 16);
#pragma unroll
        for (int r4 = 0; r4 < 4; ++r4) { const f32x4 gv = gp[r4]; xg += gv.x * wg[4 * r4] + gv.y * wg[4 * r4 + 1] + gv.z * wg[4 * r4 + 2] + gv.w * wg[4 * r4 + 3]; }
        const float ls = fminf(xg, 0.f) - __logf(1.0f + __expf(-fabsf(xg)));
        run += ls * 0.0625f; bc[i] = run; }
    tot_s[half * 256 + dk] = run;
    __syncthreads();
    const float tot0 = tot_s[dk], tot1 = tot_s[256 + dk]; const float blast = tot0 + tot1, boff = half ? tot0 : 0.f;
    unsigned kep[16];
#pragma unroll
    for (int i = 0; i < 32; i += 2) { float ke2[2];
#pragma unroll
        for (int e = 0; e < 2; ++e) { const int tok = half * 32 + i + e; const float bb = bc[i + e] + boff;
            const float q = bf2f(Z[(t0 + tok) * ZW + ZGQ + h * 256 + dk]), k = bf2f(Z[(t0 + tok) * ZW + ZGK + h * 256 + dk]);
            const float qd = q * 0.0625f * __expf(bb), kd = k * __expf(-bb); ke2[e] = k * __expf(blast - bb);
            const bf16 qb = (bf16)f2bf(qd); qd_s[tok * 264 + dk] = qb; kd_s[tok * 264 + dk] = (bf16)f2bf(kd); QD[(t0 + tok) * 1024 + h * 256 + dk] = qb; }
        kep[i >> 1] = pk2(ke2[0], ke2[1]); }
    { v4u* kp = (v4u*)(KET + ((size_t)item * 256 + dk) * 64 + half * 32);
#pragma unroll
      for (int q = 0; q < 4; ++q) { v4u w; w.x = kep[4 * q]; w.y = kep[4 * q + 1]; w.z = kep[4 * q + 2]; w.w = kep[4 * q + 3]; kp[q] = w; } }
    if (half == 0) DECAY[(size_t)item * 256 + dk] = __expf(blast);
    __syncthreads();
    const int w = F.wave, fr = F.lane & 15, fq = F.lane >> 4, mt = w >> 1;
#pragma unroll
    for (int nn = 0; nn < 2; ++nn) { const int nt = (w & 1) * 2 + nn; f32x4 acc = {0.f, 0.f, 0.f, 0.f};
        if (nt <= mt) {
#pragma unroll
            for (int s = 0; s < 8; ++s) { const bf16x8 a = *(const LAS bf16x8*)(qd_s + (16 * mt + fr) * 264 + 32 * s + 8 * fq); const bf16x8 bb = *(const LAS bf16x8*)(kd_s + (16 * nt + fr) * 264 + 32 * s + 8 * fq);
                acc = MFMA16(a, bb, acc); } }
#pragma unroll
        for (int j = 0; j < 4; ++j) { const int row = 16 * mt + 4 * fq + j, col = 16 * nt + fr; const float v = (col <= row) ? acc[j] : 0.f;
            ATT[(size_t)item * 4096 + row * 64 + col] = (bf16)f2bf(v); } }
    __syncthreads();
}

DI void n1_item(Frame& F, int item) {
    const bf16* Z = (const bf16*)(F.ws + WS_Z);
    const bf16* W1T = (const bf16*)(F.ws + WS_W1T); const bf16* W2T = (const bf16*)(F.ws + WS_W2T); const float* bias1 = (const float*)(F.ws + WS_BIAS1);
    bf16* KC = (bf16*)(F.ws + WS_KC); bf16* VCT = (bf16*)(F.ws + WS_VCT);
    const int which = item >> 6, b = (item >> 4) & 3, hk = (item >> 2) & 3, j = item & 3;
    const int w = F.wave, r = F.lane & 31, hh = F.lane >> 5;
    LAS bf16* hid = (LAS bf16*)(F.lds);
    int crow_ = 32 * j + r; if (crow_ > 126) crow_ = 126;
    const bf16* ap = Z + ((size_t)b * SEQ + 16 * crow_) * ZW + ZNKV + which * 512 + hk * 128 + 8 * hh;
    const bf16* bp = W1T + ((size_t)which * 256 + 32 * w + r) * 4096 + 8 * hh;
    f32x16 acc; for (int i = 0; i < 16; ++i) acc[i] = 0.f;
    bf16x8 fa[2][8], fb[2][8];
#pragma unroll
    for (int s = 0; s < 8; ++s) { fa[0][s] = *(const bf16x8*)(ap + 16 * s); fb[0][s] = *(const bf16x8*)(bp + 16 * s); }
#pragma unroll 1
    for (int tk = 0; tk < 32; tk += 2) {
#pragma unroll
        for (int s = 0; s < 8; ++s) { fa[1][s] = *(const bf16x8*)(ap + (size_t)(tk + 1) * ZW + 16 * s); fb[1][s] = *(const bf16x8*)(bp + (tk + 1) * 128 + 16 * s); }
#pragma unroll
        for (int s = 0; s < 8; ++s) acc = MFMA32(fa[0][s], fb[0][s], acc);
        const int t2 = (tk + 2 < 32) ? tk + 2 : 0;
#pragma unroll
        for (int s = 0; s < 8; ++s) { fa[0][s] = *(const bf16x8*)(ap + (size_t)t2 * ZW + 16 * s); fb[0][s] = *(const bf16x8*)(bp + t2 * 128 + 16 * s); }
#pragma unroll
        for (int s = 0; s < 8; ++s) acc = MFMA32(fa[1][s], fb[1][s], acc);
    }
    { const float bs = bias1[which * 256 + 32 * w + r];
#pragma unroll
      for (int i = 0; i < 16; ++i) { const int row = (i & 3) + 8 * (i >> 2) + 4 * hh; const float v = acc[i] + bs; hid[row * 264 + 32 * w + r] = (bf16)f2bf(v * sigm(v)); } }
    __syncthreads();
    if (w < 4) {
        f32x16 o; for (int i = 0; i < 16; ++i) o[i] = 0.f;
        const bf16* b2 = W2T + ((size_t)which * 128 + 32 * w + r) * 256 + 8 * hh;
#pragma unroll
        for (int s = 0; s < 16; ++s) { const bf16x8 a = *(const LAS bf16x8*)(hid + r * 264 + 16 * s + 8 * hh); const bf16x8 bb = *(const bf16x8*)(b2 + 16 * s); o = MFMA32(a, bb, o); }
        const int d = 32 * w + r;
        if (which == 0) {
#pragma unroll
            for (int i = 0; i < 16; ++i) { const int cc = 32 * j + (i & 3) + 8 * (i >> 2) + 4 * hh; KC[(((size_t)b * 4 + hk) * 128 + cc) * 128 + d] = (bf16)f2bf(o[i]); }
        } else {
#pragma unroll
            for (int a4 = 0; a4 < 4; ++a4) { v2u wv; wv.x = pk2(o[4 * a4], o[4 * a4 + 1]); wv.y = pk2(o[4 * a4 + 2], o[4 * a4 + 3]);
                *(v2u*)(VCT + (((size_t)b * 4 + hk) * 128 + d) * 128 + 32 * j + 8 * a4 + 4 * hh) = wv; }
        }
    }
    __syncthreads();
}
DI void vt_item(Frame& F, int item) {
    const bf16* Z = (const bf16*)(F.ws + WS_Z);
    const int dhalf = item & 1, tile = (item >> 1) & 31, hk = (item >> 6) & 3, b = (item >> 8) & 3, which = item >> 10;
    bf16* VT = (bf16*)(F.ws + (which ? WS_VTW : WS_VTS));
    LAS bf16* scr = (LAS bf16*)(F.lds + F.wave * 8448);
    const int lane = F.lane;
    const bf16* src = Z + ((size_t)b * SEQ + tile * 64) * ZW + ZNKV + (3 + 2 * which) * 512 + hk * 128 + dhalf * 64;
#pragma unroll
    for (int p = 0; p < 8; ++p) { const int tok = 8 * p + (lane >> 3), d8 = (lane & 7) * 8; const v4u v = *(const v4u*)(src + (size_t)tok * ZW + d8);
        LAS unsigned* dst = (LAS unsigned*)(scr + tok * 66 + d8); dst[0] = v.x; dst[1] = v.y; dst[2] = v.z; dst[3] = v.w; }
    LDS_WAIT();
#pragma unroll
    for (int p = 0; p < 8; ++p) { const int d = 8 * p + (lane >> 3), t8 = (lane & 7) * 8; unsigned short e[8];
#pragma unroll
        for (int q = 0; q < 8; ++q) e[q] = scr[(t8 + q) * 66 + d];
        v4u o; o.x = e[0] | ((unsigned)e[1] << 16); o.y = e[2] | ((unsigned)e[3] << 16); o.z = e[4] | ((unsigned)e[5] << 16); o.w = e[6] | ((unsigned)e[7] << 16);
        *(v4u*)(VT + (((size_t)b * 4 + hk) * 128 + dhalf * 64 + d) * SEQ + tile * 64 + t8) = o; }
    LDS_WAIT();
}
DI void p2_prep(Frame& F) {
    if (F.G == 256) {
        if (F.bid < 128) { n1_item(F, F.bid); g1_item(F, F.bid); }
        else { for (int k = 0; k < 3; ++k) g1_item(F, 128 + (F.bid - 128) * 3 + k); }
    } else { for (int it = F.bid; it < 128 + 512; it += F.G) { if (it < 128) n1_item(F, it); else g1_item(F, it - 128); } }
    __syncthreads();
    const int gw = F.bid * 8 + F.wave, NGW = F.G * 8;
    for (int it = gw; it < 2048; it += NGW) vt_item(F, it);
}

DI void g2_item(Frame& F, int item) {
    const bf16* Z = (const bf16*)(F.ws + WS_Z);
    const bf16* QD = (const bf16*)(F.ws + WS_QD); const bf16* KET = (const bf16*)(F.ws + WS_KET); const bf16* ATT = (const bf16*)(F.ws + WS_ATT); const float* DECAY = (const float*)(F.ws + WS_DECAY);
    float* O = F.out;
    const int bh = item >> 4, js = item & 15, b = bh >> 2, h = bh & 3;
    LAS bf16* ST = (LAS bf16*)(F.lds);
    LAS bf16* VT = (LAS bf16*)(F.lds + 16896);
    const int tid = F.tid, w = F.wave, fr = F.lane & 15, fq = F.lane >> 4, mt = w >> 1, nt = w & 1;
    for (int e = tid; e < 4224; e += 512) ((LAS unsigned*)ST)[e] = 0u;
    f32x4 Sacc[2][2];
#pragma unroll
    for (int a = 0; a < 2; ++a)
#pragma unroll
        for (int c2 = 0; c2 < 2; ++c2) Sacc[a][c2] = (f32x4){0.f, 0.f, 0.f, 0.f};
    const int vtok = tid >> 3, vd4 = (tid & 7) * 4;
    const size_t vcol = ZGV + h * 512 + 32 * js;
    v2u vv_n; bf16x8 aatt_n[2], aqd_n[8], aket_n[2][2]; f32x4 dec_n[2];
#define G2_LOAD(cc) do { const size_t itemc_ = (size_t)bh * 32 + (cc), t0_ = (size_t)b * SEQ + (cc) * 64; \
        vv_n = *(const v2u*)(Z + (t0_ + vtok) * ZW + vcol + vd4); \
        _Pragma("unroll") for (int s = 0; s < 2; ++s) aatt_n[s] = *(const bf16x8*)(ATT + itemc_ * 4096 + (16 * mt + fr) * 64 + 32 * s + 8 * fq); \
        _Pragma("unroll") for (int s = 0; s < 8; ++s) aqd_n[s] = *(const bf16x8*)(QD + (t0_ + 16 * mt + fr) * 1024 + h * 256 + 32 * s + 8 * fq); \
        _Pragma("unroll") for (int mi = 0; mi < 2; ++mi) { \
            _Pragma("unroll") for (int s = 0; s < 2; ++s) aket_n[mi][s] = *(const bf16x8*)(KET + (itemc_ * 256 + 32 * w + 16 * mi + fr) * 64 + 32 * s + 8 * fq); \
            dec_n[mi] = *(const f32x4*)(DECAY + itemc_ * 256 + 32 * w + 16 * mi + 4 * fq); } } while (0)
    G2_LOAD(0);
    for (int c = 0; c < 32; ++c) {
        const size_t t0 = (size_t)b * SEQ + c * 64;
        const v2u vv = vv_n;
        bf16x8 aatt[2], aqd[8], aket[2][2]; f32x4 dec[2];
#pragma unroll
        for (int s = 0; s < 2; ++s) aatt[s] = aatt_n[s];
#pragma unroll
        for (int s = 0; s < 8; ++s) aqd[s] = aqd_n[s];
#pragma unroll
        for (int mi = 0; mi < 2; ++mi) { aket[mi][0] = aket_n[mi][0]; aket[mi][1] = aket_n[mi][1]; dec[mi] = dec_n[mi]; }
        if (c + 1 < 32) G2_LOAD(c + 1);
        VT[(vd4 + 0) * 72 + vtok] = (bf16)(vv.x & 0xffffu); VT[(vd4 + 1) * 72 + vtok] = (bf16)(vv.x >> 16);
        VT[(vd4 + 2) * 72 + vtok] = (bf16)(vv.y & 0xffffu); VT[(vd4 + 3) * 72 + vtok] = (bf16)(vv.y >> 16);
        BAR_LDS();
        f32x4 o = {0.f, 0.f, 0.f, 0.f};
#pragma unroll
        for (int s = 0; s < 2; ++s) { const bf16x8 bb = *(const LAS bf16x8*)(VT + (16 * nt + fr) * 72 + 32 * s + 8 * fq); o = MFMA16(aatt[s], bb, o); }
#pragma unroll
        for (int s = 0; s < 8; ++s) { const bf16x8 bb = *(const LAS bf16x8*)(ST + (16 * nt + fr) * 264 + 32 * s + 8 * fq); o = MFMA16(aqd[s], bb, o); }
#pragma unroll
        for (int jj = 0; jj < 4; ++jj) O[(t0 + 16 * mt + 4 * fq + jj) * 2048 + h * 512 + 32 * js + 16 * nt + fr] = o[jj];
#pragma unroll
        for (int mi = 0; mi < 2; ++mi)
#pragma unroll
            for (int ni = 0; ni < 2; ++ni) { f32x4 a = Sacc[mi][ni] * dec[mi];
#pragma unroll
                for (int s = 0; s < 2; ++s) { const bf16x8 bb = *(const LAS bf16x8*)(VT + (16 * ni + fr) * 72 + 32 * s + 8 * fq); a = MFMA16(aket[mi][s], bb, a); }
                Sacc[mi][ni] = a; }
        BAR_LDS();
#pragma unroll
        for (int mi = 0; mi < 2; ++mi)
#pragma unroll
            for (int ni = 0; ni < 2; ++ni) { v2u wv; wv.x = pk2(Sacc[mi][ni][0], Sacc[mi][ni][1]); wv.y = pk2(Sacc[mi][ni][2], Sacc[mi][ni][3]);
                *(LAS v2u*)(ST + (16 * ni + fr) * 264 + 32 * w + 16 * mi + 4 * fq) = wv; }
    }
    BAR_LDS();
}
#undef G2_LOAD
DI void p3_scan(Frame& F) { for (int it = F.bid; it < 256; it += F.G) g2_item(F, it); }

DI void gla_out_row(Frame& F, int rowh) {
    const bf16* Z = (const bf16*)(F.ws + WS_Z); bf16* OG = (bf16*)(F.ws + WS_BUFB);
    const int t = rowh >> 2, h = rowh & 3, lane = F.lane;
    const f32x4* op = (const f32x4*)(F.out + (size_t)t * 2048 + h * 512) + lane;
    const f32x4 a = op[0], bq = op[64];
    float s = (a.x * a.x + a.y * a.y) + (a.z * a.z + a.w * a.w) + (bq.x * bq.x + bq.y * bq.y) + (bq.z * bq.z + bq.w * bq.w);
    const float rs = rsqrtf(wave_sum(s) * (1.f / 512.f) + RMS_EPS);
#pragma unroll
    for (int q = 0; q < 2; ++q) { const f32x4 v = q ? bq : a; const f32x4 g = ((const f32x4*)F.g_gla_out)[lane + 64 * q];
        const v2u rw = *(const v2u*)(Z + (size_t)t * ZW + ZGR + h * 512 + 4 * lane + 256 * q);
        const float r0 = blo(rw.x), r1 = bhi(rw.x), r2 = blo(rw.y), r3 = bhi(rw.y);
        v2u w; w.x = pk2(v.x * rs * g.x * (r0 * sigm(r0)), v.y * rs * g.y * (r1 * sigm(r1))); w.y = pk2(v.z * rs * g.z * (r2 * sigm(r2)), v.w * rs * g.w * (r3 * sigm(r3)));
        *(v2u*)(OG + (size_t)t * 2048 + h * 512 + 4 * lane + 256 * q) = w; }
}
DI int pi_key(int r) { return (r & ~12) | ((r & 4) << 1) | ((r & 8) >> 1); }

constexpr int KB_PITCH = 272, VB_PITCH = 144, KB_BYTES = 64 * KB_PITCH, KV_BUF = KB_BYTES + 128 * VB_PITCH;
constexpr int NSA_X = 2 * KV_BUF;
constexpr int NSA_IMPR = KV_BUF  , NSA_MSK = NSA_X + 69632, NSA_END = NSA_MSK + 256;
static_assert(NSA_END <= LDS_BYTES, "NSA LDS map");
struct TileRegs { v4u k[2], v[2]; };
DI void tile_gload(TileRegs& R, const bf16* kg, size_t kpitch, const bf16* vg, size_t vpitch, int tid) {
#pragma unroll
    for (int j = 0; j < 2; ++j) { const int c = tid + 512 * j;
        R.k[j] = *(const v4u*)(kg + (size_t)(c >> 4) * kpitch + (c & 15) * 8); R.v[j] = *(const v4u*)(vg + (size_t)(c >> 3) * vpitch + (c & 7) * 8); }
}
DI void tile_sstore(const TileRegs& R, LAS unsigned char* buf, int tid) {
#pragma unroll
    for (int j = 0; j < 2; ++j) { const int c = tid + 512 * j;
        *(LAS v4u*)(buf + (c >> 4) * KB_PITCH + (c & 15) * 16) = R.k[j]; *(LAS v4u*)(buf + KB_BYTES + (c >> 3) * VB_PITCH + (c & 7) * 16) = R.v[j]; }
}
DI void qk_lds(f32x16& x0, f32x16& x1, const LAS unsigned char* kb, const bf16x8 (&qf)[8]) {
#pragma unroll
    for (int i = 0; i < 16; ++i) { x0[i] = 0.f; x1[i] = 0.f; }
#pragma unroll
    for (int s = 0; s < 8; ++s) { const bf16x8 a0 = *(const LAS bf16x8*)(kb + 32 * s); const bf16x8 a1 = *(const LAS bf16x8*)(kb + 32 * KB_PITCH + 32 * s);
        x0 = MFMA32(a0, qf[s], x0); x1 = MFMA32(a1, qf[s], x1); }
}
DI void pv_lds(f32x16 (&o)[4], const f32x16& p0, const f32x16& p1, const LAS unsigned char* vb) {
#pragma unroll
    for (int mt = 0; mt < 2; ++mt)
#pragma unroll
        for (int s2 = 0; s2 < 2; ++s2) { const f32x16& p = mt ? p1 : p0;
            const bf16x8 pf = pack8(p[8 * s2], p[8 * s2 + 1], p[8 * s2 + 2], p[8 * s2 + 3], p[8 * s2 + 4], p[8 * s2 + 5], p[8 * s2 + 6], p[8 * s2 + 7]);
#pragma unroll
            for (int dt = 0; dt < 4; ++dt) { const bf16x8 a = *(const LAS bf16x8*)(vb + (32 * dt) * VB_PITCH + (32 * mt + 16 * s2) * 2); o[dt] = MFMA32(a, pf, o[dt]); } }
}
DI void softmax_step(f32x16& x0, f32x16& x1, float& m, float& l, f32x16 (&o)[4], bool rowok, float CS) {
    float mx = fmaxf(x0[0], x1[0]);
#pragma unroll
    for (int i = 1; i < 16; ++i) mx = fmaxf(mx, fmaxf(x0[i], x1[i]));
    mx = rowok ? mx : -INFINITY;
    mx = fmaxf(mx, __shfl_xor(mx, 32));
    const float mnew = fmaxf(m, mx);
    const bool need = (mnew - m) > 62.0f;
    if (__any(need)) {
        const float m2 = need ? mnew : m; const float alpha = __builtin_amdgcn_exp2f((m - m2) * CS); m = m2; l *= alpha;
#pragma unroll
        for (int dt = 0; dt < 4; ++dt) o[dt] = o[dt] * alpha;
    }
    const float negmc = rowok ? -m * CS : -INFINITY;
    float ps0 = 0.f, ps1 = 0.f;
#pragma unroll
    for (int i = 0; i < 16; ++i) { x0[i] = __builtin_amdgcn_exp2f(__builtin_fmaf(x0[i], CS, negmc)); x1[i] = __builtin_amdgcn_exp2f(__builtin_fmaf(x1[i], CS, negmc)); ps0 += x0[i]; ps1 += x1[i]; }
    l += ps0 + ps1;
}

DI void nsa_item(Frame& F, int item) {
    const bf16* Z = (const bf16*)(F.ws + WS_Z);
    const bf16* KC = (const bf16*)(F.ws + WS_KC); const bf16* VCT = (const bf16*)(F.ws + WS_VCT); const bf16* VTS = (const bf16*)(F.ws + WS_VTS); const bf16* VTW = (const bf16*)(F.ws + WS_VTW);
    bf16* ON = (bf16*)(F.ws + WS_ON);
    const int qt = item & 31, hk = (item >> 5) & 3, b = item >> 7;
    int tid = F.tid; asm volatile("" : "+v"(tid));
    const int w = F.wave, lane = tid & 63, r = lane & 31, hh = lane >> 5, g = w >> 1, th = w & 1;
    const int head = hk * 4 + g, tl = 32 * th + r  , t = 64 * qt + tl;
    const size_t trow = (size_t)b * SEQ + t;
    LAS unsigned char* buf0 = F.lds; LAS unsigned char* buf1 = F.lds + KV_BUF;
    LAS float* part = (LAS float*)(F.lds + NSA_X);
    LAS unsigned* oacc = (LAS unsigned*)(F.lds + NSA_X);
    LAS float* impr = (LAS float*)(F.lds + NSA_IMPR);
    LAS unsigned* msk = (LAS unsigned*)(F.lds + NSA_MSK);
    constexpr float CS = 0.08838834764831845f * 1.4426950408889634f;
    int kboff = pi_key(r) * KB_PITCH + 16 * hh, vboff = KB_BYTES + r * VB_PITCH + 16 * hh;
    LAS unsigned* oacc_l = oacc + w * 2048 + lane;
    asm volatile("" : "+v"(kboff), "+v"(vboff), "+v"(oacc_l));
    const int nsel = qt + 1, wlo = qt > 8 ? qt - 8 : 0, ntile = nsel + (qt - wlo + 1);
    const bf16* ksel = Z + (size_t)b * SEQ * ZW + ZNKV + 2 * 512 + hk * 128; const bf16* kwin = ksel + 2 * 512;
    const bf16* vsel = VTS + ((size_t)b * 4 + hk) * 128 * SEQ; const bf16* vwin = VTW + ((size_t)b * 4 + hk) * 128 * SEQ;
    TileRegs R;
    {
        const bf16* kc = KC + ((size_t)b * 4 + hk) * 128 * 128; const bf16* vc = VCT + ((size_t)b * 4 + hk) * 128 * 128;
        TileRegs R1; tile_gload(R, kc, 128, vc, 128, tid); tile_gload(R1, kc + 64 * 128, 128, vc + 64, 128, tid);
        for (int e = tid; e < 17408; e += 512) part[e] = 0.f;
        if (tid < 64) msk[tid] = 0u;
        tile_sstore(R, buf0, tid); tile_sstore(R1, buf1, tid);
    }
    bf16x8 qf[8];
    { const bf16* qp = Z + trow * ZW + ZNQ + head * 128 + 8 * hh;
#pragma unroll
      for (int s = 0; s < 8; ++s) qf[s] = *(const bf16x8*)(qp + 16 * s); }
    const float gate_c = sigm(bf2f(Z[trow * ZW + ZNG + head])), gate_s = sigm(bf2f(Z[trow * ZW + ZNG + 16 + head])), gate_w = sigm(bf2f(Z[trow * ZW + ZNG + 32 + head]));
    tile_gload(R, ksel, ZW, vsel, SEQ, tid);
    f32x16 o[4];
#pragma unroll
    for (int dt = 0; dt < 4; ++dt)
#pragma unroll
        for (int i = 0; i < 16; ++i) o[dt][i] = 0.f;
    BAR_LDS();
    {
        const int cmax = (t - 31) >> 4;
        float mx = -1e30f, ps = 0.f;
#pragma unroll 1
        for (int T = 0; T < 2; ++T) { f32x16 x0, x1; qk_lds(x0, x1, (T ? buf1 : buf0) + kboff, qf); float mm = -1e30f;
#pragma unroll
            for (int i = 0; i < 16; ++i) { const int cb = 64 * T + 16 * (i >> 3) + 8 * hh + (i & 7);
                x0[i] = (cb <= cmax) ? x0[i] * CS : -INFINITY; x1[i] = (cb + 32 <= cmax) ? x1[i] * CS : -INFINITY; mm = fmaxf(mm, fmaxf(x0[i], x1[i])); }
            mm = fmaxf(mm, __shfl_xor(mm, 32));
            const float mnew = fmaxf(mx, mm); float s = 0.f;
#pragma unroll
            for (int i = 0; i < 16; ++i) s += exp2f(x0[i] - mnew) + exp2f(x1[i] - mnew);
            ps = ps * exp2f(mx - mnew) + s; mx = mnew; }
        ps += __shfl_xor(ps, 32);
        const float inv = ps > 0.f ? 1.0f / ps : 0.f;
        LAS float* prow = part + ((size_t)(g * 64 + tl) * 34) * 2;
        asm volatile("" : "+v"(prow));
#pragma unroll 1
        for (int T = 0; T < 2; ++T) { f32x16 x0, x1; qk_lds(x0, x1, (T ? buf1 : buf0) + kboff, qf);
#pragma unroll
            for (int i = 0; i < 16; ++i) { const int cb = 64 * T + 16 * (i >> 3) + 8 * hh + (i & 7);
                const float s0 = (cb <= cmax) ? x0[i] * CS : -INFINITY, s1 = (cb + 32 <= cmax) ? x1[i] * CS : -INFINITY; x0[i] = exp2f(s0 - mx) * inv; x1[i] = exp2f(s1 - mx) * inv; }
#pragma unroll
            for (int mt = 0; mt < 2; ++mt)
#pragma unroll
                for (int s2 = 0; s2 < 2; ++s2) { const f32x16& p = mt ? x1 : x0;
                    const int n0 = 16 * T + 8 * mt + 4 * s2 + 2 * hh;
                    const float A = (p[8 * s2] + p[8 * s2 + 1]) + (p[8 * s2 + 2] + 0.5f * p[8 * s2 + 3]);
                    const float Bv = (0.5f * p[8 * s2 + 3] + p[8 * s2 + 4]) + (p[8 * s2 + 5] + p[8 * s2 + 6]) + 0.5f * p[8 * s2 + 7];
                    const float Cv = 0.5f * p[8 * s2 + 7];
                    prow[(n0) * 2] = A; prow[(n0 + 1) * 2] = Bv; prow[(n0 + 2) * 2 + 1] = Cv; }
            pv_lds(o, x0, x1, (T ? buf1 : buf0) + vboff); }
#pragma unroll
        for (int dt = 0; dt < 4; ++dt) o[dt] = o[dt] * gate_c;
    }
    BAR_LDS();
    tile_sstore(R, buf0, tid);
#pragma unroll
    for (int k4 = 0; k4 < 4; ++k4) { const int e = tid + 512 * k4, tok = e >> 5, n = e & 31; float s = 0.f;
#pragma unroll
        for (int gg = 0; gg < 4; ++gg) { const LAS float* pp = part + ((size_t)(gg * 64 + tok) * 34 + n) * 2; s += pp[0] + pp[1]; }
        impr[tok * 33 + n] = s; }
    BAR_LDS();
    if (qt < 16) { if (tid < 64) msk[tid] = (2u << qt) - 1u; }
    else {
#pragma unroll
        for (int k4 = 0; k4 < 4; ++k4) { const int e = tid + 512 * k4, tok = e >> 5, n = e & 31;
            if (n == 0) __hip_atomic_fetch_or(&msk[tok], 1u | (1u << qt) | (1u << (qt - 1)), __ATOMIC_RELAXED, __HIP_MEMORY_SCOPE_WORKGROUP);
            else if (n <= qt - 2) { const float v = impr[tok * 33 + n]; int rank = 0;
                for (int m2 = 1; m2 <= qt - 2; ++m2) { const float u = impr[tok * 33 + m2]; rank += (u > v || (u == v && m2 < n)) ? 1 : 0; }
                if (rank < 13) __hip_atomic_fetch_or(&msk[tok], 1u << n, __ATOMIC_RELAXED, __HIP_MEMORY_SCOPE_WORKGROUP); } }
    }
    BAR_LDS();
    const unsigned mymask = msk[tl];
#pragma unroll
    for (int dt = 0; dt < 4; ++dt)
#pragma unroll
        for (int i = 0; i < 16; i += 2) oacc_l[(dt * 8 + (i >> 1)) * 64] = pk2(o[dt][i], o[dt][i + 1]);
#pragma unroll
    for (int dt = 0; dt < 4; ++dt)
#pragma unroll
        for (int i = 0; i < 16; ++i) o[dt][i] = 0.f;
    float m = -1e30f, l = 0.f;
    for (int i = 0; i < ntile; ++i) {
        if (i + 1 < ntile) { const int i1 = i + 1; const bool br = i1 >= nsel; const int n1 = br ? wlo + (i1 - nsel) : i1;
            tile_gload(R, (br ? kwin : ksel) + (size_t)(64 * n1) * ZW, ZW, (br ? vwin : vsel) + 64 * n1, SEQ, tid); }
        if (i == nsel) {
            l += __shfl_xor(l, 32);
            const float f = l > 0.f ? gate_s / l : 0.f;
#pragma unroll
            for (int dt = 0; dt < 4; ++dt)
#pragma unroll
                for (int i2 = 0; i2 < 16; i2 += 2) { LAS unsigned* ap = oacc_l + (dt * 8 + (i2 >> 1)) * 64; const unsigned pw = *ap;
                    *ap = pk2(blo(pw) + f * o[dt][i2], bhi(pw) + f * o[dt][i2 + 1]); o[dt][i2] = 0.f; o[dt][i2 + 1] = 0.f; }
            m = -1e30f; l = 0.f;
        }
        const bool win = i >= nsel; const int n = win ? wlo + (i - nsel) : i;
        LAS unsigned char* bufc = (i & 1) ? buf1 : buf0;
        f32x16 x0, x1; qk_lds(x0, x1, bufc + kboff, qf);
        const bool rowok = win ? true : (((mymask >> n) & 1u) != 0u);
        if (n == qt || (win && n == qt - 8)) {
            const int lim = t - 64 * n, lo_lim = win ? lim - 512 : -100000;
#pragma unroll
            for (int i2 = 0; i2 < 16; ++i2) { const int kk = 16 * (i2 >> 3) + 8 * hh + (i2 & 7);
                x0[i2] = (kk <= lim && kk > lo_lim) ? x0[i2] : -INFINITY; x1[i2] = (kk + 32 <= lim && kk + 32 > lo_lim) ? x1[i2] : -INFINITY; }
        }
        softmax_step(x0, x1, m, l, o, rowok, CS);
        pv_lds(o, x0, x1, bufc + vboff);
        if (i + 1 < ntile) tile_sstore(R, (i & 1) ? buf0 : buf1, tid);
        BAR_LDS();
    }
    {
        l += __shfl_xor(l, 32);
        const float f = l > 0.f ? gate_w / l : 0.f;
        bf16* op = ON + trow * 2048 + head * 128 + 4 * hh;
#pragma unroll
        for (int dt = 0; dt < 4; ++dt)
#pragma unroll
            for (int a4 = 0; a4 < 4; ++a4) { const unsigned p0 = oacc_l[(dt * 8 + 2 * a4) * 64], p1 = oacc_l[(dt * 8 + 2 * a4 + 1) * 64];
                v2u wv; wv.x = pk2(blo(p0) + f * o[dt][4 * a4], bhi(p0) + f * o[dt][4 * a4 + 1]); wv.y = pk2(blo(p1) + f * o[dt][4 * a4 + 2], bhi(p1) + f * o[dt][4 * a4 + 3]);
                *(v2u*)(op + 32 * dt + 8 * a4) = wv; }
    }
    BAR_LDS();
}
DI void p4_nsa(Frame& F) {
    const int gw = F.bid * 8 + F.wave, NGW = F.G * 8;
    for (int rh = gw; rh < MTOK * 4; rh += NGW) gla_out_row(F, rh);
    __syncthreads();
    for (int it = F.bid; it < 256; it += F.G) {
        const int bhk = it >> 4, q = it & 15;
#pragma unroll 1
        for (int k2 = 0; k2 < 2; ++k2) nsa_item(F, bhk * 32 + (k2 ? q : 31 - q));
    }
}

#define XB_TMO      128
#define XB_XCNT(j)  (256  + 64 * (j))
#define XB_XSUB(j)  (1280 + 64 * (j))
#define XB_XGEN(j)  (2304 + 64 * (j))
#define XB_TOP      3328
#define XB_TOPGEN   3392
#define XCD_BAR_WORDS 3456
#define XB_SPIN_CAP (1u << 18)

__device__ __forceinline__ unsigned xb_ld(unsigned* p)              { return __hip_atomic_load(p, __ATOMIC_RELAXED, __HIP_MEMORY_SCOPE_AGENT); }
__device__ __forceinline__ unsigned xb_add(unsigned* p, unsigned v) { return __hip_atomic_fetch_add(p, v, __ATOMIC_RELAXED, __HIP_MEMORY_SCOPE_AGENT); }
__device__ __forceinline__ unsigned xb_xcc_id() { return (unsigned)__builtin_amdgcn_s_getreg((3 << 11) | 20) & 0xFu; }
#define XB_SPIN(cond, bar) do { unsigned _sp = 0; while (cond) { __builtin_amdgcn_s_sleep(1); \
    if ((++_sp & 255u) == 0u) { if (xb_ld(&(bar)[XB_TMO])) break; if (_sp > XB_SPIN_CAP) { atomicAdd(&(bar)[XB_TMO], 1u); break; } } } } while (0)
struct XcdBarrier {
    unsigned* bar; unsigned x;
    volatile LAS unsigned* st;
};

__device__ __forceinline__ XcdBarrier xcd_barrier_post(unsigned* bar, volatile LAS unsigned* st) {
    XcdBarrier b; b.bar = bar; b.x = xb_xcc_id(); b.st = st;
    if (threadIdx.x == 0) (void)xb_add(&bar[XB_XCNT(b.x)], 1u);
    return b;
}
__device__ __forceinline__ void xcd_barrier_complete(unsigned* bar, unsigned x, unsigned& nloc, unsigned& nx) {
    const unsigned G = gridDim.x * gridDim.y * gridDim.z;
    unsigned sum, cnt, mine, sp = 0u;
    for (;;) {
        sum = 0u; cnt = 0u; mine = 0u;
#pragma unroll
        for (unsigned j = 0; j < 16; ++j) { const unsigned c = xb_ld(&bar[XB_XCNT(j)]); sum += c; cnt += (c > 0u) ? 1u : 0u; mine = (j == x) ? c : mine; }
        if (sum == G) break;
        __builtin_amdgcn_s_sleep(1);
        if ((++sp & 255u) == 0u) { if (xb_ld(&bar[XB_TMO])) break; if (sp > XB_SPIN_CAP) { atomicAdd(&bar[XB_TMO], 1u); break; } }
    }
    nloc = mine > 0u ? mine : 1u; nx = cnt > 0u ? cnt : 1u;
}

__device__ __forceinline__ void xcd_barrier(const XcdBarrier& b) {
    asm volatile("s_waitcnt vmcnt(0)" ::: "memory");
    __syncthreads();
    if (threadIdx.x == 0) {
        unsigned* bar = b.bar;
        __builtin_amdgcn_s_waitcnt(0);
        unsigned nloc = b.st[0], nx = b.st[1];
        if (nloc == 0u) { xcd_barrier_complete(bar, b.x, nloc, nx); b.st[0] = nloc; b.st[1] = nx; }
        const unsigned old = xb_add(&bar[XB_XSUB(b.x)], 1u);
        const unsigned gen = old / nloc;
        if (old + 1u == (gen + 1u) * nloc) {
            __builtin_amdgcn_fence(__ATOMIC_RELEASE, "agent");
            asm volatile("s_waitcnt vmcnt(0)" ::: "memory");
            const unsigned og = xb_add(&bar[XB_TOP], 1u);
            const unsigned tg = og / nx;
            if (og + 1u == (tg + 1u) * nx) xb_add(&bar[XB_TOPGEN], 1u);
            else XB_SPIN(xb_ld(&bar[XB_TOPGEN]) == tg, bar);
            __builtin_amdgcn_fence(__ATOMIC_ACQUIRE, "agent");
            xb_add(&bar[XB_XGEN(b.x)], 1u);
            asm volatile("s_waitcnt vmcnt(0)" ::: "memory");
        } else {
            XB_SPIN(xb_ld(&bar[XB_XGEN(b.x)]) == gen, bar);
            __builtin_amdgcn_fence(__ATOMIC_ACQUIRE, "agent");
            asm volatile("s_waitcnt vmcnt(0)" ::: "memory");
        }
    }
    __syncthreads();
}

#ifndef MK_N_LAUNCHES
#define MK_N_LAUNCHES 1
#endif
constexpr int N_PHASES = 11;
__global__ void __launch_bounds__(512, 2) hybrid_fwd(Args args) {
    extern __shared__ __attribute__((aligned(16))) unsigned char lds_raw[];
    Frame F;
    F.lds = (LAS unsigned char*)lds_raw;
    F.tid = threadIdx.x; F.lane = F.tid & 63; F.wave = __builtin_amdgcn_readfirstlane(F.tid >> 6); F.G = gridDim.x; F.bid = blockIdx.x;
    F.x = args.in[0]; F.g_mix = args.in[1]; F.w_in = args.in[2]; F.w_gla_gate = args.in[3]; F.b_gla_gate = args.in[4]; F.g_gla_out = args.in[5];
    F.pe_k = args.in[6]; F.w_ck1 = args.in[7]; F.w_ck2 = args.in[8]; F.pe_v = args.in[9]; F.w_cv1 = args.in[10]; F.w_cv2 = args.in[11];
    F.w_pg = args.in[12]; F.w_pn = args.in[13]; F.w_out = args.in[14]; F.g_ffn = args.in[15]; F.w_fg = args.in[16]; F.w_fu = args.in[17]; F.w_fd = args.in[18]; F.g_final = args.in[19];
    F.out = args.out; F.ws = args.ws;
    const int lo = args.ph_lo, hi = args.ph_hi;
    volatile LAS unsigned* bst = (volatile LAS unsigned*)(F.lds + LDS_BYTES - 64);
    if (F.tid < 16) bst[F.tid] = 0u;
    __syncthreads();
    XcdBarrier xbar = xcd_barrier_post((unsigned*)(F.ws + WS_CTL + 65536), bst);
    if (lo < 0) cg::this_grid().sync();
    typedef pg8::bf16_t pb;
#ifndef PH_MASK
#define PH_MASK 0x7ff
#endif
#define IN(k) (((PH_MASK >> (k)) & 1) && lo <= (k) && (k) < hi)
#define SEAM(k) do { if (IN(k) && IN((k) + 1)) xcd_barrier(xbar); } while (0)
    if (IN(0)) { p0_prologue(F); } SEAM(0);
    if (IN(1)) {
        pg8::Gemm g{(const pb*)(F.ws + WS_BUFA), (const pb*)(F.ws + WS_WINT), MTOK, ZW, DM}; pg8::StaticOrder S; S.init(MTOK, ZW, F.G, F.bid);
        pg8::EpiBf16Plain E{(pb*)(F.ws + WS_Z), ZW};
        pg8::gemm_phase<pg8::EpiBf16Plain, pg8::StaticOrder, true, true>(F.lds, g, S, E);
    } SEAM(1);
#ifndef REPEAT_MASK
#define REPEAT_MASK 0
#endif
#define NREP(k) (1 + ((REPEAT_MASK >> (k)) & 1))
    if (IN(2)) { for (int rep = 0; rep < NREP(2); ++rep) p2_prep(F); } SEAM(2);
    if (IN(3)) { for (int rep = 0; rep < NREP(3); ++rep) p3_scan(F); } SEAM(3);
    if (IN(4)) { for (int rep = 0; rep < NREP(4); ++rep) p4_nsa(F); } SEAM(4);
    if (IN(5)) {
        { pg8::Gemm g{(const pb*)(F.ws + WS_BUFB), (const pb*)(F.ws + WS_WPG), MTOK, DM, DM}; pg8::StaticOrder S; S.init(MTOK, DM, F.G, F.bid);
          pg8::EpiGate<false> E{(pb*)(F.ws + WS_BUFA), (const pb*)(F.ws + WS_Z) + ZMG, DM, ZW};
          pg8::gemm_phase<pg8::EpiGate<false>, pg8::StaticOrder, true, true>(F.lds, g, S, E); }
        { pg8::Gemm g{(const pb*)(F.ws + WS_ON), (const pb*)(F.ws + WS_WPN), MTOK, DM, DM}; pg8::StaticOrder S; S.init(MTOK, DM, F.G, F.bid);
          pg8::EpiGate<true> E{(pb*)(F.ws + WS_BUFA), (const pb*)(F.ws + WS_Z) + ZMG + 2048, DM, ZW};
          pg8::gemm_phase<pg8::EpiGate<true>, pg8::StaticOrder, true, true>(F.lds, g, S, E); }
    } SEAM(5);
    if (IN(6)) {
        pg8::Gemm g{(const pb*)(F.ws + WS_BUFA), (const pb*)(F.ws + WS_WOUT), MTOK, DM, DM}; pg8::StaticOrder S; S.init(MTOK, DM, F.G, F.bid);
        pg8::EpiResF32 E{F.x, F.out, DM};
        pg8::gemm_phase<pg8::EpiResF32, pg8::StaticOrder, true, true>(F.lds, g, S, E);
    } SEAM(6);
    if (IN(7)) { for (int rep = 0; rep < NREP(7); ++rep) p7_norm_ffnw(F); } SEAM(7);
    if (IN(8)) {
        pg8::Gemm g{(const pb*)(F.ws + WS_BUFB), (const pb*)(F.ws + WS_WGU), MTOK, 2 * DFF, DM}; pg8::StaticOrder S; S.init(MTOK, 2 * DFF, F.G, F.bid);
        pg8::EpiSwiGLU E{(pb*)(F.ws + WS_ACT), DFF};
        pg8::gemm_phase<pg8::EpiSwiGLU, pg8::StaticOrder, true, true>(F.lds, g, S, E);
    } SEAM(8);
    if (IN(9)) {
        pg8::Gemm g{(const pb*)(F.ws + WS_ACT), (const pb*)(F.ws + WS_WD), MTOK, DM, DFF}; pg8::StaticOrder S; S.init(MTOK, DM, F.G, F.bid);
        pg8::EpiResF32 E{F.out, F.out, DM};
        pg8::gemm_phase<pg8::EpiResF32, pg8::StaticOrder, true, true>(F.lds, g, S, E);
    } SEAM(9);
    if (IN(10)) { p10_final(F); }
#undef IN
#undef SEAM
}

extern "C" void kernel_launch(void* const* d_in, const int* in_sizes, int n_in, void* d_out, int out_size, void* d_ws, size_t ws_size, hipStream_t stream) {
    static int grid = 0;
    if (grid == 0) {
        if (n_in != 20 || in_sizes[0] != MTOK * DM || out_size != MTOK * DM || ws_size < WS_END) {
            fprintf(stderr, "kernel_launch: unexpected shapes (n_in %d, in0 %d, out %d, ws %zu < %zu); nothing launched\n", n_in, n_in > 0 ? in_sizes[0] : -1, out_size, ws_size, (size_t)WS_END); grid = -1; return; }
        int dev = 0, cus = 0, per_cu = 0;
        if (hipGetDevice(&dev) != hipSuccess || hipDeviceGetAttribute(&cus, hipDeviceAttributeMultiprocessorCount, dev) != hipSuccess) { grid = -1; return; }
        if (hipFuncSetAttribute((const void*)hybrid_fwd, hipFuncAttributeMaxDynamicSharedMemorySize, LDS_BYTES) != hipSuccess) { fprintf(stderr, "kernel_launch: hipFuncSetAttribute failed\n"); grid = -1; return; }
        if (hipOccupancyMaxActiveBlocksPerMultiprocessor(&per_cu, (const void*)hybrid_fwd, 512, LDS_BYTES) != hipSuccess || per_cu < 1) { fprintf(stderr, "kernel_launch: occupancy query says %d blocks per CU\n", per_cu); per_cu = 1; }
        (void)hipGetLastError();
        grid = cus * (per_cu > 1 ? 1 : per_cu);
    }
    if (grid < 0) return;
    (void)hipMemsetAsync((char*)d_ws + WS_CTL, 0, CTL_ZERO_BYTES, stream);
    Args a{};
    for (int i = 0; i < 20; ++i) a.in[i] = (const float*)d_in[i];
    a.out = (float*)d_out; a.ws = (unsigned char*)d_ws;
#if MK_N_LAUNCHES == 1
    a.ph_lo = 0; a.ph_hi = N_PHASES;
    void* kargs[] = {&a};
    hipError_t e = hipLaunchCooperativeKernel((const void*)hybrid_fwd, dim3(grid), dim3(512), kargs, LDS_BYTES, stream);
    if (e != hipSuccess) fprintf(stderr, "kernel_launch: cooperative launch failed: %s (grid %d)\n", hipGetErrorString(e), grid);
#else
    for (int p = 0; p < N_PHASES; ++p) { a.ph_lo = p; a.ph_hi = p + 1; hipLaunchKernelGGL(hybrid_fwd, dim3(grid), dim3(512), LDS_BYTES, stream, a); }
#endif
}
```

```cpp
#include <hip/hip_runtime.h>
#include <hip/hip_cooperative_groups.h>
#include <cstdio>
#include <cstdint>
namespace cg = cooperative_groups;
#define MK_N_LAUNCHES 1
#define REPEAT_MASK 0
namespace pg8 {
#define PG8_LAS __attribute__((address_space(3)))
typedef unsigned short bf16_t;
typedef short bf16x8 __attribute__((ext_vector_type(8)));
typedef float f32x4 __attribute__((ext_vector_type(4)));
typedef unsigned u32x4 __attribute__((ext_vector_type(4)));
constexpr int BM = 256, BK = 64, HALF = 128, HTB = HALF * BK * 2  , STAGE_BYTES = 8 * HTB, NXCD = 8, WGM = 8;

__host__ __device__ __forceinline__ int lds_byte(int r, int c) { const int st = (r >> 4) * 2 + (c >> 5), rr = r & 15, cc = c & 31, ob = rr * 64 + cc * 2; return st * 1024 + (ob ^ (((ob >> 9) & 1) << 5)); }
__host__ __device__ __forceinline__ void stage_rc(int b, int& R, int& C) { const int st = b / 1024, sb = b % 1024, swz = sb ^ (((sb >> 9) & 1) << 5); R = (st >> 1) * 16 + swz / 64; C = (st & 1) * 32 + (swz % 64) / 2; }
__host__ __device__ __forceinline__ int perm32(int rho) { const int n = rho >> 4, i = rho & 15; return 8 * (i >> 2) + 4 * n + (i & 3); }

struct Unit { int pm, pn; };
struct Gemm { const bf16_t* A; const bf16_t* Bt; int M, N, K; };

struct StaticOrder {
    int nM, nN, nwg, G, c;
    __host__ __device__ void init(int M, int N, int G_, int c_) { nM = M / BM; nN = N / BM; nwg = nM * nN; G = G_; c = c_; }
    __host__ __device__ bool next(int i, Unit& u) const {
        const long L = (long)i * G + c; if (L >= nwg) return false;
        int wgid = (int)L; { const int q = nwg / NXCD, r = nwg % NXCD, xcd = wgid % NXCD, off = wgid / NXCD; wgid = (xcd < r ? xcd * (q + 1) : r * (q + 1) + (xcd - r) * q) + off; }
        const int nig = WGM * nN, gid = wgid / nig, fm = gid * WGM, gsz = (nM - fm) < WGM ? (nM - fm) : WGM;
        u.pm = fm + ((wgid % nig) % gsz); u.pn = (wgid % nig) / gsz; return true;
    }
    __device__ __forceinline__ void a_ready(const Unit&) const {}
    __device__ __forceinline__ void done(const Unit&) const {}
};

__device__ __forceinline__ unsigned cvt_pk_bf16(float lo, float hi) { unsigned r; asm volatile("v_cvt_pk_bf16_f32 %0, %1, %2" : "=v"(r) : "v"(lo), "v"(hi)); return r; }
__device__ __forceinline__ float bf_lo(unsigned w) { return __uint_as_float(w << 16); }
__device__ __forceinline__ float bf_hi(unsigned w) { return __uint_as_float(w & 0xffff0000u); }
__device__ __forceinline__ float sigmoidf_(float x) { return 1.0f / (1.0f + __expf(-x)); }

struct EpiBf16Plain {
    static constexpr bool PERM = true, AFTER_DRAIN = false;
    bf16_t* O; int ldc;
    __device__ __forceinline__ void operator()(const f32x4 (&acc)[2][2][4][2], const Unit& u, int wr, int wc, int fr, int fq) const {
        const int row0 = u.pm * BM + wr * 64 + fr; const int col0 = u.pn * BM + wc * 32 + 8 * fq;
#pragma unroll
        for (int ai = 0; ai < 2; ++ai)
#pragma unroll
            for (int m = 0; m < 4; ++m) { bf16_t* rowp = O + (size_t)(row0 + ai * HALF + m * 16) * ldc + col0;
#pragma unroll
                for (int bj = 0; bj < 2; ++bj) { const f32x4 v0 = acc[ai][bj][m][0], v1 = acc[ai][bj][m][1];
                    u32x4 w; w.x = cvt_pk_bf16(v0[0], v0[1]); w.y = cvt_pk_bf16(v0[2], v0[3]); w.z = cvt_pk_bf16(v1[0], v1[1]); w.w = cvt_pk_bf16(v1[2], v1[3]);
                    *(u32x4*)(rowp + bj * HALF) = w; } }
    }
};
template <bool ADD> struct EpiGate {
    static constexpr bool PERM = true, AFTER_DRAIN = false;
    bf16_t* O; const bf16_t* G; int ldo, ldg;
    __device__ __forceinline__ void operator()(const f32x4 (&acc)[2][2][4][2], const Unit& u, int wr, int wc, int fr, int fq) const {
        const int row0 = u.pm * BM + wr * 64 + fr; const int col0 = u.pn * BM + wc * 32 + 8 * fq;
#pragma unroll
        for (int ai = 0; ai < 2; ++ai)
#pragma unroll
            for (int m = 0; m < 4; ++m) { const size_t row = (size_t)(row0 + ai * HALF + m * 16);
#pragma unroll
                for (int bj = 0; bj < 2; ++bj) { const f32x4 v0 = acc[ai][bj][m][0], v1 = acc[ai][bj][m][1];
                    const u32x4 gw = *(const u32x4*)(G + row * ldg + col0 + bj * HALF);
                    float r[8];
                    r[0] = sigmoidf_(bf_lo(gw.x)) * v0[0]; r[1] = sigmoidf_(bf_hi(gw.x)) * v0[1]; r[2] = sigmoidf_(bf_lo(gw.y)) * v0[2]; r[3] = sigmoidf_(bf_hi(gw.y)) * v0[3];
                    r[4] = sigmoidf_(bf_lo(gw.z)) * v1[0]; r[5] = sigmoidf_(bf_hi(gw.z)) * v1[1]; r[6] = sigmoidf_(bf_lo(gw.w)) * v1[2]; r[7] = sigmoidf_(bf_hi(gw.w)) * v1[3];
                    bf16_t* op = O + row * ldo + col0 + bj * HALF;
                    if (ADD) { const u32x4 pw = *(const u32x4*)op;
                        r[0] += bf_lo(pw.x); r[1] += bf_hi(pw.x); r[2] += bf_lo(pw.y); r[3] += bf_hi(pw.y); r[4] += bf_lo(pw.z); r[5] += bf_hi(pw.z); r[6] += bf_lo(pw.w); r[7] += bf_hi(pw.w); }
                    u32x4 w; w.x = cvt_pk_bf16(r[0], r[1]); w.y = cvt_pk_bf16(r[2], r[3]); w.z = cvt_pk_bf16(r[4], r[5]); w.w = cvt_pk_bf16(r[6], r[7]);
                    *(u32x4*)op = w; } }
    }
};
struct EpiSwiGLU {
    static constexpr bool PERM = true, AFTER_DRAIN = false;
    bf16_t* O; int ldo;
    __device__ __forceinline__ void operator()(const f32x4 (&acc)[2][2][4][2], const Unit& u, int wr, int wc, int fr, int fq) const {
        const int row0 = u.pm * BM + wr * 64 + fr; const int col0 = u.pn * HALF + wc * 32 + 8 * fq;
#pragma unroll
        for (int ai = 0; ai < 2; ++ai)
#pragma unroll
            for (int m = 0; m < 4; ++m) { const size_t row = (size_t)(row0 + ai * HALF + m * 16);
                const f32x4 g0 = acc[ai][0][m][0], g1 = acc[ai][0][m][1], u0 = acc[ai][1][m][0], u1 = acc[ai][1][m][1];
                float r[8];
#pragma unroll
                for (int e = 0; e < 4; ++e) { r[e] = g0[e] * sigmoidf_(g0[e]) * u0[e]; r[4 + e] = g1[e] * sigmoidf_(g1[e]) * u1[e]; }
                u32x4 w; w.x = cvt_pk_bf16(r[0], r[1]); w.y = cvt_pk_bf16(r[2], r[3]); w.z = cvt_pk_bf16(r[4], r[5]); w.w = cvt_pk_bf16(r[6], r[7]);
                *(u32x4*)(O + row * ldo + col0) = w; }
    }
};
struct EpiResF32 {
    static constexpr bool PERM = false, AFTER_DRAIN = false;
    const float* base; float* out; int ldc;
    __device__ __forceinline__ void operator()(const f32x4 (&acc)[2][2][4][2], const Unit& u, int wr, int wc, int fr, int fq) const {
        const int row0 = u.pm * BM + wr * 64 + fr, col0 = u.pn * BM + wc * 32 + 4 * fq;
#pragma unroll
        for (int ai = 0; ai < 2; ++ai)
#pragma unroll
            for (int m = 0; m < 4; ++m) { const size_t off = (size_t)(row0 + ai * HALF + m * 16) * ldc + col0;
#pragma unroll
                for (int bj = 0; bj < 2; ++bj)
#pragma unroll
                    for (int n = 0; n < 2; ++n) { const f32x4 bs = *(const f32x4*)(base + off + bj * HALF + n * 16); *(f32x4*)(out + off + bj * HALF + n * 16) = bs + acc[ai][bj][m][n]; } }
    }
};
template <class Epi, class Sched, bool ALIGN_EPI = false, bool SP2 = false>
__device__ __forceinline__ void gemm_phase(PG8_LAS unsigned char* lds, const Gemm g, const Sched& S, const Epi& E) {
    const int tid = threadIdx.x, wid = __builtin_amdgcn_readfirstlane(tid >> 6), lane = tid & 63, wr = wid >> 2, wc = wid & 3, fr = lane & 15, fq = lane >> 4;
    const int K = g.K, nt = K / BK;
    unsigned voffA[2], voffB[2];
#pragma unroll
    for (int i = 0; i < 2; ++i) { int R, C; stage_rc(tid * 16 + i * 8192, R, C); const int Rb = Epi::PERM ? ((R & ~31) + perm32(R & 31)) : R;
        voffA[i] = (unsigned)(R * K + C) * 2u; voffB[i] = (unsigned)(Rb * K + C) * 2u; }
    const size_t kstep = (size_t)(BK * 2);
    const size_t hstep = (size_t)HALF * K * 2;
    const size_t tstep = 2 * hstep;
    const unsigned ldsw = (unsigned)wid * 1024u;
    const int aoff = lds_byte(wr * 64 + fr, fq * 8), boff = lds_byte(wc * 32 + fr, fq * 8);
#define PG8_SA(b, h) (((b) * 2 + (h)) * HTB)
#define PG8_SB(b, h) ((4 + (b) * 2 + (h)) * HTB)
#define PG8_STAGE(bufoff, gbase, voff) do { _Pragma("unroll") for (int _i = 0; _i < 2; ++_i) \
        __builtin_amdgcn_global_load_lds((const unsigned*)((const char*)(gbase) + (voff)[_i]), (PG8_LAS unsigned*)(lds + (bufoff) + ldsw + _i * 8192), 16, 0, 0); } while (0)
#define PG8_LDA(dst, b, h) do { _Pragma("unroll") for (int m = 0; m < 4; ++m) _Pragma("unroll") for (int k = 0; k < 2; ++k) dst[m][k] = *(const PG8_LAS bf16x8*)(lds + PG8_SA(b, h) + aoff + m * 2048 + k * 1024); } while (0)
#define PG8_LDB(dst, b, h) do { _Pragma("unroll") for (int n = 0; n < 2; ++n) _Pragma("unroll") for (int k = 0; k < 2; ++k) dst[n][k] = *(const PG8_LAS bf16x8*)(lds + PG8_SB(b, h) + boff + n * 2048 + k * 1024); } while (0)
#define PG8_MMA(ai, bj, At, Bt) do { __builtin_amdgcn_s_setprio(1); _Pragma("unroll") for (int m = 0; m < 4; ++m) _Pragma("unroll") for (int n = 0; n < 2; ++n) _Pragma("unroll") for (int k = 0; k < 2; ++k) \
        acc[ai][bj][m][n] = __builtin_amdgcn_mfma_f32_16x16x32_bf16(Bt[n][k], At[m][k], acc[ai][bj][m][n], 0, 0, 0); __builtin_amdgcn_s_setprio(0); } while (0)
#define PG8_WAIT_V(n) asm volatile("s_waitcnt vmcnt(" #n ")" ::: "memory")
#define PG8_WAIT_L(n) asm volatile("s_waitcnt lgkmcnt(" #n ")" ::: "memory")
#define PG8_BAR __builtin_amdgcn_s_barrier()
#define PG8_SCHED __builtin_amdgcn_sched_barrier(0)
    Unit cur, nxt; int ui = 0;
    if (!S.next(0, cur)) return;
    f32x4 acc[2][2][4][2];
#pragma unroll
    for (int a = 0; a < 2; ++a)
#pragma unroll
        for (int b = 0; b < 2; ++b)
#pragma unroll
            for (int m = 0; m < 4; ++m)
#pragma unroll
                for (int n = 0; n < 2; ++n) acc[a][b][m][n] = (f32x4){0.f, 0.f, 0.f, 0.f};
    bf16x8 At[4][2], B0[2][2], B1[2][2];
    const char* cA = (const char*)g.A + (size_t)cur.pm * tstep; const char* cB = (const char*)g.Bt + (size_t)cur.pn * tstep;
    S.a_ready(cur);
    if constexpr (SP2) {
        PG8_STAGE(PG8_SB(0, 0), cB, voffB); PG8_STAGE(PG8_SB(0, 1), cB + hstep, voffB); PG8_STAGE(PG8_SA(0, 0), cA, voffA); PG8_STAGE(PG8_SA(0, 1), cA + hstep, voffA);
        if (wr == 1) PG8_BAR;
        PG8_WAIT_V(2); PG8_BAR;
        PG8_STAGE(PG8_SB(1, 0), cB + kstep, voffB); PG8_STAGE(PG8_SA(1, 0), cA + kstep, voffA); PG8_STAGE(PG8_SB(1, 1), cB + hstep + kstep, voffB);
        PG8_WAIT_V(6); PG8_BAR;
    } else {
        PG8_STAGE(PG8_SB(0, 0), cB, voffB); PG8_STAGE(PG8_SA(0, 0), cA, voffA); PG8_STAGE(PG8_SB(0, 1), cB + hstep, voffB); PG8_STAGE(PG8_SA(0, 1), cA + hstep, voffA);
        if (wr == 1) PG8_BAR;
        PG8_WAIT_V(4); PG8_BAR;
        PG8_STAGE(PG8_SB(1, 0), cB + kstep, voffB); PG8_STAGE(PG8_SA(1, 0), cA + kstep, voffA); PG8_STAGE(PG8_SB(1, 1), cB + hstep + kstep, voffB);
        PG8_WAIT_V(6); PG8_BAR;
    }
    for (;;) {
        const bool has_next = S.next(ui + 1, nxt);
        const char* nA = has_next ? (const char*)g.A + (size_t)nxt.pm * tstep : cA; const char* nB = has_next ? (const char*)g.Bt + (size_t)nxt.pn * tstep : cB;
        for (int t = 0; t < nt; t += 2) {
            const bool last = (t == nt - 2);
            const char* a1 = cA + (size_t)(t + 1) * kstep;
            const char* a2 = last ? nA : cA + (size_t)(t + 2) * kstep; const char* b2 = last ? nB : cB + (size_t)(t + 2) * kstep;
            const char* a3 = a2 + kstep; const char* b3 = b2 + kstep;
            if (last && has_next) S.a_ready(nxt);
            if constexpr (SP2) {
            PG8_LDB(B0, 0, 0); PG8_LDB(B1, 0, 1); PG8_SCHED; PG8_LDA(At, 0, 0); PG8_STAGE(PG8_SA(1, 1), a1 + hstep, voffA);
            PG8_WAIT_V(8); PG8_WAIT_L(0); PG8_BAR; PG8_MMA(0, 0, At, B0); PG8_MMA(0, 1, At, B1); PG8_BAR; PG8_SCHED;
            PG8_LDA(At, 0, 1); PG8_STAGE(PG8_SB(0, 0), b2, voffB); PG8_STAGE(PG8_SB(0, 1), b2 + hstep, voffB); PG8_STAGE(PG8_SA(0, 0), a2, voffA);
            PG8_WAIT_V(8); PG8_WAIT_L(0); PG8_BAR; PG8_MMA(1, 0, At, B0); PG8_MMA(1, 1, At, B1); PG8_BAR; PG8_SCHED;
            PG8_LDB(B0, 1, 0); PG8_LDB(B1, 1, 1); PG8_SCHED; PG8_LDA(At, 1, 0); PG8_STAGE(PG8_SA(0, 1), a2 + hstep, voffA);
            PG8_WAIT_V(8); PG8_WAIT_L(0); PG8_BAR; PG8_MMA(0, 0, At, B0); PG8_MMA(0, 1, At, B1); PG8_BAR; PG8_SCHED;
            PG8_LDA(At, 1, 1); PG8_STAGE(PG8_SB(1, 0), b3, voffB); PG8_STAGE(PG8_SB(1, 1), b3 + hstep, voffB); PG8_STAGE(PG8_SA(1, 0), a3, voffA);
            PG8_WAIT_V(8); PG8_WAIT_L(0); PG8_BAR; PG8_MMA(1, 0, At, B0); PG8_MMA(1, 1, At, B1); PG8_BAR; PG8_SCHED;
            } else {
            PG8_LDB(B0, 0, 0); PG8_SCHED; PG8_LDA(At, 0, 0); PG8_STAGE(PG8_SA(1, 1), a1 + hstep, voffA);
            PG8_WAIT_L(8); PG8_BAR; PG8_WAIT_L(0); PG8_MMA(0, 0, At, B0); PG8_BAR; PG8_SCHED;
            PG8_LDB(B1, 0, 1); PG8_STAGE(PG8_SB(0, 0), b2, voffB);
            PG8_BAR; PG8_WAIT_L(0); PG8_MMA(0, 1, At, B1); PG8_BAR;
            PG8_LDA(At, 0, 1); PG8_STAGE(PG8_SA(0, 0), a2, voffA);
            PG8_BAR; PG8_WAIT_L(0); PG8_MMA(1, 0, At, B0); PG8_BAR; PG8_SCHED;
            PG8_STAGE(PG8_SB(0, 1), b2 + hstep, voffB);
            PG8_WAIT_V(6); PG8_BAR; PG8_MMA(1, 1, At, B1); PG8_BAR;
            PG8_LDB(B0, 1, 0); PG8_SCHED; PG8_LDA(At, 1, 0); PG8_STAGE(PG8_SA(0, 1), a2 + hstep, voffA);
            PG8_WAIT_L(8); PG8_BAR; PG8_WAIT_L(0); PG8_MMA(0, 0, At, B0); PG8_BAR; PG8_SCHED;
            PG8_LDB(B1, 1, 1); PG8_STAGE(PG8_SB(1, 0), b3, voffB);
            PG8_BAR; PG8_WAIT_L(0); PG8_MMA(0, 1, At, B1); PG8_BAR;
            PG8_LDA(At, 1, 1); PG8_STAGE(PG8_SA(1, 0), a3, voffA);
            PG8_BAR; PG8_WAIT_L(0); PG8_MMA(1, 0, At, B0); PG8_BAR; PG8_SCHED;
            PG8_STAGE(PG8_SB(1, 1), b3 + hstep, voffB);
            PG8_WAIT_V(6); PG8_BAR; PG8_MMA(1, 1, At, B1); PG8_BAR;
            }
        }
        if constexpr (ALIGN_EPI) { if (wr == 0) PG8_BAR; }
        if constexpr (!Epi::AFTER_DRAIN) { E(acc, cur, wr, wc, fr, fq); S.done(cur); }
        if (!has_next) break;
#pragma unroll
        for (int a = 0; a < 2; ++a)
#pragma unroll
            for (int b = 0; b < 2; ++b)
#pragma unroll
                for (int m = 0; m < 4; ++m)
#pragma unroll
                    for (int n = 0; n < 2; ++n) acc[a][b][m][n] = (f32x4){0.f, 0.f, 0.f, 0.f};
        cur = nxt; cA = nA; cB = nB; ++ui;
        if constexpr (ALIGN_EPI) { if (wr == 1) PG8_BAR; }
    }
    PG8_WAIT_V(0);
    if constexpr (!ALIGN_EPI) { if (wr == 0) PG8_BAR; }
    PG8_BAR;
    if constexpr (Epi::AFTER_DRAIN) { E.fused(acc, cur, wr, wc, fr, fq, lds, wid, lane); S.done(cur); }
#undef PG8_SA
#undef PG8_SB
#undef PG8_STAGE
#undef PG8_LDA
#undef PG8_LDB
#undef PG8_MMA
#undef PG8_WAIT_V
#undef PG8_WAIT_L
#undef PG8_BAR
#undef PG8_SCHED
}
}

constexpr int NB = 4, SEQ = 2048, DM = 2048, MTOK = NB * SEQ;
constexpr int INW = 15424, DFF = 5632;
constexpr int ZW = 15616;
constexpr int ZGQ = 0, ZGK = 1024, ZGV = 2048, ZGR = 4096, ZNQ = 6144, ZNKV = 8192, ZMG = 11264, ZGLR = 15360, ZNG = 15376;
constexpr float RMS_EPS = 1e-6f;
constexpr size_t MiB = 1u << 20;
constexpr size_t WS_CTL = 0, CTL_ZERO_BYTES = 1 * MiB;
constexpr size_t WS_BIAS1 = 4096;
constexpr size_t WS_WINT = 1 * MiB, WS_WPG = 62 * MiB, WS_WPN = 70 * MiB, WS_WOUT = 78 * MiB, WS_W1T = 86 * MiB, WS_W2T = 90 * MiB;
constexpr size_t WS_KC = 91 * MiB, WS_VCT = 91 * MiB + 512 * 1024, WS_DECAY = 92 * MiB, WS_VTS = 93 * MiB, WS_VTW = 101 * MiB, WS_ATT = 109 * MiB;
constexpr size_t WS_QD = 113 * MiB, WS_KET = 129 * MiB, WS_MERGED = 113 * MiB  ;
constexpr size_t WS_BUFA = 145 * MiB  , WS_ON = 145 * MiB, WS_BUFB = 177 * MiB  , WS_Z = 209 * MiB;
constexpr size_t WS_WGU = 209 * MiB, WS_WD = 253 * MiB, WS_ACT = 275 * MiB  ;
constexpr size_t WS_END = 453 * MiB;
constexpr int LDS_BYTES = 147456;

#define LAS __attribute__((address_space(3)))
#define DI __device__ __forceinline__
typedef unsigned short bf16;
typedef unsigned v4u __attribute__((ext_vector_type(4)));
typedef unsigned v2u __attribute__((ext_vector_type(2)));
typedef float f32x4 __attribute__((ext_vector_type(4)));
typedef float f32x16 __attribute__((ext_vector_type(16)));
typedef short bf16x8 __attribute__((ext_vector_type(8)));
typedef float f32x2_t __attribute__((ext_vector_type(2)));
typedef __bf16 bf16x2_t __attribute__((ext_vector_type(2)));
#define MFMA32(a, b, c) __builtin_amdgcn_mfma_f32_32x32x16_bf16((a), (b), (c), 0, 0, 0)
#define MFMA16(a, b, c) __builtin_amdgcn_mfma_f32_16x16x32_bf16((a), (b), (c), 0, 0, 0)
#define LDS_WAIT() asm volatile("s_waitcnt lgkmcnt(0)" ::: "memory")
#define BAR_LDS() do { asm volatile("s_waitcnt lgkmcnt(0)" ::: "memory"); __builtin_amdgcn_s_barrier(); asm volatile("" ::: "memory"); } while (0)

DI unsigned f2bf(float f) { unsigned u = __builtin_bit_cast(unsigned, f); return (u + 0x7fffu + ((u >> 16) & 1u)) >> 16; }
DI unsigned pk2(float lo, float hi) { f32x2_t v = {lo, hi}; bf16x2_t b = __builtin_convertvector(v, bf16x2_t); return __builtin_bit_cast(unsigned, b); }
DI float bf2f(bf16 b) { return __uint_as_float(((unsigned)b) << 16); }
DI float blo(unsigned w) { return __uint_as_float(w << 16); }
DI float bhi(unsigned w) { return __uint_as_float(w & 0xffff0000u); }
DI float sigm(float x) { return 1.0f / (1.0f + __expf(-x)); }
DI float wave_sum(float v) {
#pragma unroll
    for (int o = 1; o < 64; o <<= 1) v += __shfl_xor(v, o);
    return v;
}
DI bf16x8 pack8(float a0, float a1, float a2, float a3, float a4, float a5, float a6, float a7) {
    v4u p; p.x = pk2(a0, a1); p.y = pk2(a2, a3); p.z = pk2(a4, a5); p.w = pk2(a6, a7); return __builtin_bit_cast(bf16x8, p);
}

struct Args {
    const float* in[20]; float* out; unsigned char* ws; int ph_lo, ph_hi;
};
struct Frame {
    LAS unsigned char* lds; int tid, lane, wave, G, bid;
    const float* x; const float* g_mix; const float* w_in; const float* w_gla_gate; const float* b_gla_gate; const float* g_gla_out;
    const float* pe_k; const float* w_ck1; const float* w_ck2; const float* pe_v; const float* w_cv1; const float* w_cv2;
    const float* w_pg; const float* w_pn; const float* w_out; const float* g_ffn; const float* w_fg; const float* w_fu; const float* w_fd; const float* g_final;
    float* out; unsigned char* ws;
};

struct MapId { DI int operator()(int n) const { return n; } };
struct MapOff { int off; DI int operator()(int n) const { return n + off; } };
struct MapWin { DI int operator()(int n) const {
    if (n < 6144) return n; if (n < 6160) return ZGLR + (n - 6144); if (n < 8208) return ZNQ + (n - 6160);
    if (n < 11280) return ZNKV + (n - 8208); if (n < 11328) return ZNG + (n - 11280); return ZMG + (n - 11328); } };
struct MapGU { int up; DI int operator()(int n) const { return (n >> 7) * 256 + up * 128 + (n & 127); } };

template <class Map>
DI void transpose_item(const float* __restrict__ W, int N, bf16* __restrict__ WT, int Kp, LAS float* scr, int item, int lane, const Map map) {
    const int nblk = N / 32, kb = item / nblk, nb = item - kb * nblk, k0 = 64 * kb, n0 = 32 * nb;
    float tv[32];
#pragma unroll
    for (int i = 0; i < 32; ++i) { const int kk = 2 * i + (lane >> 5); tv[i] = W[(size_t)(k0 + kk) * N + n0 + (lane & 31)]; }
#pragma unroll
    for (int i = 0; i < 32; ++i) { const int kk = 2 * i + (lane >> 5); scr[kk * 33 + (lane & 31)] = tv[i]; }
    LDS_WAIT();
    const int c = lane & 7;
#pragma unroll
    for (int j = 0; j < 4; ++j) { const int n = (lane >> 3) + 8 * j; const LAS float* s = scr + (8 * c) * 33 + n;
        v4u o; o.x = pk2(s[0 * 33], s[1 * 33]); o.y = pk2(s[2 * 33], s[3 * 33]); o.z = pk2(s[4 * 33], s[5 * 33]); o.w = pk2(s[6 * 33], s[7 * 33]);
        *(v4u*)(WT + (size_t)map(n0 + n) * Kp + k0 + 8 * c) = o; }
    LDS_WAIT();
}
template <bool TO_BF16>
DI void rms_row(const float* __restrict__ xrow, const float* __restrict__ g, void* orow, int lane) {
    const f32x4* xr = (const f32x4*)xrow + lane; const f32x4* gr = (const f32x4*)g + lane;
    f32x4 v[8]; float s = 0.f;
#pragma unroll
    for (int j = 0; j < 8; ++j) { v[j] = xr[64 * j]; s += (v[j].x * v[j].x + v[j].y * v[j].y) + (v[j].z * v[j].z + v[j].w * v[j].w); }
    const float rs = rsqrtf(wave_sum(s) * (1.f / DM) + RMS_EPS);
#pragma unroll
    for (int j = 0; j < 8; ++j) { const f32x4 gg = gr[64 * j]; const f32x4 o = v[j] * rs * gg;
        if (TO_BF16) { v2u w; w.x = pk2(o.x, o.y); w.y = pk2(o.z, o.w); ((v2u*)orow)[lane + 64 * j] = w; }
        else ((f32x4*)orow)[lane + 64 * j] = o; }
}

DI void p0_prologue(Frame& F, bool with_bias) {
    LAS float* scr = (LAS float*)(F.lds + F.wave * 8448);
    const int gw = F.bid * 8 + F.wave, NGW = F.G * 8;
    bf16* WINT = (bf16*)(F.ws + WS_WINT); bf16* WPG = (bf16*)(F.ws + WS_WPG); bf16* WPN = (bf16*)(F.ws + WS_WPN); bf16* WOUT = (bf16*)(F.ws + WS_WOUT);
    bf16* W1T = (bf16*)(F.ws + WS_W1T); bf16* W2T = (bf16*)(F.ws + WS_W2T);
    constexpr int I_IN = (DM / 64) * (INW / 32), I_P = (DM / 64) * (DM / 32), I_C1 = (4096 / 64) * (256 / 32), I_C2 = (256 / 64) * (128 / 32);
    constexpr int NITEMS = I_IN + 3 * I_P + 2 * I_C1 + 2 * I_C2;
    for (int it = gw; it < NITEMS; it += NGW) {
        int r = it;
        if (r < I_IN) { transpose_item(F.w_in, INW, WINT, DM, scr, r, F.lane, MapWin{}); continue; } r -= I_IN;
        if (r < I_P) { transpose_item(F.w_pg, DM, WPG, DM, scr, r, F.lane, MapId{}); continue; } r -= I_P;
        if (r < I_P) { transpose_item(F.w_pn, DM, WPN, DM, scr, r, F.lane, MapId{}); continue; } r -= I_P;
        if (r < I_P) { transpose_item(F.w_out, DM, WOUT, DM, scr, r, F.lane, MapId{}); continue; } r -= I_P;
        if (r < I_C1) { transpose_item(F.w_ck1, 256, W1T, 4096, scr, r, F.lane, MapId{}); continue; } r -= I_C1;
        if (r < I_C1) { transpose_item(F.w_cv1, 256, W1T, 4096, scr, r, F.lane, MapOff{256}); continue; } r -= I_C1;
        if (r < I_C2) { transpose_item(F.w_ck2, 128, W2T, 256, scr, r, F.lane, MapId{}); continue; } r -= I_C2;
        transpose_item(F.w_cv2, 128, W2T, 256, scr, r, F.lane, MapOff{128});
    }
    bf16* H = (bf16*)(F.ws + WS_BUFA);
    for (int m = gw; m < MTOK; m += NGW) rms_row<true>(F.x + (size_t)m * DM, F.g_mix, H + (size_t)m * DM, F.lane);
    float* bias1 = (float*)(F.ws + WS_BIAS1);
    if (with_bias) for (int it = gw; it < 128; it += NGW) {
        const int which = it >> 6, kc = it & 63; const float* pe = which ? F.pe_v : F.pe_k; const float* w1 = which ? F.w_cv1 : F.w_ck1;
        float a[4] = {0.f, 0.f, 0.f, 0.f};
        for (int kk = kc * 64; kk < kc * 64 + 64; ++kk) { const float p = pe[kk];
#pragma unroll
            for (int q = 0; q < 4; ++q) a[q] += p * w1[(size_t)kk * 256 + F.lane + 64 * q]; }
#pragma unroll
        for (int q = 0; q < 4; ++q) atomicAdd(bias1 + which * 256 + F.lane + 64 * q, a[q]);
    }
}
DI void p7_norm_ffnw(Frame& F) {
    LAS float* scr = (LAS float*)(F.lds + F.wave * 8448);
    const int gw = F.bid * 8 + F.wave, NGW = F.G * 8;
    bf16* WGU = (bf16*)(F.ws + WS_WGU); bf16* WD = (bf16*)(F.ws + WS_WD);
    constexpr int I_G = (DM / 64) * (DFF / 32), I_D = (DFF / 64) * (DM / 32);
    for (int it = gw; it < 2 * I_G + I_D; it += NGW) {
        int r = it;
        if (r < I_G) { transpose_item(F.w_fg, DFF, WGU, DM, scr, r, F.lane, MapGU{0}); continue; } r -= I_G;
        if (r < I_G) { transpose_item(F.w_fu, DFF, WGU, DM, scr, r, F.lane, MapGU{1}); continue; } r -= I_G;
        transpose_item(F.w_fd, DM, WD, DFF, scr, r, F.lane, MapId{});
    }
    bf16* H2 = (bf16*)(F.ws + WS_BUFB);
    for (int m = gw; m < MTOK; m += NGW) rms_row<true>(F.out + (size_t)m * DM, F.g_ffn, H2 + (size_t)m * DM, F.lane);
}
DI void p10_final(Frame& F) {
    const int gw = F.bid * 8 + F.wave, NGW = F.G * 8;
    for (int m = gw; m < MTOK; m += NGW) rms_row<false>(F.out + (size_t)m * DM, F.g_final, F.out + (size_t)m * DM, F.lane);
}

DI void g1_item(Frame& F, int item) {
    const bf16* Z = (const bf16*)(F.ws + WS_Z);
    bf16* QD = (bf16*)(F.ws + WS_QD); bf16* KET = (bf16*)(F.ws + WS_KET); bf16* ATT = (bf16*)(F.ws + WS_ATT); float* DECAY = (float*)(F.ws + WS_DECAY);
    const int bh = item >> 5, c = item & 31, b = bh >> 2, h = bh & 3;
    const size_t t0 = (size_t)b * SEQ + c * 64;
    LAS float* glr_s = (LAS float*)(F.lds);
    LAS float* tot_s = (LAS float*)(F.lds + 4096);
    LAS bf16* qd_s = (LAS bf16*)(F.lds + 8192);
    LAS bf16* kd_s = (LAS bf16*)(F.lds + 8192 + 33792);
    const int tid = F.tid, dk = tid & 255, half = tid >> 8;
    for (int e = tid; e < 1024; e += 512) { const int tok = e >> 4, r = e & 15; glr_s[e] = bf2f(Z[(t0 + tok) * ZW + ZGLR + r]); }
    float wg[16];
#pragma unroll
    for (int r = 0; r < 16; ++r) wg[r] = F.w_gla_gate[r * 1024 + h * 256 + dk];
    const float bg = F.b_gla_gate[h * 256 + dk];
    __syncthreads();
    float bc[32]; float run = 0.f;
#pragma unroll
    for (int i = 0; i < 32; ++i) { const int tok = half * 32 + i; float xg = bg;
        const LAS f32x4* gp = (const LAS f32x4*)(glr_s + tok * 16);
#pragma unroll
        for (int r4 = 0; r4 < 4; ++r4) { const f32x4 gv = gp[r4]; xg += gv.x * wg[4 * r4] + gv.y * wg[4 * r4 + 1] + gv.z * wg[4 * r4 + 2] + gv.w * wg[4 * r4 + 3]; }
        const float ls = fminf(xg, 0.f) - __logf(1.0f + __expf(-fabsf(xg)));
        run += ls * 0.0625f; bc[i] = run; }
    tot_s[half * 256 + dk] = run;
    __syncthreads();
    const float tot0 = tot_s[dk], tot1 = tot_s[256 + dk]; const float blast = tot0 + tot1, boff = half ? tot0 : 0.f;
    unsigned kep[16];
#pragma unroll
    for (int i = 0; i < 32; i += 2) { float ke2[2];
#pragma unroll
        for (int e = 0; e < 2; ++e) { const int tok = half * 32 + i + e; const float bb = bc[i + e] + boff;
            const float q = bf2f(Z[(t0 + tok) * ZW + ZGQ + h * 256 + dk]), k = bf2f(Z[(t0 + tok) * ZW + ZGK + h * 256 + dk]);
            const float qd = q * 0.0625f * __expf(bb), kd = k * __expf(-bb); ke2[e] = k * __expf(blast - bb);
            const bf16 qb = (bf16)f2bf(qd); qd_s[tok * 264 + dk] = qb; kd_s[tok * 264 + dk] = (bf16)f2bf(kd); QD[(t0 + tok) * 1024 + h * 256 + dk] = qb; }
        kep[i >> 1] = pk2(ke2[0], ke2[1]); }
    { v4u* kp = (v4u*)(KET + ((size_t)item * 256 + dk) * 64 + half * 32);
#pragma unroll
      for (int q = 0; q < 4; ++q) { v4u w; w.x = kep[4 * q]; w.y = kep[4 * q + 1]; w.z = kep[4 * q + 2]; w.w = kep[4 * q + 3]; kp[q] = w; } }
    if (half == 0) DECAY[(size_t)item * 256 + dk] = __expf(blast);
    __syncthreads();
    const int w = F.wave, fr = F.lane & 15, fq = F.lane >> 4, mt = w >> 1;
#pragma unroll
    for (int nn = 0; nn < 2; ++nn) { const int nt = (w & 1) * 2 + nn; f32x4 acc = {0.f, 0.f, 0.f, 0.f};
        if (nt <= mt) {
#pragma unroll
            for (int s = 0; s < 8; ++s) { const bf16x8 a = *(const LAS bf16x8*)(qd_s + (16 * mt + fr) * 264 + 32 * s + 8 * fq); const bf16x8 bb = *(const LAS bf16x8*)(kd_s + (16 * nt + fr) * 264 + 32 * s + 8 * fq);
                acc = MFMA16(a, bb, acc); } }
#pragma unroll
        for (int j = 0; j < 4; ++j) { const int row = 16 * mt + 4 * fq + j, col = 16 * nt + fr; const float v = (col <= row) ? acc[j] : 0.f;
            ATT[(size_t)item * 4096 + row * 64 + col] = (bf16)f2bf(v); } }
    __syncthreads();
}

DI void n1_item(Frame& F, int item) {
    const bf16* Z = (const bf16*)(F.ws + WS_Z);
    const bf16* W1T = (const bf16*)(F.ws + WS_W1T); const bf16* W2T = (const bf16*)(F.ws + WS_W2T); const float* bias1 = (const float*)(F.ws + WS_BIAS1);
    bf16* KC = (bf16*)(F.ws + WS_KC); bf16* VCT = (bf16*)(F.ws + WS_VCT);
    const int which = item >> 6, b = (item >> 4) & 3, hk = (item >> 2) & 3, j = item & 3;
    const int w = F.wave, r = F.lane & 31, hh = F.lane >> 5;
    LAS bf16* hid = (LAS bf16*)(F.lds);
    int crow_ = 32 * j + r; if (crow_ > 126) crow_ = 126;
    const bf16* ap = Z + ((size_t)b * SEQ + 16 * crow_) * ZW + ZNKV + which * 512 + hk * 128 + 8 * hh;
    const bf16* bp = W1T + ((size_t)which * 256 + 32 * w + r) * 4096 + 8 * hh;
    f32x16 acc; for (int i = 0; i < 16; ++i) acc[i] = 0.f;
    bf16x8 fa[2][8], fb[2][8];
#pragma unroll
    for (int s = 0; s < 8; ++s) { fa[0][s] = *(const bf16x8*)(ap + 16 * s); fb[0][s] = *(const bf16x8*)(bp + 16 * s); }
#pragma unroll 1
    for (int tk = 0; tk < 32; tk += 2) {
#pragma unroll
        for (int s = 0; s < 8; ++s) { fa[1][s] = *(const bf16x8*)(ap + (size_t)(tk + 1) * ZW + 16 * s); fb[1][s] = *(const bf16x8*)(bp + (tk + 1) * 128 + 16 * s); }
#pragma unroll
        for (int s = 0; s < 8; ++s) acc = MFMA32(fa[0][s], fb[0][s], acc);
        const int t2 = (tk + 2 < 32) ? tk + 2 : 0;
#pragma unroll
        for (int s = 0; s < 8; ++s) { fa[0][s] = *(const bf16x8*)(ap + (size_t)t2 * ZW + 16 * s); fb[0][s] = *(const bf16x8*)(bp + t2 * 128 + 16 * s); }
#pragma unroll
        for (int s = 0; s < 8; ++s) acc = MFMA32(fa[1][s], fb[1][s], acc);
    }
    { const float bs = bias1[which * 256 + 32 * w + r];
#pragma unroll
      for (int i = 0; i < 16; ++i) { const int row = (i & 3) + 8 * (i >> 2) + 4 * hh; const float v = acc[i] + bs; hid[row * 264 + 32 * w + r] = (bf16)f2bf(v * sigm(v)); } }
    __syncthreads();
    if (w < 4) {
        f32x16 o; for (int i = 0; i < 16; ++i) o[i] = 0.f;
        const bf16* b2 = W2T + ((size_t)which * 128 + 32 * w + r) * 256 + 8 * hh;
#pragma unroll
        for (int s = 0; s < 16; ++s) { const bf16x8 a = *(const LAS bf16x8*)(hid + r * 264 + 16 * s + 8 * hh); const bf16x8 bb = *(const bf16x8*)(b2 + 16 * s); o = MFMA32(a, bb, o); }
        const int d = 32 * w + r;
        if (which == 0) {
#pragma unroll
            for (int i = 0; i < 16; ++i) { const int cc = 32 * j + (i & 3) + 8 * (i >> 2) + 4 * hh; KC[(((size_t)b * 4 + hk) * 128 + cc) * 128 + d] = (bf16)f2bf(o[i]); }
        } else {
#pragma unroll
            for (int a4 = 0; a4 < 4; ++a4) { v2u wv; wv.x = pk2(o[4 * a4], o[4 * a4 + 1]); wv.y = pk2(o[4 * a4 + 2], o[4 * a4 + 3]);
                *(v2u*)(VCT + (((size_t)b * 4 + hk) * 128 + d) * 128 + 32 * j + 8 * a4 + 4 * hh) = wv; }
        }
    }
    __syncthreads();
}
DI void vt_item(Frame& F, int item) {
    const bf16* Z = (const bf16*)(F.ws + WS_Z);
    const int dhalf = item & 1, tile = (item >> 1) & 31, hk = (item >> 6) & 3, b = (item >> 8) & 3, which = item >> 10;
    bf16* VT = (bf16*)(F.ws + (which ? WS_VTW : WS_VTS));
    LAS bf16* scr = (LAS bf16*)(F.lds + F.wave * 8448);
    const int lane = F.lane;
    const bf16* src = Z + ((size_t)b * SEQ + tile * 64) * ZW + ZNKV + (3 + 2 * which) * 512 + hk * 128 + dhalf * 64;
#pragma unroll
    for (int p = 0; p < 8; ++p) { const int tok = 8 * p + (lane >> 3), d8 = (lane & 7) * 8; const v4u v = *(const v4u*)(src + (size_t)tok * ZW + d8);
        LAS unsigned* dst = (LAS unsigned*)(scr + tok * 66 + d8); dst[0] = v.x; dst[1] = v.y; dst[2] = v.z; dst[3] = v.w; }
    LDS_WAIT();
#pragma unroll
    for (int p = 0; p < 8; ++p) { const int d = 8 * p + (lane >> 3), t8 = (lane & 7) * 8; unsigned short e[8];
#pragma unroll
        for (int q = 0; q < 8; ++q) e[q] = scr[(t8 + q) * 66 + d];
        v4u o; o.x = e[0] | ((unsigned)e[1] << 16); o.y = e[2] | ((unsigned)e[3] << 16); o.z = e[4] | ((unsigned)e[5] << 16); o.w = e[6] | ((unsigned)e[7] << 16);
        *(v4u*)(VT + (((size_t)b * 4 + hk) * 128 + dhalf * 64 + d) * SEQ + tile * 64 + t8) = o; }
    LDS_WAIT();
}
DI void p2_prep(Frame& F) {
    if (F.G == 256) {
        if (F.bid < 128) { n1_item(F, F.bid); g1_item(F, F.bid); }
        else { for (int k = 0; k < 3; ++k) g1_item(F, 128 + (F.bid - 128) * 3 + k); }
    } else { for (int it = F.bid; it < 128 + 512; it += F.G) { if (it < 128) n1_item(F, it); else g1_item(F, it - 128); } }
    __syncthreads();
    const int gw = F.bid * 8 + F.wave, NGW = F.G * 8;
    for (int it = gw; it < 2048; it += NGW) vt_item(F, it);
}

template <int NT>
DI void g2_item(Frame& F, int item) {
    constexpr int DV = 32 * NT, NJ = 16 / NT, ST_BYTES = DV * 264 * 2;
    const bf16* Z = (const bf16*)(F.ws + WS_Z);
    const bf16* QD = (const bf16*)(F.ws + WS_QD); const bf16* KET = (const bf16*)(F.ws + WS_KET); const bf16* ATT = (const bf16*)(F.ws + WS_ATT); const float* DECAY = (const float*)(F.ws + WS_DECAY);
    float* O = F.out;
    const int bh = item / NJ, js = item % NJ, b = bh >> 2, h = bh & 3;
    LAS bf16* ST = (LAS bf16*)(F.lds);
    LAS bf16* VT = (LAS bf16*)(F.lds + ST_BYTES);
    const int tid = F.tid, w = F.wave, fr = F.lane & 15, fq = F.lane >> 4, mt = w >> 1, nt0 = (w & 1) * NT;
    for (int e = tid; e < ST_BYTES / 4; e += 512) ((LAS unsigned*)ST)[e] = 0u;
    f32x4 Sacc[2][2 * NT];
#pragma unroll
    for (int a = 0; a < 2; ++a)
#pragma unroll
        for (int c2 = 0; c2 < 2 * NT; ++c2) Sacc[a][c2] = (f32x4){0.f, 0.f, 0.f, 0.f};
    const int vtok = tid >> 3, vd4 = (tid & 7) * 4 * NT;
    const size_t vcol = ZGV + h * 512 + DV * js;
    v2u vv_n[NT]; bf16x8 aatt_n[2], aqd_n[8], aket_n[2][2]; f32x4 dec_n[2];
#define G2_LOAD(cc) do { const size_t itemc_ = (size_t)bh * 32 + (cc), t0_ = (size_t)b * SEQ + (cc) * 64; \
        _Pragma("unroll") for (int q = 0; q < NT; ++q) vv_n[q] = *(const v2u*)(Z + (t0_ + vtok) * ZW + vcol + vd4 + 4 * q); \
        _Pragma("unroll") for (int s = 0; s < 2; ++s) aatt_n[s] = *(const bf16x8*)(ATT + itemc_ * 4096 + (16 * mt + fr) * 64 + 32 * s + 8 * fq); \
        _Pragma("unroll") for (int s = 0; s < 8; ++s) aqd_n[s] = *(const bf16x8*)(QD + (t0_ + 16 * mt + fr) * 1024 + h * 256 + 32 * s + 8 * fq); \
        _Pragma("unroll") for (int mi = 0; mi < 2; ++mi) { \
            _Pragma("unroll") for (int s = 0; s < 2; ++s) aket_n[mi][s] = *(const bf16x8*)(KET + (itemc_ * 256 + 32 * w + 16 * mi + fr) * 64 + 32 * s + 8 * fq); \
            dec_n[mi] = *(const f32x4*)(DECAY + itemc_ * 256 + 32 * w + 16 * mi + 4 * fq); } } while (0)
    G2_LOAD(0);
    f32x4 o_prev[NT];
#pragma unroll
    for (int q = 0; q < NT; ++q) o_prev[q] = (f32x4){0.f, 0.f, 0.f, 0.f};
    for (int c = 0; c < 32; ++c) {
        const size_t t0 = (size_t)b * SEQ + c * 64;
        v2u vv[NT];
#pragma unroll
        for (int q = 0; q < NT; ++q) vv[q] = vv_n[q];
        bf16x8 aatt[2], aqd[8], aket[2][2]; f32x4 dec[2];
#pragma unroll
        for (int s = 0; s < 2; ++s) aatt[s] = aatt_n[s];
#pragma unroll
        for (int s = 0; s < 8; ++s) aqd[s] = aqd_n[s];
#pragma unroll
        for (int mi = 0; mi < 2; ++mi) { aket[mi][0] = aket_n[mi][0]; aket[mi][1] = aket_n[mi][1]; dec[mi] = dec_n[mi]; }
        if (c > 0) {
#pragma unroll
            for (int q = 0; q < NT; ++q)
#pragma unroll
                for (int jj = 0; jj < 4; ++jj) O[(t0 - 64 + 16 * mt + 4 * fq + jj) * 2048 + h * 512 + DV * js + 16 * (nt0 + q) + fr] = o_prev[q][jj]; }
        if (c + 1 < 32) G2_LOAD(c + 1);
#pragma unroll
        for (int q = 0; q < NT; ++q) {
            VT[(vd4 + 4 * q + 0) * 72 + vtok] = (bf16)(vv[q].x & 0xffffu); VT[(vd4 + 4 * q + 1) * 72 + vtok] = (bf16)(vv[q].x >> 16);
            VT[(vd4 + 4 * q + 2) * 72 + vtok] = (bf16)(vv[q].y & 0xffffu); VT[(vd4 + 4 * q + 3) * 72 + vtok] = (bf16)(vv[q].y >> 16); }
        BAR_LDS();
#pragma unroll
        for (int q = 0; q < NT; ++q) { const int nt = nt0 + q; f32x4 o = {0.f, 0.f, 0.f, 0.f};
#pragma unroll
            for (int s = 0; s < 2; ++s) { const bf16x8 bb = *(const LAS bf16x8*)(VT + (16 * nt + fr) * 72 + 32 * s + 8 * fq); o = MFMA16(aatt[s], bb, o); }
#pragma unroll
            for (int s = 0; s < 8; ++s) { const bf16x8 bb = *(const LAS bf16x8*)(ST + (16 * nt + fr) * 264 + 32 * s + 8 * fq); o = MFMA16(aqd[s], bb, o); }
            o_prev[q] = o; }
#pragma unroll
        for (int mi = 0; mi < 2; ++mi)
#pragma unroll
            for (int ni = 0; ni < 2 * NT; ++ni) { f32x4 a = Sacc[mi][ni] * dec[mi];
#pragma unroll
                for (int s = 0; s < 2; ++s) { const bf16x8 bb = *(const LAS bf16x8*)(VT + (16 * ni + fr) * 72 + 32 * s + 8 * fq); a = MFMA16(aket[mi][s], bb, a); }
                Sacc[mi][ni] = a; }
        BAR_LDS();
#pragma unroll
        for (int mi = 0; mi < 2; ++mi)
#pragma unroll
            for (int ni = 0; ni < 2 * NT; ++ni) { v2u wv; wv.x = pk2(Sacc[mi][ni][0], Sacc[mi][ni][1]); wv.y = pk2(Sacc[mi][ni][2], Sacc[mi][ni][3]);
                *(LAS v2u*)(ST + (16 * ni + fr) * 264 + 32 * w + 16 * mi + 4 * fq) = wv; }
    }
    { const size_t t0 = (size_t)b * SEQ + 31 * 64;
#pragma unroll
      for (int q = 0; q < NT; ++q)
#pragma unroll
          for (int jj = 0; jj < 4; ++jj) O[(t0 + 16 * mt + 4 * fq + jj) * 2048 + h * 512 + DV * js + 16 * (nt0 + q) + fr] = o_prev[q][jj]; }
    BAR_LDS();
}
#undef G2_LOAD

DI void gla_out_row(Frame& F, int rowh) {
    const bf16* Z = (const bf16*)(F.ws + WS_Z); bf16* OG = (bf16*)(F.ws + WS_BUFB);
    const int t = rowh >> 2, h = rowh & 3, lane = F.lane;
    const f32x4* op = (const f32x4*)(F.out + (size_t)t * 2048 + h * 512) + lane;
    const f32x4 a = op[0], bq = op[64];
    float s = (a.x * a.x + a.y * a.y) + (a.z * a.z + a.w * a.w) + (bq.x * bq.x + bq.y * bq.y) + (bq.z * bq.z + bq.w * bq.w);
    const float rs = rsqrtf(wave_sum(s) * (1.f / 512.f) + RMS_EPS);
#pragma unroll
    for (int q = 0; q < 2; ++q) { const f32x4 v = q ? bq : a; const f32x4 g = ((const f32x4*)F.g_gla_out)[lane + 64 * q];
        const v2u rw = *(const v2u*)(Z + (size_t)t * ZW + ZGR + h * 512 + 4 * lane + 256 * q);
        const float r0 = blo(rw.x), r1 = bhi(rw.x), r2 = blo(rw.y), r3 = bhi(rw.y);
        v2u w; w.x = pk2(v.x * rs * g.x * (r0 * sigm(r0)), v.y * rs * g.y * (r1 * sigm(r1))); w.y = pk2(v.z * rs * g.z * (r2 * sigm(r2)), v.w * rs * g.w * (r3 * sigm(r3)));
        *(v2u*)(OG + (size_t)t * 2048 + h * 512 + 4 * lane + 256 * q) = w; }
}
DI int pi_key(int r) { return (r & ~12) | ((r & 4) << 1) | ((r & 8) >> 1); }

constexpr int KB_PITCH = 272, VB_PITCH = 144, KB_BYTES = 64 * KB_PITCH, KV_BUF = KB_BYTES + 128 * VB_PITCH;
constexpr int NSA_X = 2 * KV_BUF;
constexpr int NSA_IMPR = KV_BUF  , NSA_MSK = NSA_X + 69632, NSA_END = NSA_MSK + 256;
static_assert(NSA_END <= LDS_BYTES, "NSA LDS map");
struct TileRegs { v4u k[2], v[2]; };
DI void tile_gload(TileRegs& R, const bf16* kg, size_t kpitch, const bf16* vg, size_t vpitch, int tid) {
#pragma unroll
    for (int j = 0; j < 2; ++j) { const int c = tid + 512 * j;
        R.k[j] = *(const v4u*)(kg + (size_t)(c >> 4) * kpitch + (c & 15) * 8); R.v[j] = *(const v4u*)(vg + (size_t)(c >> 3) * vpitch + (c & 7) * 8); }
}
DI void tile_sstore(const TileRegs& R, LAS unsigned char* buf, int tid) {
#pragma unroll
    for (int j = 0; j < 2; ++j) { const int c = tid + 512 * j;
        *(LAS v4u*)(buf + (c >> 4) * KB_PITCH + (c & 15) * 16) = R.k[j]; *(LAS v4u*)(buf + KB_BYTES + (c >> 3) * VB_PITCH + (c & 7) * 16) = R.v[j]; }
}
DI void qk_lds(f32x16& x0, f32x16& x1, const LAS unsigned char* kb, const bf16x8 (&qf)[8]) {
#pragma unroll
    for (int i = 0; i < 16; ++i) { x0[i] = 0.f; x1[i] = 0.f; }
#pragma unroll
    for (int s = 0; s < 8; ++s) { const bf16x8 a0 = *(const LAS bf16x8*)(kb + 32 * s); const bf16x8 a1 = *(const LAS bf16x8*)(kb + 32 * KB_PITCH + 32 * s);
        x0 = MFMA32(a0, qf[s], x0); x1 = MFMA32(a1, qf[s], x1); }
}
DI void pv_lds(f32x16 (&o)[4], const f32x16& p0, const f32x16& p1, const LAS unsigned char* vb) {
#pragma unroll
    for (int mt = 0; mt < 2; ++mt)
#pragma unroll
        for (int s2 = 0; s2 < 2; ++s2) { const f32x16& p = mt ? p1 : p0;
            const bf16x8 pf = pack8(p[8 * s2], p[8 * s2 + 1], p[8 * s2 + 2], p[8 * s2 + 3], p[8 * s2 + 4], p[8 * s2 + 5], p[8 * s2 + 6], p[8 * s2 + 7]);
#pragma unroll
            for (int dt = 0; dt < 4; ++dt) { const bf16x8 a = *(const LAS bf16x8*)(vb + (32 * dt) * VB_PITCH + (32 * mt + 16 * s2) * 2); o[dt] = MFMA32(a, pf, o[dt]); } }
}
DI void softmax_step(f32x16& x0, f32x16& x1, float& m, float& l, f32x16 (&o)[4], bool rowok, float CS) {
    float mx = fmaxf(x0[0], x1[0]);
#pragma unroll
    for (int i = 1; i < 16; ++i) mx = fmaxf(mx, fmaxf(x0[i], x1[i]));
    mx = rowok ? mx : -INFINITY;
    mx = fmaxf(mx, __shfl_xor(mx, 32));
    const float mnew = fmaxf(m, mx);
    const bool need = (mnew - m) > 62.0f;
    if (__any(need)) {
        const float m2 = need ? mnew : m; const float alpha = __builtin_amdgcn_exp2f((m - m2) * CS); m = m2; l *= alpha;
#pragma unroll
        for (int dt = 0; dt < 4; ++dt) o[dt] = o[dt] * alpha;
    }
    const float negmc = rowok ? -m * CS : -INFINITY;
    float ps0 = 0.f, ps1 = 0.f;
#pragma unroll
    for (int i = 0; i < 16; ++i) { x0[i] = __builtin_amdgcn_exp2f(__builtin_fmaf(x0[i], CS, negmc)); x1[i] = __builtin_amdgcn_exp2f(__builtin_fmaf(x1[i], CS, negmc)); ps0 += x0[i]; ps1 += x1[i]; }
    l += ps0 + ps1;
}

DI void nsa_item(Frame& F, int item) {
    const bf16* Z = (const bf16*)(F.ws + WS_Z);
    const bf16* KC = (const bf16*)(F.ws + WS_KC); const bf16* VCT = (const bf16*)(F.ws + WS_VCT); const bf16* VTS = (const bf16*)(F.ws + WS_VTS); const bf16* VTW = (const bf16*)(F.ws + WS_VTW);
    bf16* ON = (bf16*)(F.ws + WS_ON);
    const int qt = item & 31, hk = (item >> 5) & 3, b = item >> 7;
    int tid = F.tid; asm volatile("" : "+v"(tid));
    const int w = F.wave, lane = tid & 63, r = lane & 31, hh = lane >> 5, g = w >> 1, th = w & 1;
    const int head = hk * 4 + g, tl = 32 * th + r  , t = 64 * qt + tl;
    const size_t trow = (size_t)b * SEQ + t;
    LAS unsigned char* buf0 = F.lds; LAS unsigned char* buf1 = F.lds + KV_BUF;
    LAS float* part = (LAS float*)(F.lds + NSA_X);
    LAS unsigned* oacc = (LAS unsigned*)(F.lds + NSA_X);
    LAS float* impr = (LAS float*)(F.lds + NSA_IMPR);
    LAS unsigned* msk = (LAS unsigned*)(F.lds + NSA_MSK);
    constexpr float CS = 0.08838834764831845f * 1.4426950408889634f;
    int kboff = pi_key(r) * KB_PITCH + 16 * hh, vboff = KB_BYTES + r * VB_PITCH + 16 * hh;
    LAS unsigned* oacc_l = oacc + w * 2048 + lane;
    asm volatile("" : "+v"(kboff), "+v"(vboff), "+v"(oacc_l));
    const int nsel = qt + 1, wlo = qt > 8 ? qt - 8 : 0, ntile = nsel + (qt - wlo + 1);
    const bf16* ksel = Z + (size_t)b * SEQ * ZW + ZNKV + 2 * 512 + hk * 128; const bf16* kwin = ksel + 2 * 512;
    const bf16* vsel = VTS + ((size_t)b * 4 + hk) * 128 * SEQ; const bf16* vwin = VTW + ((size_t)b * 4 + hk) * 128 * SEQ;
    TileRegs R;
    {
        const bf16* kc = KC + ((size_t)b * 4 + hk) * 128 * 128; const bf16* vc = VCT + ((size_t)b * 4 + hk) * 128 * 128;
        TileRegs R1; tile_gload(R, kc, 128, vc, 128, tid); tile_gload(R1, kc + 64 * 128, 128, vc + 64, 128, tid);
        for (int e = tid; e < 17408; e += 512) part[e] = 0.f;
        if (tid < 64) msk[tid] = 0u;
        tile_sstore(R, buf0, tid); tile_sstore(R1, buf1, tid);
    }
    bf16x8 qf[8];
    { const bf16* qp = Z + trow * ZW + ZNQ + head * 128 + 8 * hh;
#pragma unroll
      for (int s = 0; s < 8; ++s) qf[s] = *(const bf16x8*)(qp + 16 * s); }
    const float gate_c = sigm(bf2f(Z[trow * ZW + ZNG + head])), gate_s = sigm(bf2f(Z[trow * ZW + ZNG + 16 + head])), gate_w = sigm(bf2f(Z[trow * ZW + ZNG + 32 + head]));
    tile_gload(R, ksel, ZW, vsel, SEQ, tid);
    f32x16 o[4];
#pragma unroll
    for (int dt = 0; dt < 4; ++dt)
#pragma unroll
        for (int i = 0; i < 16; ++i) o[dt][i] = 0.f;
    BAR_LDS();
    {
        const int cmax = (t - 31) >> 4;
        float mx = -1e30f, ps = 0.f;
#pragma unroll 1
        for (int T = 0; T < 2; ++T) { f32x16 x0, x1; qk_lds(x0, x1, (T ? buf1 : buf0) + kboff, qf); float mm = -1e30f;
#pragma unroll
            for (int i = 0; i < 16; ++i) { const int cb = 64 * T + 16 * (i >> 3) + 8 * hh + (i & 7);
                x0[i] = (cb <= cmax) ? x0[i] * CS : -INFINITY; x1[i] = (cb + 32 <= cmax) ? x1[i] * CS : -INFINITY; mm = fmaxf(mm, fmaxf(x0[i], x1[i])); }
            mm = fmaxf(mm, __shfl_xor(mm, 32));
            const float mnew = fmaxf(mx, mm); float s = 0.f;
#pragma unroll
            for (int i = 0; i < 16; ++i) s += exp2f(x0[i] - mnew) + exp2f(x1[i] - mnew);
            ps = ps * exp2f(mx - mnew) + s; mx = mnew; }
        ps += __shfl_xor(ps, 32);
        const float inv = ps > 0.f ? 1.0f / ps : 0.f;
        LAS float* prow = part + ((size_t)(g * 64 + tl) * 34) * 2;
        asm volatile("" : "+v"(prow));
#pragma unroll 1
        for (int T = 0; T < 2; ++T) { f32x16 x0, x1; qk_lds(x0, x1, (T ? buf1 : buf0) + kboff, qf);
#pragma unroll
            for (int i = 0; i < 16; ++i) { const int cb = 64 * T + 16 * (i >> 3) + 8 * hh + (i & 7);
                const float s0 = (cb <= cmax) ? x0[i] * CS : -INFINITY, s1 = (cb + 32 <= cmax) ? x1[i] * CS : -INFINITY; x0[i] = exp2f(s0 - mx) * inv; x1[i] = exp2f(s1 - mx) * inv; }
#pragma unroll
            for (int mt = 0; mt < 2; ++mt)
#pragma unroll
                for (int s2 = 0; s2 < 2; ++s2) { const f32x16& p = mt ? x1 : x0;
                    const int n0 = 16 * T + 8 * mt + 4 * s2 + 2 * hh;
                    const float A = (p[8 * s2] + p[8 * s2 + 1]) + (p[8 * s2 + 2] + 0.5f * p[8 * s2 + 3]);
                    const float Bv = (0.5f * p[8 * s2 + 3] + p[8 * s2 + 4]) + (p[8 * s2 + 5] + p[8 * s2 + 6]) + 0.5f * p[8 * s2 + 7];
                    const float Cv = 0.5f * p[8 * s2 + 7];
                    prow[(n0) * 2] = A; prow[(n0 + 1) * 2] = Bv; prow[(n0 + 2) * 2 + 1] = Cv; }
            pv_lds(o, x0, x1, (T ? buf1 : buf0) + vboff); }
#pragma unroll
        for (int dt = 0; dt < 4; ++dt) o[dt] = o[dt] * gate_c;
    }
    BAR_LDS();
    tile_sstore(R, buf0, tid);
#pragma unroll
    for (int k4 = 0; k4 < 4; ++k4) { const int e = tid + 512 * k4, tok = e >> 5, n = e & 31; float s = 0.f;
#pragma unroll
        for (int gg = 0; gg < 4; ++gg) { const LAS float* pp = part + ((size_t)(gg * 64 + tok) * 34 + n) * 2; s += pp[0] + pp[1]; }
        impr[tok * 33 + n] = s; }
    BAR_LDS();
    if (qt < 16) { if (tid < 64) msk[tid] = (2u << qt) - 1u; }
    else {
#pragma unroll
        for (int k4 = 0; k4 < 4; ++k4) { const int e = tid + 512 * k4, tok = e >> 5, n = e & 31;
            if (n == 0) __hip_atomic_fetch_or(&msk[tok], 1u | (1u << qt) | (1u << (qt - 1)), __ATOMIC_RELAXED, __HIP_MEMORY_SCOPE_WORKGROUP);
            else if (n <= qt - 2) { const float v = impr[tok * 33 + n]; int rank = 0;
                for (int m2 = 1; m2 <= qt - 2; ++m2) { const float u = impr[tok * 33 + m2]; rank += (u > v || (u == v && m2 < n)) ? 1 : 0; }
                if (rank < 13) __hip_atomic_fetch_or(&msk[tok], 1u << n, __ATOMIC_RELAXED, __HIP_MEMORY_SCOPE_WORKGROUP); } }
    }
    BAR_LDS();
    const unsigned mymask = msk[tl];
#pragma unroll
    for (int dt = 0; dt < 4; ++dt)
#pragma unroll
        for (int i = 0; i < 16; i += 2) oacc_l[(dt * 8 + (i >> 1)) * 64] = pk2(o[dt][i], o[dt][i + 1]);
#pragma unroll
    for (int dt = 0; dt < 4; ++dt)
#pragma unroll
        for (int i = 0; i < 16; ++i) o[dt][i] = 0.f;
    float m = -1e30f, l = 0.f;
    for (int i = 0; i < ntile; ++i) {
        if (i + 1 < ntile) { const int i1 = i + 1; const bool br = i1 >= nsel; const int n1 = br ? wlo + (i1 - nsel) : i1;
            tile_gload(R, (br ? kwin : ksel) + (size_t)(64 * n1) * ZW, ZW, (br ? vwin : vsel) + 64 * n1, SEQ, tid); }
        if (i == nsel) {
            l += __shfl_xor(l, 32);
            const float f = l > 0.f ? gate_s / l : 0.f;
#pragma unroll
            for (int dt = 0; dt < 4; ++dt)
#pragma unroll
                for (int i2 = 0; i2 < 16; i2 += 2) { LAS unsigned* ap = oacc_l + (dt * 8 + (i2 >> 1)) * 64; const unsigned pw = *ap;
                    *ap = pk2(blo(pw) + f * o[dt][i2], bhi(pw) + f * o[dt][i2 + 1]); o[dt][i2] = 0.f; o[dt][i2 + 1] = 0.f; }
            m = -1e30f; l = 0.f;
        }
        const bool win = i >= nsel; const int n = win ? wlo + (i - nsel) : i;
        LAS unsigned char* bufc = (i & 1) ? buf1 : buf0;
        f32x16 x0, x1; qk_lds(x0, x1, bufc + kboff, qf);
        const bool rowok = win ? true : (((mymask >> n) & 1u) != 0u);
        if (n == qt || (win && n == qt - 8)) {
            const int lim = t - 64 * n, lo_lim = win ? lim - 512 : -100000;
#pragma unroll
            for (int i2 = 0; i2 < 16; ++i2) { const int kk = 16 * (i2 >> 3) + 8 * hh + (i2 & 7);
                x0[i2] = (kk <= lim && kk > lo_lim) ? x0[i2] : -INFINITY; x1[i2] = (kk + 32 <= lim && kk + 32 > lo_lim) ? x1[i2] : -INFINITY; }
        }
        softmax_step(x0, x1, m, l, o, rowok, CS);
        pv_lds(o, x0, x1, bufc + vboff);
        if (i + 1 < ntile) tile_sstore(R, (i & 1) ? buf0 : buf1, tid);
        BAR_LDS();
    }
    {
        l += __shfl_xor(l, 32);
        const float f = l > 0.f ? gate_w / l : 0.f;
        bf16* op = ON + trow * 2048 + head * 128 + 4 * hh;
#pragma unroll
        for (int dt = 0; dt < 4; ++dt)
#pragma unroll
            for (int a4 = 0; a4 < 4; ++a4) { const unsigned p0 = oacc_l[(dt * 8 + 2 * a4) * 64], p1 = oacc_l[(dt * 8 + 2 * a4 + 1) * 64];
                v2u wv; wv.x = pk2(blo(p0) + f * o[dt][4 * a4], bhi(p0) + f * o[dt][4 * a4 + 1]); wv.y = pk2(blo(p1) + f * o[dt][4 * a4 + 2], bhi(p1) + f * o[dt][4 * a4 + 3]);
                *(v2u*)(op + 32 * dt + 8 * a4) = wv; }
    }
    BAR_LDS();
}
DI int queue_next(Frame& F, unsigned* ctr) {
    LAS int* slot = (LAS int*)(F.lds + LDS_BYTES - 128);
    if (F.tid == 0) *slot = (int)atomicAdd(ctr, 1u);
    BAR_LDS(); const int v = *slot; BAR_LDS();
    return v;
}
DI void p3_scan_nsa(Frame& F) {
    for (int it = F.bid; it < 128; it += F.G) g2_item<2>(F, it);
    unsigned* ctr = (unsigned*)(F.ws + WS_CTL + 8192);
#pragma unroll 1
    for (;;) { const int it = queue_next(F, ctr); if (it >= 512) break; nsa_item(F, (it & 15) * 32 + (31 - (it >> 4))); }
}
DI void p4_gla_out(Frame& F) {
    const int gw = F.bid * 8 + F.wave, NGW = F.G * 8;
    for (int rh = gw; rh < MTOK * 4; rh += NGW) gla_out_row(F, rh);
}

#define XB_TMO      128
#define XB_XCNT(j)  (256  + 64 * (j))
#define XB_XSUB(j)  (1280 + 64 * (j))
#define XB_XGEN(j)  (2304 + 64 * (j))
#define XB_TOP      3328
#define XB_TOPGEN   3392
#define XCD_BAR_WORDS 3456
#define XB_SPIN_CAP (1u << 18)

__device__ __forceinline__ unsigned xb_ld(unsigned* p)              { return __hip_atomic_load(p, __ATOMIC_RELAXED, __HIP_MEMORY_SCOPE_AGENT); }
__device__ __forceinline__ unsigned xb_add(unsigned* p, unsigned v) { return __hip_atomic_fetch_add(p, v, __ATOMIC_RELAXED, __HIP_MEMORY_SCOPE_AGENT); }
__device__ __forceinline__ unsigned xb_xcc_id() { return (unsigned)__builtin_amdgcn_s_getreg((3 << 11) | 20) & 0xFu; }
#define XB_SPIN(cond, bar) do { unsigned _sp = 0; while (cond) { __builtin_amdgcn_s_sleep(1); \
    if ((++_sp & 255u) == 0u) { if (xb_ld(&(bar)[XB_TMO])) break; if (_sp > XB_SPIN_CAP) { atomicAdd(&(bar)[XB_TMO], 1u); break; } } } } while (0)
struct XcdBarrier {
    unsigned* bar; unsigned x;
    volatile LAS unsigned* st;
};

__device__ __forceinline__ XcdBarrier xcd_barrier_post(unsigned* bar, volatile LAS unsigned* st) {
    XcdBarrier b; b.bar = bar; b.x = xb_xcc_id(); b.st = st;
    if (threadIdx.x == 0) (void)xb_add(&bar[XB_XCNT(b.x)], 1u);
    return b;
}
__device__ __forceinline__ void xcd_barrier_complete(unsigned* bar, unsigned x, unsigned& nloc, unsigned& nx) {
    const unsigned G = gridDim.x * gridDim.y * gridDim.z;
    unsigned sum, cnt, mine, sp = 0u;
    for (;;) {
        sum = 0u; cnt = 0u; mine = 0u;
#pragma unroll
        for (unsigned j = 0; j < 16; ++j) { const unsigned c = xb_ld(&bar[XB_XCNT(j)]); sum += c; cnt += (c > 0u) ? 1u : 0u; mine = (j == x) ? c : mine; }
        if (sum == G) break;
        __builtin_amdgcn_s_sleep(1);
        if ((++sp & 255u) == 0u) { if (xb_ld(&bar[XB_TMO])) break; if (sp > XB_SPIN_CAP) { atomicAdd(&bar[XB_TMO], 1u); break; } }
    }
    nloc = mine > 0u ? mine : 1u; nx = cnt > 0u ? cnt : 1u;
}

__device__ __forceinline__ void xcd_barrier(const XcdBarrier& b) {
    asm volatile("s_waitcnt vmcnt(0)" ::: "memory");
    __syncthreads();
    if (threadIdx.x == 0) {
        unsigned* bar = b.bar;
        __builtin_amdgcn_s_waitcnt(0);
        unsigned nloc = b.st[0], nx = b.st[1];
        if (nloc == 0u) { xcd_barrier_complete(bar, b.x, nloc, nx); b.st[0] = nloc; b.st[1] = nx; }
        const unsigned old = xb_add(&bar[XB_XSUB(b.x)], 1u);
        const unsigned gen = old / nloc;
        if (old + 1u == (gen + 1u) * nloc) {
            __builtin_amdgcn_fence(__ATOMIC_RELEASE, "agent");
            asm volatile("s_waitcnt vmcnt(0)" ::: "memory");
            const unsigned og = xb_add(&bar[XB_TOP], 1u);
            const unsigned tg = og / nx;
            if (og + 1u == (tg + 1u) * nx) xb_add(&bar[XB_TOPGEN], 1u);
            else XB_SPIN(xb_ld(&bar[XB_TOPGEN]) == tg, bar);
            __builtin_amdgcn_fence(__ATOMIC_ACQUIRE, "agent");
            xb_add(&bar[XB_XGEN(b.x)], 1u);
            asm volatile("s_waitcnt vmcnt(0)" ::: "memory");
        } else {
            XB_SPIN(xb_ld(&bar[XB_XGEN(b.x)]) == gen, bar);
            __builtin_amdgcn_fence(__ATOMIC_ACQUIRE, "agent");
            asm volatile("s_waitcnt vmcnt(0)" ::: "memory");
        }
    }
    __syncthreads();
}

#ifndef MK_N_LAUNCHES
#define MK_N_LAUNCHES 1
#endif
constexpr int N_PHASES = 11;
__global__ void __launch_bounds__(512, 2) hybrid_fwd(Args args) {
    extern __shared__ __attribute__((aligned(16))) unsigned char lds_raw[];
    Frame F;
    F.lds = (LAS unsigned char*)lds_raw;
    F.tid = threadIdx.x; F.lane = F.tid & 63; F.wave = __builtin_amdgcn_readfirstlane(F.tid >> 6); F.G = gridDim.x; F.bid = blockIdx.x;
    F.x = args.in[0]; F.g_mix = args.in[1]; F.w_in = args.in[2]; F.w_gla_gate = args.in[3]; F.b_gla_gate = args.in[4]; F.g_gla_out = args.in[5];
    F.pe_k = args.in[6]; F.w_ck1 = args.in[7]; F.w_ck2 = args.in[8]; F.pe_v = args.in[9]; F.w_cv1 = args.in[10]; F.w_cv2 = args.in[11];
    F.w_pg = args.in[12]; F.w_pn = args.in[13]; F.w_out = args.in[14]; F.g_ffn = args.in[15]; F.w_fg = args.in[16]; F.w_fu = args.in[17]; F.w_fd = args.in[18]; F.g_final = args.in[19];
    F.out = args.out; F.ws = args.ws;
    const int lo = args.ph_lo, hi = args.ph_hi;
    volatile LAS unsigned* bst = (volatile LAS unsigned*)(F.lds + LDS_BYTES - 64);
    if (F.tid < 16) bst[F.tid] = 0u;
    __syncthreads();
    XcdBarrier xbar = xcd_barrier_post((unsigned*)(F.ws + WS_CTL + 65536), bst);
    if (lo < 0) cg::this_grid().sync();
    typedef pg8::bf16_t pb;
#ifndef PH_MASK
#define PH_MASK 0x7ff
#endif
#define IN(k) (((PH_MASK >> (k)) & 1) && lo <= (k) && (k) < hi)
#ifndef REPEAT_MASK
#define REPEAT_MASK 0
#endif
#define NREP(k) (1 + ((REPEAT_MASK >> (k)) & 1))
#define SEAM(k) do { if (IN(k) && IN((k) + 1)) xcd_barrier(xbar); } while (0)
    if (IN(0)) { for (int rep = 0; rep < NREP(0); ++rep) p0_prologue(F, rep == 0); } SEAM(0);
    if (IN(1)) for (int rep = 0; rep < NREP(1); ++rep) {
        pg8::Gemm g{(const pb*)(F.ws + WS_BUFA), (const pb*)(F.ws + WS_WINT), MTOK, ZW, DM}; pg8::StaticOrder S; S.init(MTOK, ZW, F.G, F.bid);
        pg8::EpiBf16Plain E{(pb*)(F.ws + WS_Z), ZW};
        pg8::gemm_phase<pg8::EpiBf16Plain, pg8::StaticOrder, true, true>(F.lds, g, S, E);
    } SEAM(1);
    if (IN(2)) { for (int rep = 0; rep < NREP(2); ++rep) p2_prep(F); } SEAM(2);
    if (IN(3)) { p3_scan_nsa(F); } SEAM(3);
    if (IN(4)) { p4_gla_out(F); } SEAM(4);
    if (IN(5)) {
        { pg8::Gemm g{(const pb*)(F.ws + WS_BUFB), (const pb*)(F.ws + WS_WPG), MTOK, DM, DM}; pg8::StaticOrder S; S.init(MTOK, DM, F.G, F.bid);
          pg8::EpiGate<false> E{(pb*)(F.ws + WS_MERGED), (const pb*)(F.ws + WS_Z) + ZMG, DM, ZW};
          pg8::gemm_phase<pg8::EpiGate<false>, pg8::StaticOrder, true, true>(F.lds, g, S, E); }
        { pg8::Gemm g{(const pb*)(F.ws + WS_ON), (const pb*)(F.ws + WS_WPN), MTOK, DM, DM}; pg8::StaticOrder S; S.init(MTOK, DM, F.G, F.bid);
          pg8::EpiGate<true> E{(pb*)(F.ws + WS_MERGED), (const pb*)(F.ws + WS_Z) + ZMG + 2048, DM, ZW};
          pg8::gemm_phase<pg8::EpiGate<true>, pg8::StaticOrder, true, true>(F.lds, g, S, E); }
    } SEAM(5);
    if (IN(6)) {
        pg8::Gemm g{(const pb*)(F.ws + WS_MERGED), (const pb*)(F.ws + WS_WOUT), MTOK, DM, DM}; pg8::StaticOrder S; S.init(MTOK, DM, F.G, F.bid);
        pg8::EpiResF32 E{F.x, F.out, DM};
        pg8::gemm_phase<pg8::EpiResF32, pg8::StaticOrder, true, true>(F.lds, g, S, E);
    } SEAM(6);
    if (IN(7)) { for (int rep = 0; rep < NREP(7); ++rep) p7_norm_ffnw(F); } SEAM(7);
    if (IN(8)) for (int rep = 0; rep < NREP(8); ++rep) {
        pg8::Gemm g{(const pb*)(F.ws + WS_BUFB), (const pb*)(F.ws + WS_WGU), MTOK, 2 * DFF, DM}; pg8::StaticOrder S; S.init(MTOK, 2 * DFF, F.G, F.bid);
        pg8::EpiSwiGLU E{(pb*)(F.ws + WS_ACT), DFF};
        pg8::gemm_phase<pg8::EpiSwiGLU, pg8::StaticOrder, true, true>(F.lds, g, S, E);
    } SEAM(8);
    if (IN(9)) {
        pg8::Gemm g{(const pb*)(F.ws + WS_ACT), (const pb*)(F.ws + WS_WD), MTOK, DM, DFF}; pg8::StaticOrder S; S.init(MTOK, DM, F.G, F.bid);
        pg8::EpiResF32 E{F.out, F.out, DM};
        pg8::gemm_phase<pg8::EpiResF32, pg8::StaticOrder, true, true>(F.lds, g, S, E);
    } SEAM(9);
    if (IN(10)) { p10_final(F); }
#undef IN
#undef SEAM
}

extern "C" void kernel_launch(void* const* d_in, const int* in_sizes, int n_in, void* d_out, int out_size, void* d_ws, size_t ws_size, hipStream_t stream) {
    static int grid = 0;
    if (grid == 0) {
        if (n_in != 20 || in_sizes[0] != MTOK * DM || out_size != MTOK * DM || ws_size < WS_END) {
            fprintf(stderr, "kernel_launch: unexpected shapes (n_in %d, in0 %d, out %d, ws %zu < %zu); nothing launched\n", n_in, n_in > 0 ? in_sizes[0] : -1, out_size, ws_size, (size_t)WS_END); grid = -1; return; }
        int dev = 0, cus = 0, per_cu = 0;
        if (hipGetDevice(&dev) != hipSuccess || hipDeviceGetAttribute(&cus, hipDeviceAttributeMultiprocessorCount, dev) != hipSuccess) { grid = -1; return; }
        if (hipFuncSetAttribute((const void*)hybrid_fwd, hipFuncAttributeMaxDynamicSharedMemorySize, LDS_BYTES) != hipSuccess) { fprintf(stderr, "kernel_launch: hipFuncSetAttribute failed\n"); grid = -1; return; }
        if (hipOccupancyMaxActiveBlocksPerMultiprocessor(&per_cu, (const void*)hybrid_fwd, 512, LDS_BYTES) != hipSuccess || per_cu < 1) { fprintf(stderr, "kernel_launch: occupancy query says %d blocks per CU\n", per_cu); per_cu = 1; }
        (void)hipGetLastError();
        grid = cus * (per_cu > 1 ? 1 : per_cu);
    }
    if (grid < 0) return;
    (void)hipMemsetAsync((char*)d_ws + WS_CTL, 0, CTL_ZERO_BYTES, stream);
    Args a{};
    for (int i = 0; i < 20; ++i) a.in[i] = (const float*)d_in[i];
    a.out = (float*)d_out; a.ws = (unsigned char*)d_ws;
#if MK_N_LAUNCHES == 1
    a.ph_lo = 0; a.ph_hi = N_PHASES;
    void* kargs[] = {&a};
    hipError_t e = hipLaunchCooperativeKernel((const void*)hybrid_fwd, dim3(grid), dim3(512), kargs, LDS_BYTES, stream);
    if (e != hipSuccess) fprintf(stderr, "kernel_launch: cooperative launch failed: %s (grid %d)\n", hipGetErrorString(e), grid);
#else
    for (int p = 0; p < N_PHASES; ++p) { a.ph_lo = p; a.ph_hi = p + 1; hipLaunchKernelGGL(hybrid_fwd, dim3(grid), dim3(512), LDS_BYTES, stream, a); }
#endif
}
```

```cpp
#include <hip/hip_runtime.h>
#include <hip/hip_cooperative_groups.h>
#include <cstdio>
#include <cstdint>
namespace cg = cooperative_groups;
#define MK_N_LAUNCHES 1
#define REPEAT_MASK 0
namespace pg8 {
#define PG8_LAS __attribute__((address_space(3)))
typedef unsigned short bf16_t;
typedef short bf16x8 __attribute__((ext_vector_type(8)));
typedef float f32x4 __attribute__((ext_vector_type(4)));
typedef unsigned u32x4 __attribute__((ext_vector_type(4)));
constexpr int BM = 256, BK = 64, HALF = 128, HTB = HALF * BK * 2  , STAGE_BYTES = 8 * HTB, NXCD = 8, WGM = 8;

__host__ __device__ __forceinline__ int lds_byte(int r, int c) { const int st = (r >> 4) * 2 + (c >> 5), rr = r & 15, cc = c & 31, ob = rr * 64 + cc * 2; return st * 1024 + (ob ^ (((ob >> 9) & 1) << 5)); }
__host__ __device__ __forceinline__ void stage_rc(int b, int& R, int& C) { const int st = b / 1024, sb = b % 1024, swz = sb ^ (((sb >> 9) & 1) << 5); R = (st >> 1) * 16 + swz / 64; C = (st & 1) * 32 + (swz % 64) / 2; }
__host__ __device__ __forceinline__ int perm32(int rho) { const int n = rho >> 4, i = rho & 15; return 8 * (i >> 2) + 4 * n + (i & 3); }

struct Unit { int pm, pn; };
struct Gemm { const bf16_t* A; const bf16_t* Bt; int M, N, K; };

struct StaticOrder {
    int nM, nN, nwg, G, c;
    __host__ __device__ void init(int M, int N, int G_, int c_) { nM = M / BM; nN = N / BM; nwg = nM * nN; G = G_; c = c_; }
    __host__ __device__ bool next(int i, Unit& u) const {
        const long L = (long)i * G + c; if (L >= nwg) return false;
        int wgid = (int)L; { const int q = nwg / NXCD, r = nwg % NXCD, xcd = wgid % NXCD, off = wgid / NXCD; wgid = (xcd < r ? xcd * (q + 1) : r * (q + 1) + (xcd - r) * q) + off; }
        const int nig = WGM * nN, gid = wgid / nig, fm = gid * WGM, gsz = (nM - fm) < WGM ? (nM - fm) : WGM;
        u.pm = fm + ((wgid % nig) % gsz); u.pn = (wgid % nig) / gsz; return true;
    }
    __device__ __forceinline__ void a_ready(const Unit&) const {}
    __device__ __forceinline__ void done(const Unit&) const {}
};

__device__ __forceinline__ unsigned cvt_pk_bf16(float lo, float hi) { unsigned r; asm volatile("v_cvt_pk_bf16_f32 %0, %1, %2" : "=v"(r) : "v"(lo), "v"(hi)); return r; }
__device__ __forceinline__ float bf_lo(unsigned w) { return __uint_as_float(w << 16); }
__device__ __forceinline__ float bf_hi(unsigned w) { return __uint_as_float(w & 0xffff0000u); }
__device__ __forceinline__ float sigmoidf_(float x) { return 1.0f / (1.0f + __expf(-x)); }

struct EpiBf16Plain {
    static constexpr bool PERM = true, AFTER_DRAIN = false;
    bf16_t* O; int ldc;
    __device__ __forceinline__ void operator()(const f32x4 (&acc)[2][2][4][2], const Unit& u, int wr, int wc, int fr, int fq) const {
        const int row0 = u.pm * BM + wr * 64 + fr; const int col0 = u.pn * BM + wc * 32 + 8 * fq;
#pragma unroll
        for (int ai = 0; ai < 2; ++ai)
#pragma unroll
            for (int m = 0; m < 4; ++m) { bf16_t* rowp = O + (size_t)(row0 + ai * HALF + m * 16) * ldc + col0;
#pragma unroll
                for (int bj = 0; bj < 2; ++bj) { const f32x4 v0 = acc[ai][bj][m][0], v1 = acc[ai][bj][m][1];
                    u32x4 w; w.x = cvt_pk_bf16(v0[0], v0[1]); w.y = cvt_pk_bf16(v0[2], v0[3]); w.z = cvt_pk_bf16(v1[0], v1[1]); w.w = cvt_pk_bf16(v1[2], v1[3]);
                    *(u32x4*)(rowp + bj * HALF) = w; } }
    }
};
template <bool ADD> struct EpiGate {
    static constexpr bool PERM = true, AFTER_DRAIN = false;
    bf16_t* O; const bf16_t* G; int ldo, ldg;
    __device__ __forceinline__ void operator()(const f32x4 (&acc)[2][2][4][2], const Unit& u, int wr, int wc, int fr, int fq) const {
        const int row0 = u.pm * BM + wr * 64 + fr; const int col0 = u.pn * BM + wc * 32 + 8 * fq;
#pragma unroll
        for (int ai = 0; ai < 2; ++ai)
#pragma unroll
            for (int m = 0; m < 4; ++m) { const size_t row = (size_t)(row0 + ai * HALF + m * 16);
#pragma unroll
                for (int bj = 0; bj < 2; ++bj) { const f32x4 v0 = acc[ai][bj][m][0], v1 = acc[ai][bj][m][1];
                    const u32x4 gw = *(const u32x4*)(G + row * ldg + col0 + bj * HALF);
                    float r[8];
                    r[0] = sigmoidf_(bf_lo(gw.x)) * v0[0]; r[1] = sigmoidf_(bf_hi(gw.x)) * v0[1]; r[2] = sigmoidf_(bf_lo(gw.y)) * v0[2]; r[3] = sigmoidf_(bf_hi(gw.y)) * v0[3];
                    r[4] = sigmoidf_(bf_lo(gw.z)) * v1[0]; r[5] = sigmoidf_(bf_hi(gw.z)) * v1[1]; r[6] = sigmoidf_(bf_lo(gw.w)) * v1[2]; r[7] = sigmoidf_(bf_hi(gw.w)) * v1[3];
                    bf16_t* op = O + row * ldo + col0 + bj * HALF;
                    if (ADD) { const u32x4 pw = *(const u32x4*)op;
                        r[0] += bf_lo(pw.x); r[1] += bf_hi(pw.x); r[2] += bf_lo(pw.y); r[3] += bf_hi(pw.y); r[4] += bf_lo(pw.z); r[5] += bf_hi(pw.z); r[6] += bf_lo(pw.w); r[7] += bf_hi(pw.w); }
                    u32x4 w; w.x = cvt_pk_bf16(r[0], r[1]); w.y = cvt_pk_bf16(r[2], r[3]); w.z = cvt_pk_bf16(r[4], r[5]); w.w = cvt_pk_bf16(r[6], r[7]);
                    *(u32x4*)op = w; } }
    }
};
struct EpiSwiGLU {
    static constexpr bool PERM = true, AFTER_DRAIN = false;
    bf16_t* O; int ldo;
    __device__ __forceinline__ void operator()(const f32x4 (&acc)[2][2][4][2], const Unit& u, int wr, int wc, int fr, int fq) const {
        const int row0 = u.pm * BM + wr * 64 + fr; const int col0 = u.pn * HALF + wc * 32 + 8 * fq;
#pragma unroll
        for (int ai = 0; ai < 2; ++ai)
#pragma unroll
            for (int m = 0; m < 4; ++m) { const size_t row = (size_t)(row0 + ai * HALF + m * 16);
                const f32x4 g0 = acc[ai][0][m][0], g1 = acc[ai][0][m][1], u0 = acc[ai][1][m][0], u1 = acc[ai][1][m][1];
                float r[8];
#pragma unroll
                for (int e = 0; e < 4; ++e) { r[e] = g0[e] * sigmoidf_(g0[e]) * u0[e]; r[4 + e] = g1[e] * sigmoidf_(g1[e]) * u1[e]; }
                u32x4 w; w.x = cvt_pk_bf16(r[0], r[1]); w.y = cvt_pk_bf16(r[2], r[3]); w.z = cvt_pk_bf16(r[4], r[5]); w.w = cvt_pk_bf16(r[6], r[7]);
                *(u32x4*)(O + row * ldo + col0) = w; }
    }
};
struct EpiResF32 {
    static constexpr bool PERM = false, AFTER_DRAIN = false;
    const float* base; float* out; int ldc;
    __device__ __forceinline__ void operator()(const f32x4 (&acc)[2][2][4][2], const Unit& u, int wr, int wc, int fr, int fq) const {
        const int row0 = u.pm * BM + wr * 64 + fr, col0 = u.pn * BM + wc * 32 + 4 * fq;
#pragma unroll
        for (int ai = 0; ai < 2; ++ai)
#pragma unroll
            for (int m = 0; m < 4; ++m) { const size_t off = (size_t)(row0 + ai * HALF + m * 16) * ldc + col0;
#pragma unroll
                for (int bj = 0; bj < 2; ++bj)
#pragma unroll
                    for (int n = 0; n < 2; ++n) { const f32x4 bs = *(const f32x4*)(base + off + bj * HALF + n * 16); *(f32x4*)(out + off + bj * HALF + n * 16) = bs + acc[ai][bj][m][n]; } }
    }
};
template <class Epi, class Sched, bool ALIGN_EPI = false, bool SP2 = false>
__device__ __forceinline__ void gemm_phase(PG8_LAS unsigned char* lds, const Gemm g, const Sched& S, const Epi& E) {
    const int tid = threadIdx.x, wid = __builtin_amdgcn_readfirstlane(tid >> 6), lane = tid & 63, wr = wid >> 2, wc = wid & 3, fr = lane & 15, fq = lane >> 4;
    const int K = g.K, nt = K / BK;
    unsigned voffA[2], voffB[2];
#pragma unroll
    for (int i = 0; i < 2; ++i) { int R, C; stage_rc(tid * 16 + i * 8192, R, C); const int Rb = Epi::PERM ? ((R & ~31) + perm32(R & 31)) : R;
        voffA[i] = (unsigned)(R * K + C) * 2u; voffB[i] = (unsigned)(Rb * K + C) * 2u; }
    const size_t kstep = (size_t)(BK * 2);
    const size_t hstep = (size_t)HALF * K * 2;
    const size_t tstep = 2 * hstep;
    const unsigned ldsw = (unsigned)wid * 1024u;
    const int aoff = lds_byte(wr * 64 + fr, fq * 8), boff = lds_byte(wc * 32 + fr, fq * 8);
#define PG8_SA(b, h) (((b) * 2 + (h)) * HTB)
#define PG8_SB(b, h) ((4 + (b) * 2 + (h)) * HTB)
#define PG8_STAGE(bufoff, gbase, voff) do { _Pragma("unroll") for (int _i = 0; _i < 2; ++_i) \
        __builtin_amdgcn_global_load_lds((const unsigned*)((const char*)(gbase) + (voff)[_i]), (PG8_LAS unsigned*)(lds + (bufoff) + ldsw + _i * 8192), 16, 0, 0); } while (0)
#define PG8_LDA(dst, b, h) do { _Pragma("unroll") for (int m = 0; m < 4; ++m) _Pragma("unroll") for (int k = 0; k < 2; ++k) dst[m][k] = *(const PG8_LAS bf16x8*)(lds + PG8_SA(b, h) + aoff + m * 2048 + k * 1024); } while (0)
#define PG8_LDB(dst, b, h) do { _Pragma("unroll") for (int n = 0; n < 2; ++n) _Pragma("unroll") for (int k = 0; k < 2; ++k) dst[n][k] = *(const PG8_LAS bf16x8*)(lds + PG8_SB(b, h) + boff + n * 2048 + k * 1024); } while (0)
#define PG8_MMA(ai, bj, At, Bt) do { __builtin_amdgcn_s_setprio(1); _Pragma("unroll") for (int m = 0; m < 4; ++m) _Pragma("unroll") for (int n = 0; n < 2; ++n) _Pragma("unroll") for (int k = 0; k < 2; ++k) \
        acc[ai][bj][m][n] = __builtin_amdgcn_mfma_f32_16x16x32_bf16(Bt[n][k], At[m][k], acc[ai][bj][m][n], 0, 0, 0); __builtin_amdgcn_s_setprio(0); } while (0)
#define PG8_WAIT_V(n) asm volatile("s_waitcnt vmcnt(" #n ")" ::: "memory")
#define PG8_WAIT_L(n) asm volatile("s_waitcnt lgkmcnt(" #n ")" ::: "memory")
#define PG8_BAR __builtin_amdgcn_s_barrier()
#define PG8_SCHED __builtin_amdgcn_sched_barrier(0)
    Unit cur, nxt; int ui = 0;
    if (!S.next(0, cur)) return;
    f32x4 acc[2][2][4][2];
#pragma unroll
    for (int a = 0; a < 2; ++a)
#pragma unroll
        for (int b = 0; b < 2; ++b)
#pragma unroll
            for (int m = 0; m < 4; ++m)
#pragma unroll
                for (int n = 0; n < 2; ++n) acc[a][b][m][n] = (f32x4){0.f, 0.f, 0.f, 0.f};
    bf16x8 At[4][2], B0[2][2], B1[2][2];
    const char* cA = (const char*)g.A + (size_t)cur.pm * tstep; const char* cB = (const char*)g.Bt + (size_t)cur.pn * tstep;
    S.a_ready(cur);
    if constexpr (SP2) {
        PG8_STAGE(PG8_SB(0, 0), cB, voffB); PG8_STAGE(PG8_SB(0, 1), cB + hstep, voffB); PG8_STAGE(PG8_SA(0, 0), cA, voffA); PG8_STAGE(PG8_SA(0, 1), cA + hstep, voffA);
        if (wr == 1) PG8_BAR;
        PG8_WAIT_V(2); PG8_BAR;
        PG8_STAGE(PG8_SB(1, 0), cB + kstep, voffB); PG8_STAGE(PG8_SA(1, 0), cA + kstep, voffA); PG8_STAGE(PG8_SB(1, 1), cB + hstep + kstep, voffB);
        PG8_WAIT_V(6); PG8_BAR;
    } else {
        PG8_STAGE(PG8_SB(0, 0), cB, voffB); PG8_STAGE(PG8_SA(0, 0), cA, voffA); PG8_STAGE(PG8_SB(0, 1), cB + hstep, voffB); PG8_STAGE(PG8_SA(0, 1), cA + hstep, voffA);
        if (wr == 1) PG8_BAR;
        PG8_WAIT_V(4); PG8_BAR;
        PG8_STAGE(PG8_SB(1, 0), cB + kstep, voffB); PG8_STAGE(PG8_SA(1, 0), cA + kstep, voffA); PG8_STAGE(PG8_SB(1, 1), cB + hstep + kstep, voffB);
        PG8_WAIT_V(6); PG8_BAR;
    }
    for (;;) {
        const bool has_next = S.next(ui + 1, nxt);
        const char* nA = has_next ? (const char*)g.A + (size_t)nxt.pm * tstep : cA; const char* nB = has_next ? (const char*)g.Bt + (size_t)nxt.pn * tstep : cB;
        for (int t = 0; t < nt; t += 2) {
            const bool last = (t == nt - 2);
            const char* a1 = cA + (size_t)(t + 1) * kstep;
            const char* a2 = last ? nA : cA + (size_t)(t + 2) * kstep; const char* b2 = last ? nB : cB + (size_t)(t + 2) * kstep;
            const char* a3 = a2 + kstep; const char* b3 = b2 + kstep;
            if (last && has_next) S.a_ready(nxt);
            if constexpr (SP2) {
            PG8_LDB(B0, 0, 0); PG8_LDB(B1, 0, 1); PG8_SCHED; PG8_LDA(At, 0, 0); PG8_STAGE(PG8_SA(1, 1), a1 + hstep, voffA);
            PG8_WAIT_V(8); PG8_WAIT_L(0); PG8_BAR; PG8_MMA(0, 0, At, B0); PG8_MMA(0, 1, At, B1); PG8_BAR; PG8_SCHED;
            PG8_LDA(At, 0, 1); PG8_STAGE(PG8_SB(0, 0), b2, voffB); PG8_STAGE(PG8_SB(0, 1), b2 + hstep, voffB); PG8_STAGE(PG8_SA(0, 0), a2, voffA);
            PG8_WAIT_V(8); PG8_WAIT_L(0); PG8_BAR; PG8_MMA(1, 0, At, B0); PG8_MMA(1, 1, At, B1); PG8_BAR; PG8_SCHED;
            PG8_LDB(B0, 1, 0); PG8_LDB(B1, 1, 1); PG8_SCHED; PG8_LDA(At, 1, 0); PG8_STAGE(PG8_SA(0, 1), a2 + hstep, voffA);
            PG8_WAIT_V(8); PG8_WAIT_L(0); PG8_BAR; PG8_MMA(0, 0, At, B0); PG8_MMA(0, 1, At, B1); PG8_BAR; PG8_SCHED;
            PG8_LDA(At, 1, 1); PG8_STAGE(PG8_SB(1, 0), b3, voffB); PG8_STAGE(PG8_SB(1, 1), b3 + hstep, voffB); PG8_STAGE(PG8_SA(1, 0), a3, voffA);
            PG8_WAIT_V(8); PG8_WAIT_L(0); PG8_BAR; PG8_MMA(1, 0, At, B0); PG8_MMA(1, 1, At, B1); PG8_BAR; PG8_SCHED;
            } else {
            PG8_LDB(B0, 0, 0); PG8_SCHED; PG8_LDA(At, 0, 0); PG8_STAGE(PG8_SA(1, 1), a1 + hstep, voffA);
            PG8_WAIT_L(8); PG8_BAR; PG8_WAIT_L(0); PG8_MMA(0, 0, At, B0); PG8_BAR; PG8_SCHED;
            PG8_LDB(B1, 0, 1); PG8_STAGE(PG8_SB(0, 0), b2, voffB);
            PG8_BAR; PG8_WAIT_L(0); PG8_MMA(0, 1, At, B1); PG8_BAR;
            PG8_LDA(At, 0, 1); PG8_STAGE(PG8_SA(0, 0), a2, voffA);
            PG8_BAR; PG8_WAIT_L(0); PG8_MMA(1, 0, At, B0); PG8_BAR; PG8_SCHED;
            PG8_STAGE(PG8_SB(0, 1), b2 + hstep, voffB);
            PG8_WAIT_V(6); PG8_BAR; PG8_MMA(1, 1, At, B1); PG8_BAR;
            PG8_LDB(B0, 1, 0); PG8_SCHED; PG8_LDA(At, 1, 0); PG8_STAGE(PG8_SA(0, 1), a2 + hstep, voffA);
            PG8_WAIT_L(8); PG8_BAR; PG8_WAIT_L(0); PG8_MMA(0, 0, At, B0); PG8_BAR; PG8_SCHED;
            PG8_LDB(B1, 1, 1); PG8_STAGE(PG8_SB(1, 0), b3, voffB);
            PG8_BAR; PG8_WAIT_L(0); PG8_MMA(0, 1, At, B1); PG8_BAR;
            PG8_LDA(At, 1, 1); PG8_STAGE(PG8_SA(1, 0), a3, voffA);
            PG8_BAR; PG8_WAIT_L(0); PG8_MMA(1, 0, At, B0); PG8_BAR; PG8_SCHED;
            PG8_STAGE(PG8_SB(1, 1), b3 + hstep, voffB);
            PG8_WAIT_V(6); PG8_BAR; PG8_MMA(1, 1, At, B1); PG8_BAR;
            }
        }
        if constexpr (ALIGN_EPI) { if (wr == 0) PG8_BAR; }
        if constexpr (!Epi::AFTER_DRAIN) { E(acc, cur, wr, wc, fr, fq); S.done(cur); }
        if (!has_next) break;
#pragma unroll
        for (int a = 0; a < 2; ++a)
#pragma unroll
            for (int b = 0; b < 2; ++b)
#pragma unroll
                for (int m = 0; m < 4; ++m)
#pragma unroll
                    for (int n = 0; n < 2; ++n) acc[a][b][m][n] = (f32x4){0.f, 0.f, 0.f, 0.f};
        cur = nxt; cA = nA; cB = nB; ++ui;
        if constexpr (ALIGN_EPI) { if (wr == 1) PG8_BAR; }
    }
    PG8_WAIT_V(0);
    if constexpr (!ALIGN_EPI) { if (wr == 0) PG8_BAR; }
    PG8_BAR;
    if constexpr (Epi::AFTER_DRAIN) { E.fused(acc, cur, wr, wc, fr, fq, lds, wid, lane); S.done(cur); }
#undef PG8_SA
#undef PG8_SB
#undef PG8_STAGE
#undef PG8_LDA
#undef PG8_LDB
#undef PG8_MMA
#undef PG8_WAIT_V
#undef PG8_WAIT_L
#undef PG8_BAR
#undef PG8_SCHED
}
}

constexpr int NB = 4, SEQ = 2048, DM = 2048, MTOK = NB * SEQ;
constexpr int INW = 15424, DFF = 5632;
constexpr int ZW = 15616;
constexpr int ZGQ = 0, ZGK = 1024, ZGV = 2048, ZGR = 4096, ZNQ = 6144, ZNKV = 8192, ZMG = 11264, ZGLR = 15360, ZNG = 15376;
constexpr float RMS_EPS = 1e-6f;
constexpr size_t MiB = 1u << 20;
constexpr size_t WS_CTL = 0, CTL_ZERO_BYTES = 1 * MiB;
constexpr size_t WS_BIAS1 = 4096;
constexpr size_t WS_WINT = 1 * MiB, WS_WPG = 62 * MiB, WS_WPN = 70 * MiB, WS_WOUT = 78 * MiB, WS_W1T = 86 * MiB, WS_W2T = 90 * MiB;
constexpr size_t WS_KC = 91 * MiB, WS_VCT = 91 * MiB + 512 * 1024, WS_DECAY = 92 * MiB, WS_VTS = 93 * MiB, WS_VTW = 101 * MiB, WS_ATT = 109 * MiB;
constexpr size_t WS_QD = 113 * MiB, WS_KET = 129 * MiB, WS_MERGED = 113 * MiB  ;
constexpr size_t WS_BUFA = 145 * MiB  , WS_ON = 145 * MiB, WS_BUFB = 177 * MiB  , WS_Z = 209 * MiB;
constexpr size_t WS_WGU = 209 * MiB, WS_WD = 253 * MiB, WS_ACT = 275 * MiB  ;
constexpr size_t WS_END = 453 * MiB;
constexpr int LDS_BYTES = 147456;

#define LAS __attribute__((address_space(3)))
#define DI __device__ __forceinline__
typedef unsigned short bf16;
typedef unsigned v4u __attribute__((ext_vector_type(4)));
typedef unsigned v2u __attribute__((ext_vector_type(2)));
typedef float f32x4 __attribute__((ext_vector_type(4)));
typedef float f32x16 __attribute__((ext_vector_type(16)));
typedef short bf16x8 __attribute__((ext_vector_type(8)));
typedef float f32x2_t __attribute__((ext_vector_type(2)));
typedef __bf16 bf16x2_t __attribute__((ext_vector_type(2)));
#define MFMA32(a, b, c) __builtin_amdgcn_mfma_f32_32x32x16_bf16((a), (b), (c), 0, 0, 0)
#define MFMA16(a, b, c) __builtin_amdgcn_mfma_f32_16x16x32_bf16((a), (b), (c), 0, 0, 0)
#define LDS_WAIT() asm volatile("s_waitcnt lgkmcnt(0)" ::: "memory")
#define BAR_LDS() do { asm volatile("s_waitcnt lgkmcnt(0)" ::: "memory"); __builtin_amdgcn_s_barrier(); asm volatile("" ::: "memory"); } while (0)

DI unsigned f2bf(float f) { unsigned u = __builtin_bit_cast(unsigned, f); return (u + 0x7fffu + ((u >> 16) & 1u)) >> 16; }
DI unsigned pk2(float lo, float hi) { f32x2_t v = {lo, hi}; bf16x2_t b = __builtin_convertvector(v, bf16x2_t); return __builtin_bit_cast(unsigned, b); }
DI float bf2f(bf16 b) { return __uint_as_float(((unsigned)b) << 16); }
DI float blo(unsigned w) { return __uint_as_float(w << 16); }
DI float bhi(unsigned w) { return __uint_as_float(w & 0xffff0000u); }
DI float sigm(float x) { return 1.0f / (1.0f + __expf(-x)); }
DI float wave_sum(float v) {
#pragma unroll
    for (int o = 1; o < 64; o <<= 1) v += __shfl_xor(v, o);
    return v;
}
DI bf16x8 pack8(float a0, float a1, float a2, float a3, float a4, float a5, float a6, float a7) {
    v4u p; p.x = pk2(a0, a1); p.y = pk2(a2, a3); p.z = pk2(a4, a5); p.w = pk2(a6, a7); return __builtin_bit_cast(bf16x8, p);
}

struct Args {
    const float* in[20]; float* out; unsigned char* ws; int ph_lo, ph_hi;
};
struct Frame {
    LAS unsigned char* lds; int tid, lane, wave, G, bid;
    const float* x; const float* g_mix; const float* w_in; const float* w_gla_gate; const float* b_gla_gate; const float* g_gla_out;
    const float* pe_k; const float* w_ck1; const float* w_ck2; const float* pe_v; const float* w_cv1; const float* w_cv2;
    const float* w_pg; const float* w_pn; const float* w_out; const float* g_ffn; const float* w_fg; const float* w_fu; const float* w_fd; const float* g_final;
    float* out; unsigned char* ws;
};

struct MapId { DI int operator()(int n) const { return n; } };
struct MapOff { int off; DI int operator()(int n) const { return n + off; } };
struct MapWin { DI int operator()(int n) const {
    if (n < 6144) return n; if (n < 6160) return ZGLR + (n - 6144); if (n < 8208) return ZNQ + (n - 6160);
    if (n < 11280) return ZNKV + (n - 8208); if (n < 11328) return ZNG + (n - 11280); return ZMG + (n - 11328); } };
struct MapGU { int up; DI int operator()(int n) const { return (n >> 7) * 256 + up * 128 + (n & 127); } };

template <class Map>
DI void transpose_item(const float* __restrict__ W, int N, bf16* __restrict__ WT, int Kp, LAS float* scr, int item, int lane, const Map map) {
    const int nblk = N / 32, kb = item / nblk, nb = item - kb * nblk, k0 = 64 * kb, n0 = 32 * nb;
    float tv[32];
#pragma unroll
    for (int i = 0; i < 32; ++i) { const int kk = 2 * i + (lane >> 5); tv[i] = W[(size_t)(k0 + kk) * N + n0 + (lane & 31)]; }
#pragma unroll
    for (int i = 0; i < 32; ++i) { const int kk = 2 * i + (lane >> 5); scr[kk * 33 + (lane & 31)] = tv[i]; }
    LDS_WAIT();
    const int c = lane & 7;
#pragma unroll
    for (int j = 0; j < 4; ++j) { const int n = (lane >> 3) + 8 * j; const LAS float* s = scr + (8 * c) * 33 + n;
        v4u o; o.x = pk2(s[0 * 33], s[1 * 33]); o.y = pk2(s[2 * 33], s[3 * 33]); o.z = pk2(s[4 * 33], s[5 * 33]); o.w = pk2(s[6 * 33], s[7 * 33]);
        *(v4u*)(WT + (size_t)map(n0 + n) * Kp + k0 + 8 * c) = o; }
    LDS_WAIT();
}
template <bool TO_BF16>
DI void rms_row(const float* __restrict__ xrow, const float* __restrict__ g, void* orow, int lane) {
    const f32x4* xr = (const f32x4*)xrow + lane; const f32x4* gr = (const f32x4*)g + lane;
    f32x4 v[8]; float s = 0.f;
#pragma unroll
    for (int j = 0; j < 8; ++j) { v[j] = xr[64 * j]; s += (v[j].x * v[j].x + v[j].y * v[j].y) + (v[j].z * v[j].z + v[j].w * v[j].w); }
    const float rs = rsqrtf(wave_sum(s) * (1.f / DM) + RMS_EPS);
#pragma unroll
    for (int j = 0; j < 8; ++j) { const f32x4 gg = gr[64 * j]; const f32x4 o = v[j] * rs * gg;
        if (TO_BF16) { v2u w; w.x = pk2(o.x, o.y); w.y = pk2(o.z, o.w); ((v2u*)orow)[lane + 64 * j] = w; }
        else ((f32x4*)orow)[lane + 64 * j] = o; }
}

DI void p0_prologue(Frame& F, bool with_bias) {
    LAS float* scr = (LAS float*)(F.lds + F.wave * 8448);
    const int gw = F.bid * 8 + F.wave, NGW = F.G * 8;
    bf16* WINT = (bf16*)(F.ws + WS_WINT); bf16* WPG = (bf16*)(F.ws + WS_WPG); bf16* WPN = (bf16*)(F.ws + WS_WPN); bf16* WOUT = (bf16*)(F.ws + WS_WOUT);
    bf16* W1T = (bf16*)(F.ws + WS_W1T); bf16* W2T = (bf16*)(F.ws + WS_W2T);
    constexpr int I_IN = (DM / 64) * (INW / 32), I_P = (DM / 64) * (DM / 32), I_C1 = (4096 / 64) * (256 / 32), I_C2 = (256 / 64) * (128 / 32);
    constexpr int NITEMS = I_IN + 3 * I_P + 2 * I_C1 + 2 * I_C2;
    for (int it = gw; it < NITEMS; it += NGW) {
        int r = it;
        if (r < I_IN) { transpose_item(F.w_in, INW, WINT, DM, scr, r, F.lane, MapWin{}); continue; } r -= I_IN;
        if (r < I_P) { transpose_item(F.w_pg, DM, WPG, DM, scr, r, F.lane, MapId{}); continue; } r -= I_P;
        if (r < I_P) { transpose_item(F.w_pn, DM, WPN, DM, scr, r, F.lane, MapId{}); continue; } r -= I_P;
        if (r < I_P) { transpose_item(F.w_out, DM, WOUT, DM, scr, r, F.lane, MapId{}); continue; } r -= I_P;
        if (r < I_C1) { transpose_item(F.w_ck1, 256, W1T, 4096, scr, r, F.lane, MapId{}); continue; } r -= I_C1;
        if (r < I_C1) { transpose_item(F.w_cv1, 256, W1T, 4096, scr, r, F.lane, MapOff{256}); continue; } r -= I_C1;
        if (r < I_C2) { transpose_item(F.w_ck2, 128, W2T, 256, scr, r, F.lane, MapId{}); continue; } r -= I_C2;
        transpose_item(F.w_cv2, 128, W2T, 256, scr, r, F.lane, MapOff{128});
    }
    bf16* H = (bf16*)(F.ws + WS_BUFA);
    for (int m = gw; m < MTOK; m += NGW) rms_row<true>(F.x + (size_t)m * DM, F.g_mix, H + (size_t)m * DM, F.lane);
    float* bias1 = (float*)(F.ws + WS_BIAS1);
    if (with_bias) for (int it = gw; it < 128; it += NGW) {
        const int which = it >> 6, kc = it & 63; const float* pe = which ? F.pe_v : F.pe_k; const float* w1 = which ? F.w_cv1 : F.w_ck1;
        float a[4] = {0.f, 0.f, 0.f, 0.f};
        for (int kk = kc * 64; kk < kc * 64 + 64; ++kk) { const float p = pe[kk];
#pragma unroll
            for (int q = 0; q < 4; ++q) a[q] += p * w1[(size_t)kk * 256 + F.lane + 64 * q]; }
#pragma unroll
        for (int q = 0; q < 4; ++q) atomicAdd(bias1 + which * 256 + F.lane + 64 * q, a[q]);
    }
}
DI void p7_norm_ffnw(Frame& F) {
    LAS float* scr = (LAS float*)(F.lds + F.wave * 8448);
    const int gw = F.bid * 8 + F.wave, NGW = F.G * 8;
    bf16* WGU = (bf16*)(F.ws + WS_WGU); bf16* WD = (bf16*)(F.ws + WS_WD);
    constexpr int I_G = (DM / 64) * (DFF / 32), I_D = (DFF / 64) * (DM / 32);
    for (int it = gw; it < 2 * I_G + I_D; it += NGW) {
        int r = it;
        if (r < I_G) { transpose_item(F.w_fg, DFF, WGU, DM, scr, r, F.lane, MapGU{0}); continue; } r -= I_G;
        if (r < I_G) { transpose_item(F.w_fu, DFF, WGU, DM, scr, r, F.lane, MapGU{1}); continue; } r -= I_G;
        transpose_item(F.w_fd, DM, WD, DFF, scr, r, F.lane, MapId{});
    }
    bf16* H2 = (bf16*)(F.ws + WS_BUFB);
    for (int m = gw; m < MTOK; m += NGW) rms_row<true>(F.out + (size_t)m * DM, F.g_ffn, H2 + (size_t)m * DM, F.lane);
}
DI void p10_final(Frame& F) {
    const int gw = F.bid * 8 + F.wave, NGW = F.G * 8;
    for (int m = gw; m < MTOK; m += NGW) rms_row<false>(F.out + (size_t)m * DM, F.g_final, F.out + (size_t)m * DM, F.lane);
}

DI void g1_item(Frame& F, int item) {
    const bf16* Z = (const bf16*)(F.ws + WS_Z);
    bf16* QD = (bf16*)(F.ws + WS_QD); bf16* KET = (bf16*)(F.ws + WS_KET); bf16* ATT = (bf16*)(F.ws + WS_ATT); float* DECAY = (float*)(F.ws + WS_DECAY);
    const int bh = item >> 5, c = item & 31, b = bh >> 2, h = bh & 3;
    const size_t t0 = (size_t)b * SEQ + c * 64;
    LAS float* glr_s = (LAS float*)(F.lds);
    LAS float* tot_s = (LAS float*)(F.lds + 4096);
    LAS bf16* qd_s = (LAS bf16*)(F.lds + 8192);
    LAS bf16* kd_s = (LAS bf16*)(F.lds + 8192 + 33792);
    const int tid = F.tid, dk = tid & 255, half = tid >> 8;
    for (int e = tid; e < 1024; e += 512) { const int tok = e >> 4, r = e & 15; glr_s[e] = bf2f(Z[(t0 + tok) * ZW + ZGLR + r]); }
    float wg[16];
#pragma unroll
    for (int r = 0; r < 16; ++r) wg[r] = F.w_gla_gate[r * 1024 + h * 256 + dk];
    const float bg = F.b_gla_gate[h * 256 + dk];
    __syncthreads();
    float bc[32]; float run = 0.f;
#pragma unroll
    for (int i = 0; i < 32; ++i) { const int tok = half * 32 + i; float xg = bg;
        const LAS f32x4* gp = (const LAS f32x4*)(glr_s + tok * 16);
#pragma unroll
        for (int r4 = 0; r4 < 4; ++r4) { const f32x4 gv = gp[r4]; xg += gv.x * wg[4 * r4] + gv.y * wg[4 * r4 + 1] + gv.z * wg[4 * r4 + 2] + gv.w * wg[4 * r4 + 3]; }
        const float ls = fminf(xg, 0.f) - __logf(1.0f + __expf(-fabsf(xg)));
        run += ls * 0.0625f; bc[i] = run; }
    tot_s[half * 256 + dk] = run;
    __syncthreads();
    const float tot0 = tot_s[dk], tot1 = tot_s[256 + dk]; const float blast = tot0 + tot1, boff = half ? tot0 : 0.f;
    unsigned kep[16];
#pragma unroll
    for (int i = 0; i < 32; i += 2) { float ke2[2];
#pragma unroll
        for (int e = 0; e < 2; ++e) { const int tok = half * 32 + i + e; const float bb = bc[i + e] + boff;
            const float q = bf2f(Z[(t0 + tok) * ZW + ZGQ + h * 256 + dk]), k = bf2f(Z[(t0 + tok) * ZW + ZGK + h * 256 + dk]);
            const float qd = q * 0.0625f * __expf(bb), kd = k * __expf(-bb); ke2[e] = k * __expf(blast - bb);
            const bf16 qb = (bf16)f2bf(qd); qd_s[tok * 264 + dk] = qb; kd_s[tok * 264 + dk] = (bf16)f2bf(kd); QD[(t0 + tok) * 1024 + h * 256 + dk] = qb; }
        kep[i >> 1] = pk2(ke2[0], ke2[1]); }
    { v4u* kp = (v4u*)(KET + ((size_t)item * 256 + dk) * 64 + half * 32);
#pragma unroll
      for (int q = 0; q < 4; ++q) { v4u w; w.x = kep[4 * q]; w.y = kep[4 * q + 1]; w.z = kep[4 * q + 2]; w.w = kep[4 * q + 3]; kp[q] = w; } }
    if (half == 0) DECAY[(size_t)item * 256 + dk] = __expf(blast);
    __syncthreads();
    const int w = F.wave, fr = F.lane & 15, fq = F.lane >> 4, mt = w >> 1;
#pragma unroll
    for (int nn = 0; nn < 2; ++nn) { const int nt = (w & 1) * 2 + nn; f32x4 acc = {0.f, 0.f, 0.f, 0.f};
        if (nt <= mt) {
#pragma unroll
            for (int s = 0; s < 8; ++s) { const bf16x8 a = *(const LAS bf16x8*)(qd_s + (16 * mt + fr) * 264 + 32 * s + 8 * fq); const bf16x8 bb = *(const LAS bf16x8*)(kd_s + (16 * nt + fr) * 264 + 32 * s + 8 * fq);
                acc = MFMA16(a, bb, acc); } }
#pragma unroll
        for (int j = 0; j < 4; ++j) { const int row = 16 * mt + 4 * fq + j, col = 16 * nt + fr; const float v = (col <= row) ? acc[j] : 0.f;
            ATT[(size_t)item * 4096 + row * 64 + col] = (bf16)f2bf(v); } }
    __syncthreads();
}

DI void n1_item(Frame& F, int item) {
    const bf16* Z = (const bf16*)(F.ws + WS_Z);
    const bf16* W1T = (const bf16*)(F.ws + WS_W1T); const bf16* W2T = (const bf16*)(F.ws + WS_W2T); const float* bias1 = (const float*)(F.ws + WS_BIAS1);
    bf16* KC = (bf16*)(F.ws + WS_KC); bf16* VCT = (bf16*)(F.ws + WS_VCT);
    const int which = item >> 6, b = (item >> 4) & 3, hk = (item >> 2) & 3, j = item & 3;
    const int w = F.wave, r = F.lane & 31, hh = F.lane >> 5;
    LAS bf16* hid = (LAS bf16*)(F.lds);
    int crow_ = 32 * j + r; if (crow_ > 126) crow_ = 126;
    const bf16* ap = Z + ((size_t)b * SEQ + 16 * crow_) * ZW + ZNKV + which * 512 + hk * 128 + 8 * hh;
    const bf16* bp = W1T + ((size_t)which * 256 + 32 * w + r) * 4096 + 8 * hh;
    f32x16 acc; for (int i = 0; i < 16; ++i) acc[i] = 0.f;
    bf16x8 fa[2][8], fb[2][8];
#pragma unroll
    for (int s = 0; s < 8; ++s) { fa[0][s] = *(const bf16x8*)(ap + 16 * s); fb[0][s] = *(const bf16x8*)(bp + 16 * s); }
#pragma unroll 1
    for (int tk = 0; tk < 32; tk += 2) {
#pragma unroll
        for (int s = 0; s < 8; ++s) { fa[1][s] = *(const bf16x8*)(ap + (size_t)(tk + 1) * ZW + 16 * s); fb[1][s] = *(const bf16x8*)(bp + (tk + 1) * 128 + 16 * s); }
#pragma unroll
        for (int s = 0; s < 8; ++s) acc = MFMA32(fa[0][s], fb[0][s], acc);
        const int t2 = (tk + 2 < 32) ? tk + 2 : 0;
#pragma unroll
        for (int s = 0; s < 8; ++s) { fa[0][s] = *(const bf16x8*)(ap + (size_t)t2 * ZW + 16 * s); fb[0][s] = *(const bf16x8*)(bp + t2 * 128 + 16 * s); }
#pragma unroll
        for (int s = 0; s < 8; ++s) acc = MFMA32(fa[1][s], fb[1][s], acc);
    }
    { const float bs = bias1[which * 256 + 32 * w + r];
#pragma unroll
      for (int i = 0; i < 16; ++i) { const int row = (i & 3) + 8 * (i >> 2) + 4 * hh; const float v = acc[i] + bs; hid[row * 264 + 32 * w + r] = (bf16)f2bf(v * sigm(v)); } }
    __syncthreads();
    if (w < 4) {
        f32x16 o; for (int i = 0; i < 16; ++i) o[i] = 0.f;
        const bf16* b2 = W2T + ((size_t)which * 128 + 32 * w + r) * 256 + 8 * hh;
#pragma unroll
        for (int s = 0; s < 16; ++s) { const bf16x8 a = *(const LAS bf16x8*)(hid + r * 264 + 16 * s + 8 * hh); const bf16x8 bb = *(const bf16x8*)(b2 + 16 * s); o = MFMA32(a, bb, o); }
        const int d = 32 * w + r;
        if (which == 0) {
#pragma unroll
            for (int i = 0; i < 16; ++i) { const int cc = 32 * j + (i & 3) + 8 * (i >> 2) + 4 * hh; KC[(((size_t)b * 4 + hk) * 128 + cc) * 128 + d] = (bf16)f2bf(o[i]); }
        } else {
#pragma unroll
            for (int a4 = 0; a4 < 4; ++a4) { v2u wv; wv.x = pk2(o[4 * a4], o[4 * a4 + 1]); wv.y = pk2(o[4 * a4 + 2], o[4 * a4 + 3]);
                *(v2u*)(VCT + (((size_t)b * 4 + hk) * 128 + d) * 128 + 32 * j + 8 * a4 + 4 * hh) = wv; }
        }
    }
    __syncthreads();
}
DI void vt_item(Frame& F, int item) {
    const bf16* Z = (const bf16*)(F.ws + WS_Z);
    const int dhalf = item & 1, tile = (item >> 1) & 31, hk = (item >> 6) & 3, b = (item >> 8) & 3, which = item >> 10;
    bf16* VT = (bf16*)(F.ws + (which ? WS_VTW : WS_VTS));
    LAS bf16* scr = (LAS bf16*)(F.lds + F.wave * 8448);
    const int lane = F.lane;
    const bf16* src = Z + ((size_t)b * SEQ + tile * 64) * ZW + ZNKV + (3 + 2 * which) * 512 + hk * 128 + dhalf * 64;
#pragma unroll
    for (int p = 0; p < 8; ++p) { const int tok = 8 * p + (lane >> 3), d8 = (lane & 7) * 8; const v4u v = *(const v4u*)(src + (size_t)tok * ZW + d8);
        LAS unsigned* dst = (LAS unsigned*)(scr + tok * 66 + d8); dst[0] = v.x; dst[1] = v.y; dst[2] = v.z; dst[3] = v.w; }
    LDS_WAIT();
#pragma unroll
    for (int p = 0; p < 8; ++p) { const int d = 8 * p + (lane >> 3), t8 = (lane & 7) * 8; unsigned short e[8];
#pragma unroll
        for (int q = 0; q < 8; ++q) e[q] = scr[(t8 + q) * 66 + d];
        v4u o; o.x = e[0] | ((unsigned)e[1] << 16); o.y = e[2] | ((unsigned)e[3] << 16); o.z = e[4] | ((unsigned)e[5] << 16); o.w = e[6] | ((unsigned)e[7] << 16);
        *(v4u*)(VT + (((size_t)b * 4 + hk) * 128 + dhalf * 64 + d) * SEQ + tile * 64 + t8) = o; }
    LDS_WAIT();
}
DI void p2_prep(Frame& F) {
    const int gw = F.bid * 8 + F.wave;
    if (F.G == 256) {
        if (F.bid < 128) { n1_item(F, F.bid); __syncthreads(); for (int it = gw; it < 2048; it += 1024) vt_item(F, it); }
        else { for (int k = 0; k < 4; ++k) g1_item(F, (F.bid - 128) * 4 + k); }
    } else {
        for (int it = F.bid; it < 128 + 512; it += F.G) { if (it < 128) n1_item(F, it); else g1_item(F, it - 128); }
        __syncthreads();
        for (int it = gw; it < 2048; it += F.G * 8) vt_item(F, it);
    }
}

template <int NT>
DI void g2_item(Frame& F, int item) {
    constexpr int DV = 32 * NT, NJ = 16 / NT, ST_BYTES = DV * 264 * 2;
    const bf16* Z = (const bf16*)(F.ws + WS_Z);
    const bf16* QD = (const bf16*)(F.ws + WS_QD); const bf16* KET = (const bf16*)(F.ws + WS_KET); const bf16* ATT = (const bf16*)(F.ws + WS_ATT); const float* DECAY = (const float*)(F.ws + WS_DECAY);
    float* O = F.out;
    const int bh = item / NJ, js = item % NJ, b = bh >> 2, h = bh & 3;
    LAS bf16* ST = (LAS bf16*)(F.lds);
    LAS bf16* VT = (LAS bf16*)(F.lds + ST_BYTES);
    const int tid = F.tid, w = F.wave, fr = F.lane & 15, fq = F.lane >> 4, mt = w >> 1, nt0 = (w & 1) * NT;
    for (int e = tid; e < ST_BYTES / 4; e += 512) ((LAS unsigned*)ST)[e] = 0u;
    f32x4 Sacc[2][2 * NT];
#pragma unroll
    for (int a = 0; a < 2; ++a)
#pragma unroll
        for (int c2 = 0; c2 < 2 * NT; ++c2) Sacc[a][c2] = (f32x4){0.f, 0.f, 0.f, 0.f};
    const int vtok = tid >> 3, vd4 = (tid & 7) * 4 * NT;
    const size_t vcol = ZGV + h * 512 + DV * js;
    v2u vv_n[NT]; bf16x8 aatt_n[2], aqd_n[8], aket_n[2][2]; f32x4 dec_n[2];
#define G2_LOAD(cc) do { const size_t itemc_ = (size_t)bh * 32 + (cc), t0_ = (size_t)b * SEQ + (cc) * 64; \
        _Pragma("unroll") for (int q = 0; q < NT; ++q) vv_n[q] = *(const v2u*)(Z + (t0_ + vtok) * ZW + vcol + vd4 + 4 * q); \
        _Pragma("unroll") for (int s = 0; s < 2; ++s) aatt_n[s] = *(const bf16x8*)(ATT + itemc_ * 4096 + (16 * mt + fr) * 64 + 32 * s + 8 * fq); \
        _Pragma("unroll") for (int s = 0; s < 8; ++s) aqd_n[s] = *(const bf16x8*)(QD + (t0_ + 16 * mt + fr) * 1024 + h * 256 + 32 * s + 8 * fq); \
        _Pragma("unroll") for (int mi = 0; mi < 2; ++mi) { \
            _Pragma("unroll") for (int s = 0; s < 2; ++s) aket_n[mi][s] = *(const bf16x8*)(KET + (itemc_ * 256 + 32 * w + 16 * mi + fr) * 64 + 32 * s + 8 * fq); \
            dec_n[mi] = *(const f32x4*)(DECAY + itemc_ * 256 + 32 * w + 16 * mi + 4 * fq); } } while (0)
    G2_LOAD(0);
    f32x4 o_prev[NT];
#pragma unroll
    for (int q = 0; q < NT; ++q) o_prev[q] = (f32x4){0.f, 0.f, 0.f, 0.f};
    for (int c = 0; c < 32; ++c) {
        const size_t t0 = (size_t)b * SEQ + c * 64;
        v2u vv[NT];
#pragma unroll
        for (int q = 0; q < NT; ++q) vv[q] = vv_n[q];
        bf16x8 aatt[2], aqd[8], aket[2][2]; f32x4 dec[2];
#pragma unroll
        for (int s = 0; s < 2; ++s) aatt[s] = aatt_n[s];
#pragma unroll
        for (int s = 0; s < 8; ++s) aqd[s] = aqd_n[s];
#pragma unroll
        for (int mi = 0; mi < 2; ++mi) { aket[mi][0] = aket_n[mi][0]; aket[mi][1] = aket_n[mi][1]; dec[mi] = dec_n[mi]; }
        if (c > 0) {
#pragma unroll
            for (int q = 0; q < NT; ++q)
#pragma unroll
                for (int jj = 0; jj < 4; ++jj) O[(t0 - 64 + 16 * mt + 4 * fq + jj) * 2048 + h * 512 + DV * js + 16 * (nt0 + q) + fr] = o_prev[q][jj]; }
        if (c + 1 < 32) G2_LOAD(c + 1);
#pragma unroll
        for (int q = 0; q < NT; ++q) {
            VT[(vd4 + 4 * q + 0) * 72 + vtok] = (bf16)(vv[q].x & 0xffffu); VT[(vd4 + 4 * q + 1) * 72 + vtok] = (bf16)(vv[q].x >> 16);
            VT[(vd4 + 4 * q + 2) * 72 + vtok] = (bf16)(vv[q].y & 0xffffu); VT[(vd4 + 4 * q + 3) * 72 + vtok] = (bf16)(vv[q].y >> 16); }
        BAR_LDS();
#pragma unroll
        for (int q = 0; q < NT; ++q) { const int nt = nt0 + q; f32x4 o = {0.f, 0.f, 0.f, 0.f};
#pragma unroll
            for (int s = 0; s < 2; ++s) { const bf16x8 bb = *(const LAS bf16x8*)(VT + (16 * nt + fr) * 72 + 32 * s + 8 * fq); o = MFMA16(aatt[s], bb, o); }
#pragma unroll
            for (int s = 0; s < 8; ++s) { const bf16x8 bb = *(const LAS bf16x8*)(ST + (16 * nt + fr) * 264 + 32 * s + 8 * fq); o = MFMA16(aqd[s], bb, o); }
            o_prev[q] = o; }
#pragma unroll
        for (int mi = 0; mi < 2; ++mi)
#pragma unroll
            for (int ni = 0; ni < 2 * NT; ++ni) { f32x4 a = Sacc[mi][ni] * dec[mi];
#pragma unroll
                for (int s = 0; s < 2; ++s) { const bf16x8 bb = *(const LAS bf16x8*)(VT + (16 * ni + fr) * 72 + 32 * s + 8 * fq); a = MFMA16(aket[mi][s], bb, a); }
                Sacc[mi][ni] = a; }
        BAR_LDS();
#pragma unroll
        for (int mi = 0; mi < 2; ++mi)
#pragma unroll
            for (int ni = 0; ni < 2 * NT; ++ni) { v2u wv; wv.x = pk2(Sacc[mi][ni][0], Sacc[mi][ni][1]); wv.y = pk2(Sacc[mi][ni][2], Sacc[mi][ni][3]);
                *(LAS v2u*)(ST + (16 * ni + fr) * 264 + 32 * w + 16 * mi + 4 * fq) = wv; }
    }
    { const size_t t0 = (size_t)b * SEQ + 31 * 64;
#pragma unroll
      for (int q = 0; q < NT; ++q)
#pragma unroll
          for (int jj = 0; jj < 4; ++jj) O[(t0 + 16 * mt + 4 * fq + jj) * 2048 + h * 512 + DV * js + 16 * (nt0 + q) + fr] = o_prev[q][jj]; }
    BAR_LDS();
}
#undef G2_LOAD

DI void gla_out_row(Frame& F, int rowh) {
    const bf16* Z = (const bf16*)(F.ws + WS_Z); bf16* OG = (bf16*)(F.ws + WS_BUFB);
    const int t = rowh >> 2, h = rowh & 3, lane = F.lane;
    const f32x4* op = (const f32x4*)(F.out + (size_t)t * 2048 + h * 512) + lane;
    const f32x4 a = op[0], bq = op[64];
    float s = (a.x * a.x + a.y * a.y) + (a.z * a.z + a.w * a.w) + (bq.x * bq.x + bq.y * bq.y) + (bq.z * bq.z + bq.w * bq.w);
    const float rs = rsqrtf(wave_sum(s) * (1.f / 512.f) + RMS_EPS);
#pragma unroll
    for (int q = 0; q < 2; ++q) { const f32x4 v = q ? bq : a; const f32x4 g = ((const f32x4*)F.g_gla_out)[lane + 64 * q];
        const v2u rw = *(const v2u*)(Z + (size_t)t * ZW + ZGR + h * 512 + 4 * lane + 256 * q);
        const float r0 = blo(rw.x), r1 = bhi(rw.x), r2 = blo(rw.y), r3 = bhi(rw.y);
        v2u w; w.x = pk2(v.x * rs * g.x * (r0 * sigm(r0)), v.y * rs * g.y * (r1 * sigm(r1))); w.y = pk2(v.z * rs * g.z * (r2 * sigm(r2)), v.w * rs * g.w * (r3 * sigm(r3)));
        *(v2u*)(OG + (size_t)t * 2048 + h * 512 + 4 * lane + 256 * q) = w; }
}
DI int pi_key(int r) { return (r & ~12) | ((r & 4) << 1) | ((r & 8) >> 1); }

constexpr int KB_PITCH = 272, VB_PITCH = 144, KB_BYTES = 64 * KB_PITCH, KV_BUF = KB_BYTES + 128 * VB_PITCH;
constexpr int NSA_X = 2 * KV_BUF;
constexpr int NSA_IMPR = KV_BUF  , NSA_MSK = NSA_X + 69632, NSA_END = NSA_MSK + 256;
static_assert(NSA_END <= LDS_BYTES, "NSA LDS map");
struct TileRegs { v4u k[2], v[2]; };
DI void tile_gload(TileRegs& R, const bf16* kg, size_t kpitch, const bf16* vg, size_t vpitch, int tid) {
#pragma unroll
    for (int j = 0; j < 2; ++j) { const int c = tid + 512 * j;
        R.k[j] = *(const v4u*)(kg + (size_t)(c >> 4) * kpitch + (c & 15) * 8); R.v[j] = *(const v4u*)(vg + (size_t)(c >> 3) * vpitch + (c & 7) * 8); }
}
DI void tile_sstore(const TileRegs& R, LAS unsigned char* buf, int tid) {
#pragma unroll
    for (int j = 0; j < 2; ++j) { const int c = tid + 512 * j;
        *(LAS v4u*)(buf + (c >> 4) * KB_PITCH + (c & 15) * 16) = R.k[j]; *(LAS v4u*)(buf + KB_BYTES + (c >> 3) * VB_PITCH + (c & 7) * 16) = R.v[j]; }
}
DI void qk_lds(f32x16& x0, f32x16& x1, const LAS unsigned char* kb, const bf16x8 (&qf)[8]) {
#pragma unroll
    for (int i = 0; i < 16; ++i) { x0[i] = 0.f; x1[i] = 0.f; }
#pragma unroll
    for (int s = 0; s < 8; ++s) { const bf16x8 a0 = *(const LAS bf16x8*)(kb + 32 * s); const bf16x8 a1 = *(const LAS bf16x8*)(kb + 32 * KB_PITCH + 32 * s);
        x0 = MFMA32(a0, qf[s], x0); x1 = MFMA32(a1, qf[s], x1); }
}
DI void pv_lds(f32x16 (&o)[4], const f32x16& p0, const f32x16& p1, const LAS unsigned char* vb) {
#pragma unroll
    for (int mt = 0; mt < 2; ++mt)
#pragma unroll
        for (int s2 = 0; s2 < 2; ++s2) { const f32x16& p = mt ? p1 : p0;
            const bf16x8 pf = pack8(p[8 * s2], p[8 * s2 + 1], p[8 * s2 + 2], p[8 * s2 + 3], p[8 * s2 + 4], p[8 * s2 + 5], p[8 * s2 + 6], p[8 * s2 + 7]);
#pragma unroll
            for (int dt = 0; dt < 4; ++dt) { const bf16x8 a = *(const LAS bf16x8*)(vb + (32 * dt) * VB_PITCH + (32 * mt + 16 * s2) * 2); o[dt] = MFMA32(a, pf, o[dt]); } }
}
DI void softmax_step(f32x16& x0, f32x16& x1, float& m, float& l, f32x16 (&o)[4], bool rowok, float CS) {
    float mx = fmaxf(x0[0], x1[0]);
#pragma unroll
    for (int i = 1; i < 16; ++i) mx = fmaxf(mx, fmaxf(x0[i], x1[i]));
    mx = rowok ? mx : -INFINITY;
    mx = fmaxf(mx, __shfl_xor(mx, 32));
    const float mnew = fmaxf(m, mx);
    const bool need = (mnew - m) > 62.0f;
    if (__any(need)) {
        const float m2 = need ? mnew : m; const float alpha = __builtin_amdgcn_exp2f((m - m2) * CS); m = m2; l *= alpha;
#pragma unroll
        for (int dt = 0; dt < 4; ++dt) o[dt] = o[dt] * alpha;
    }
    const float negmc = rowok ? -m * CS : -INFINITY;
    float ps0 = 0.f, ps1 = 0.f;
#pragma unroll
    for (int i = 0; i < 16; ++i) { x0[i] = __builtin_amdgcn_exp2f(__builtin_fmaf(x0[i], CS, negmc)); x1[i] = __builtin_amdgcn_exp2f(__builtin_fmaf(x1[i], CS, negmc)); ps0 += x0[i]; ps1 += x1[i]; }
    l += ps0 + ps1;
}

DI void nsa_item(Frame& F, int item) {
    const bf16* Z = (const bf16*)(F.ws + WS_Z);
    const bf16* KC = (const bf16*)(F.ws + WS_KC); const bf16* VCT = (const bf16*)(F.ws + WS_VCT); const bf16* VTS = (const bf16*)(F.ws + WS_VTS); const bf16* VTW = (const bf16*)(F.ws + WS_VTW);
    bf16* ON = (bf16*)(F.ws + WS_ON);
    const int qt = item & 31, hk = (item >> 5) & 3, b = item >> 7;
    int tid = F.tid; asm volatile("" : "+v"(tid));
    const int w = F.wave, lane = tid & 63, r = lane & 31, hh = lane >> 5, g = w >> 1, th = w & 1;
    const int head = hk * 4 + g, tl = 32 * th + r  , t = 64 * qt + tl;
    const size_t trow = (size_t)b * SEQ + t;
    LAS unsigned char* buf0 = F.lds; LAS unsigned char* buf1 = F.lds + KV_BUF;
    LAS float* part = (LAS float*)(F.lds + NSA_X);
    LAS unsigned* oacc = (LAS unsigned*)(F.lds + NSA_X);
    LAS float* impr = (LAS float*)(F.lds + NSA_IMPR);
    LAS unsigned* msk = (LAS unsigned*)(F.lds + NSA_MSK);
    constexpr float CS = 0.08838834764831845f * 1.4426950408889634f;
    int kboff = pi_key(r) * KB_PITCH + 16 * hh, vboff = KB_BYTES + r * VB_PITCH + 16 * hh;
    LAS unsigned* oacc_l = oacc + w * 2048 + lane;
    asm volatile("" : "+v"(kboff), "+v"(vboff), "+v"(oacc_l));
    const int nsel = qt + 1, wlo = qt > 8 ? qt - 8 : 0, ntile = nsel + (qt - wlo + 1);
    const bf16* ksel = Z + (size_t)b * SEQ * ZW + ZNKV + 2 * 512 + hk * 128; const bf16* kwin = ksel + 2 * 512;
    const bf16* vsel = VTS + ((size_t)b * 4 + hk) * 128 * SEQ; const bf16* vwin = VTW + ((size_t)b * 4 + hk) * 128 * SEQ;
    TileRegs R;
    {
        const bf16* kc = KC + ((size_t)b * 4 + hk) * 128 * 128; const bf16* vc = VCT + ((size_t)b * 4 + hk) * 128 * 128;
        TileRegs R1; tile_gload(R, kc, 128, vc, 128, tid); tile_gload(R1, kc + 64 * 128, 128, vc + 64, 128, tid);
        for (int e = tid; e < 17408; e += 512) part[e] = 0.f;
        if (tid < 64) msk[tid] = 0u;
        tile_sstore(R, buf0, tid); tile_sstore(R1, buf1, tid);
    }
    bf16x8 qf[8];
    { const bf16* qp = Z + trow * ZW + ZNQ + head * 128 + 8 * hh;
#pragma unroll
      for (int s = 0; s < 8; ++s) qf[s] = *(const bf16x8*)(qp + 16 * s); }
    const float gate_c = sigm(bf2f(Z[trow * ZW + ZNG + head])), gate_s = sigm(bf2f(Z[trow * ZW + ZNG + 16 + head])), gate_w = sigm(bf2f(Z[trow * ZW + ZNG + 32 + head]));
    tile_gload(R, ksel, ZW, vsel, SEQ, tid);
    f32x16 o[4];
#pragma unroll
    for (int dt = 0; dt < 4; ++dt)
#pragma unroll
        for (int i = 0; i < 16; ++i) o[dt][i] = 0.f;
    BAR_LDS();
    {
        const int cmax = (t - 31) >> 4;
        float mx = -1e30f, ps = 0.f;
#pragma unroll 1
        for (int T = 0; T < 2; ++T) { f32x16 x0, x1; qk_lds(x0, x1, (T ? buf1 : buf0) + kboff, qf); float mm = -1e30f;
#pragma unroll
            for (int i = 0; i < 16; ++i) { const int cb = 64 * T + 16 * (i >> 3) + 8 * hh + (i & 7);
                x0[i] = (cb <= cmax) ? x0[i] * CS : -INFINITY; x1[i] = (cb + 32 <= cmax) ? x1[i] * CS : -INFINITY; mm = fmaxf(mm, fmaxf(x0[i], x1[i])); }
            mm = fmaxf(mm, __shfl_xor(mm, 32));
            const float mnew = fmaxf(mx, mm); float s = 0.f;
#pragma unroll
            for (int i = 0; i < 16; ++i) s += exp2f(x0[i] - mnew) + exp2f(x1[i] - mnew);
            ps = ps * exp2f(mx - mnew) + s; mx = mnew; }
        ps += __shfl_xor(ps, 32);
        const float inv = ps > 0.f ? 1.0f / ps : 0.f;
        LAS float* prow = part + ((size_t)(g * 64 + tl) * 34) * 2;
        asm volatile("" : "+v"(prow));
#pragma unroll 1
        for (int T = 0; T < 2; ++T) { f32x16 x0, x1; qk_lds(x0, x1, (T ? buf1 : buf0) + kboff, qf);
#pragma unroll
            for (int i = 0; i < 16; ++i) { const int cb = 64 * T + 16 * (i >> 3) + 8 * hh + (i & 7);
                const float s0 = (cb <= cmax) ? x0[i] * CS : -INFINITY, s1 = (cb + 32 <= cmax) ? x1[i] * CS : -INFINITY; x0[i] = exp2f(s0 - mx) * inv; x1[i] = exp2f(s1 - mx) * inv; }
#pragma unroll
            for (int mt = 0; mt < 2; ++mt)
#pragma unroll
                for (int s2 = 0; s2 < 2; ++s2) { const f32x16& p = mt ? x1 : x0;
                    const int n0 = 16 * T + 8 * mt + 4 * s2 + 2 * hh;
                    const float A = (p[8 * s2] + p[8 * s2 + 1]) + (p[8 * s2 + 2] + 0.5f * p[8 * s2 + 3]);
                    const float Bv = (0.5f * p[8 * s2 + 3] + p[8 * s2 + 4]) + (p[8 * s2 + 5] + p[8 * s2 + 6]) + 0.5f * p[8 * s2 + 7];
                    const float Cv = 0.5f * p[8 * s2 + 7];
                    prow[(n0) * 2] = A; prow[(n0 + 1) * 2] = Bv; prow[(n0 + 2) * 2 + 1] = Cv; }
            pv_lds(o, x0, x1, (T ? buf1 : buf0) + vboff); }
#pragma unroll
        for (int dt = 0; dt < 4; ++dt) o[dt] = o[dt] * gate_c;
    }
    BAR_LDS();
    tile_sstore(R, buf0, tid);
#pragma unroll
    for (int k4 = 0; k4 < 4; ++k4) { const int e = tid + 512 * k4, tok = e >> 5, n = e & 31; float s = 0.f;
#pragma unroll
        for (int gg = 0; gg < 4; ++gg) { const LAS float* pp = part + ((size_t)(gg * 64 + tok) * 34 + n) * 2; s += pp[0] + pp[1]; }
        impr[tok * 33 + n] = s; }
    BAR_LDS();
    if (qt < 16) { if (tid < 64) msk[tid] = (2u << qt) - 1u; }
    else {
#pragma unroll
        for (int k4 = 0; k4 < 4; ++k4) { const int e = tid + 512 * k4, tok = e >> 5, n = e & 31;
            if (n == 0) __hip_atomic_fetch_or(&msk[tok], 1u | (1u << qt) | (1u << (qt - 1)), __ATOMIC_RELAXED, __HIP_MEMORY_SCOPE_WORKGROUP);
            else if (n <= qt - 2) { const float v = impr[tok * 33 + n]; int rank = 0;
                for (int m2 = 1; m2 <= qt - 2; ++m2) { const float u = impr[tok * 33 + m2]; rank += (u > v || (u == v && m2 < n)) ? 1 : 0; }
                if (rank < 13) __hip_atomic_fetch_or(&msk[tok], 1u << n, __ATOMIC_RELAXED, __HIP_MEMORY_SCOPE_WORKGROUP); } }
    }
    BAR_LDS();
    const unsigned mymask = msk[tl];
#pragma unroll
    for (int dt = 0; dt < 4; ++dt)
#pragma unroll
        for (int i = 0; i < 16; i += 2) oacc_l[(dt * 8 + (i >> 1)) * 64] = pk2(o[dt][i], o[dt][i + 1]);
#pragma unroll
    for (int dt = 0; dt < 4; ++dt)
#pragma unroll
        for (int i = 0; i < 16; ++i) o[dt][i] = 0.f;
    float m = -1e30f, l = 0.f;
    for (int i = 0; i < ntile; ++i) {
        if (i + 1 < ntile) { const int i1 = i + 1; const bool br = i1 >= nsel; const int n1 = br ? wlo + (i1 - nsel) : i1;
            tile_gload(R, (br ? kwin : ksel) + (size_t)(64 * n1) * ZW, ZW, (br ? vwin : vsel) + 64 * n1, SEQ, tid); }
        if (i == nsel) {
            l += __shfl_xor(l, 32);
            const float f = l > 0.f ? gate_s / l : 0.f;
#pragma unroll
            for (int dt = 0; dt < 4; ++dt)
#pragma unroll
                for (int i2 = 0; i2 < 16; i2 += 2) { LAS unsigned* ap = oacc_l + (dt * 8 + (i2 >> 1)) * 64; const unsigned pw = *ap;
                    *ap = pk2(blo(pw) + f * o[dt][i2], bhi(pw) + f * o[dt][i2 + 1]); o[dt][i2] = 0.f; o[dt][i2 + 1] = 0.f; }
            m = -1e30f; l = 0.f;
        }
        const bool win = i >= nsel; const int n = win ? wlo + (i - nsel) : i;
        LAS unsigned char* bufc = (i & 1) ? buf1 : buf0;
        f32x16 x0, x1; qk_lds(x0, x1, bufc + kboff, qf);
        const bool rowok = win ? true : (((mymask >> n) & 1u) != 0u);
        if (n == qt || (win && n == qt - 8)) {
            const int lim = t - 64 * n, lo_lim = win ? lim - 512 : -100000;
#pragma unroll
            for (int i2 = 0; i2 < 16; ++i2) { const int kk = 16 * (i2 >> 3) + 8 * hh + (i2 & 7);
                x0[i2] = (kk <= lim && kk > lo_lim) ? x0[i2] : -INFINITY; x1[i2] = (kk + 32 <= lim && kk + 32 > lo_lim) ? x1[i2] : -INFINITY; }
        }
        softmax_step(x0, x1, m, l, o, rowok, CS);
        pv_lds(o, x0, x1, bufc + vboff);
        if (i + 1 < ntile) tile_sstore(R, (i & 1) ? buf0 : buf1, tid);
        BAR_LDS();
    }
    {
        l += __shfl_xor(l, 32);
        const float f = l > 0.f ? gate_w / l : 0.f;
        bf16* op = ON + trow * 2048 + head * 128 + 4 * hh;
#pragma unroll
        for (int dt = 0; dt < 4; ++dt)
#pragma unroll
            for (int a4 = 0; a4 < 4; ++a4) { const unsigned p0 = oacc_l[(dt * 8 + 2 * a4) * 64], p1 = oacc_l[(dt * 8 + 2 * a4 + 1) * 64];
                v2u wv; wv.x = pk2(blo(p0) + f * o[dt][4 * a4], bhi(p0) + f * o[dt][4 * a4 + 1]); wv.y = pk2(blo(p1) + f * o[dt][4 * a4 + 2], bhi(p1) + f * o[dt][4 * a4 + 3]);
                *(v2u*)(op + 32 * dt + 8 * a4) = wv; }
    }
    BAR_LDS();
}
DI int queue_next(Frame& F, unsigned* ctr) {
    LAS int* slot = (LAS int*)(F.lds + LDS_BYTES - 128);
    if (F.tid == 0) *slot = (int)atomicAdd(ctr, 1u);
    BAR_LDS(); const int v = *slot; BAR_LDS();
    return v;
}
DI void p3_scan_nsa(Frame& F) {
    for (int it = F.bid; it < 128; it += F.G) g2_item<2>(F, it);
    unsigned* ctr = (unsigned*)(F.ws + WS_CTL + 8192);
#pragma unroll 1
    for (;;) { const int it = queue_next(F, ctr); if (it >= 512) break; nsa_item(F, (it & 15) * 32 + (31 - (it >> 4))); }
}
DI void p4_gla_out(Frame& F) {
    const int gw = F.bid * 8 + F.wave, NGW = F.G * 8;
    for (int rh = gw; rh < MTOK * 4; rh += NGW) gla_out_row(F, rh);
}

#define XB_TMO      128
#define XB_XCNT(j)  (256  + 64 * (j))
#define XB_XSUB(j)  (1280 + 64 * (j))
#define XB_XGEN(j)  (2304 + 64 * (j))
#define XB_TOP      3328
#define XB_TOPGEN   3392
#define XCD_BAR_WORDS 3456
#define XB_SPIN_CAP (1u << 18)

__device__ __forceinline__ unsigned xb_ld(unsigned* p)              { return __hip_atomic_load(p, __ATOMIC_RELAXED, __HIP_MEMORY_SCOPE_AGENT); }
__device__ __forceinline__ unsigned xb_add(unsigned* p, unsigned v) { return __hip_atomic_fetch_add(p, v, __ATOMIC_RELAXED, __HIP_MEMORY_SCOPE_AGENT); }
__device__ __forceinline__ unsigned xb_xcc_id() { return (unsigned)__builtin_amdgcn_s_getreg((3 << 11) | 20) & 0xFu; }
#define XB_SPIN(cond, bar) do { unsigned _sp = 0; while (cond) { __builtin_amdgcn_s_sleep(1); \
    if ((++_sp & 255u) == 0u) { if (xb_ld(&(bar)[XB_TMO])) break; if (_sp > XB_SPIN_CAP) { atomicAdd(&(bar)[XB_TMO], 1u); break; } } } } while (0)
struct XcdBarrier {
    unsigned* bar; unsigned x;
    volatile LAS unsigned* st;
};

__device__ __forceinline__ XcdBarrier xcd_barrier_post(unsigned* bar, volatile LAS unsigned* st) {
    XcdBarrier b; b.bar = bar; b.x = xb_xcc_id(); b.st = st;
    if (threadIdx.x == 0) (void)xb_add(&bar[XB_XCNT(b.x)], 1u);
    return b;
}
__device__ __forceinline__ void xcd_barrier_complete(unsigned* bar, unsigned x, unsigned& nloc, unsigned& nx) {
    const unsigned G = gridDim.x * gridDim.y * gridDim.z;
    unsigned sum, cnt, mine, sp = 0u;
    for (;;) {
        sum = 0u; cnt = 0u; mine = 0u;
#pragma unroll
        for (unsigned j = 0; j < 16; ++j) { const unsigned c = xb_ld(&bar[XB_XCNT(j)]); sum += c; cnt += (c > 0u) ? 1u : 0u; mine = (j == x) ? c : mine; }
        if (sum == G) break;
        __builtin_amdgcn_s_sleep(1);
        if ((++sp & 255u) == 0u) { if (xb_ld(&bar[XB_TMO])) break; if (sp > XB_SPIN_CAP) { atomicAdd(&bar[XB_TMO], 1u); break; } }
    }
    nloc = mine > 0u ? mine : 1u; nx = cnt > 0u ? cnt : 1u;
}

__device__ __forceinline__ void xcd_barrier(const XcdBarrier& b) {
    asm volatile("s_waitcnt vmcnt(0)" ::: "memory");
    __syncthreads();
    if (threadIdx.x == 0) {
        unsigned* bar = b.bar;
        __builtin_amdgcn_s_waitcnt(0);
        unsigned nloc = b.st[0], nx = b.st[1];
        if (nloc == 0u) { xcd_barrier_complete(bar, b.x, nloc, nx); b.st[0] = nloc; b.st[1] = nx; }
        const unsigned old = xb_add(&bar[XB_XSUB(b.x)], 1u);
        const unsigned gen = old / nloc;
        if (old + 1u == (gen + 1u) * nloc) {
            __builtin_amdgcn_fence(__ATOMIC_RELEASE, "agent");
            asm volatile("s_waitcnt vmcnt(0)" ::: "memory");
            const unsigned og = xb_add(&bar[XB_TOP], 1u);
            const unsigned tg = og / nx;
            if (og + 1u == (tg + 1u) * nx) xb_add(&bar[XB_TOPGEN], 1u);
            else XB_SPIN(xb_ld(&bar[XB_TOPGEN]) == tg, bar);
            __builtin_amdgcn_fence(__ATOMIC_ACQUIRE, "agent");
            xb_add(&bar[XB_XGEN(b.x)], 1u);
            asm volatile("s_waitcnt vmcnt(0)" ::: "memory");
        } else {
            XB_SPIN(xb_ld(&bar[XB_XGEN(b.x)]) == gen, bar);
            __builtin_amdgcn_fence(__ATOMIC_ACQUIRE, "agent");
            asm volatile("s_waitcnt vmcnt(0)" ::: "memory");
        }
    }
    __syncthreads();
}

#ifndef MK_N_LAUNCHES
#define MK_N_LAUNCHES 1
#endif
constexpr int N_PHASES = 11;
__global__ void __launch_bounds__(512, 2) hybrid_fwd(Args args) {
    extern __shared__ __attribute__((aligned(16))) unsigned char lds_raw[];
    Frame F;
    F.lds = (LAS unsigned char*)lds_raw;
    F.tid = threadIdx.x; F.lane = F.tid & 63; F.wave = __builtin_amdgcn_readfirstlane(F.tid >> 6); F.G = gridDim.x; F.bid = blockIdx.x;
    F.x = args.in[0]; F.g_mix = args.in[1]; F.w_in = args.in[2]; F.w_gla_gate = args.in[3]; F.b_gla_gate = args.in[4]; F.g_gla_out = args.in[5];
    F.pe_k = args.in[6]; F.w_ck1 = args.in[7]; F.w_ck2 = args.in[8]; F.pe_v = args.in[9]; F.w_cv1 = args.in[10]; F.w_cv2 = args.in[11];
    F.w_pg = args.in[12]; F.w_pn = args.in[13]; F.w_out = args.in[14]; F.g_ffn = args.in[15]; F.w_fg = args.in[16]; F.w_fu = args.in[17]; F.w_fd = args.in[18]; F.g_final = args.in[19];
    F.out = args.out; F.ws = args.ws;
    const int lo = args.ph_lo, hi = args.ph_hi;
    volatile LAS unsigned* bst = (volatile LAS unsigned*)(F.lds + LDS_BYTES - 64);
    if (F.tid < 16) bst[F.tid] = 0u;
    __syncthreads();
    XcdBarrier xbar = xcd_barrier_post((unsigned*)(F.ws + WS_CTL + 65536), bst);
    if (lo < 0) cg::this_grid().sync();
    typedef pg8::bf16_t pb;
#ifndef PH_MASK
#define PH_MASK 0x7ff
#endif
#define IN(k) (((PH_MASK >> (k)) & 1) && lo <= (k) && (k) < hi)
#ifndef REPEAT_MASK
#define REPEAT_MASK 0
#endif
#define NREP(k) (1 + ((REPEAT_MASK >> (k)) & 1))
#define SEAM(k) do { if (IN(k) && IN((k) + 1)) xcd_barrier(xbar); } while (0)
    if (IN(0)) { for (int rep = 0; rep < NREP(0); ++rep) p0_prologue(F, rep == 0); } SEAM(0);
    if (IN(1)) for (int rep = 0; rep < NREP(1); ++rep) {
        pg8::Gemm g{(const pb*)(F.ws + WS_BUFA), (const pb*)(F.ws + WS_WINT), MTOK, ZW, DM}; pg8::StaticOrder S; S.init(MTOK, ZW, F.G, F.bid);
        pg8::EpiBf16Plain E{(pb*)(F.ws + WS_Z), ZW};
        pg8::gemm_phase<pg8::EpiBf16Plain, pg8::StaticOrder, true, true>(F.lds, g, S, E);
    } SEAM(1);
    if (IN(2)) { for (int rep = 0; rep < NREP(2); ++rep) p2_prep(F); } SEAM(2);
    if (IN(3)) { p3_scan_nsa(F); } SEAM(3);
    if (IN(4)) { p4_gla_out(F); } SEAM(4);
    if (IN(5)) {
        { pg8::Gemm g{(const pb*)(F.ws + WS_BUFB), (const pb*)(F.ws + WS_WPG), MTOK, DM, DM}; pg8::StaticOrder S; S.init(MTOK, DM, F.G, F.bid);
          pg8::EpiGate<false> E{(pb*)(F.ws + WS_MERGED), (const pb*)(F.ws + WS_Z) + ZMG, DM, ZW};
          pg8::gemm_phase<pg8::EpiGate<false>, pg8::StaticOrder, true, true>(F.lds, g, S, E); }
        { pg8::Gemm g{(const pb*)(F.ws + WS_ON), (const pb*)(F.ws + WS_WPN), MTOK, DM, DM}; pg8::StaticOrder S; S.init(MTOK, DM, F.G, F.bid);
          pg8::EpiGate<true> E{(pb*)(F.ws + WS_MERGED), (const pb*)(F.ws + WS_Z) + ZMG + 2048, DM, ZW};
          pg8::gemm_phase<pg8::EpiGate<true>, pg8::StaticOrder, true, true>(F.lds, g, S, E); }
    } SEAM(5);
    if (IN(6)) {
        pg8::Gemm g{(const pb*)(F.ws + WS_MERGED), (const pb*)(F.ws + WS_WOUT), MTOK, DM, DM}; pg8::StaticOrder S; S.init(MTOK, DM, F.G, F.bid);
        pg8::EpiResF32 E{F.x, F.out, DM};
        pg8::gemm_phase<pg8::EpiResF32, pg8::StaticOrder, true, true>(F.lds, g, S, E);
    } SEAM(6);
    if (IN(7)) { for (int rep = 0; rep < NREP(7); ++rep) p7_norm_ffnw(F); } SEAM(7);
    if (IN(8)) for (int rep = 0; rep < NREP(8); ++rep) {
        pg8::Gemm g{(const pb*)(F.ws + WS_BUFB), (const pb*)(F.ws + WS_WGU), MTOK, 2 * DFF, DM}; pg8::StaticOrder S; S.init(MTOK, 2 * DFF, F.G, F.bid);
        pg8::EpiSwiGLU E{(pb*)(F.ws + WS_ACT), DFF};
        pg8::gemm_phase<pg8::EpiSwiGLU, pg8::StaticOrder, true, true>(F.lds, g, S, E);
    } SEAM(8);
    if (IN(9)) {
        pg8::Gemm g{(const pb*)(F.ws + WS_ACT), (const pb*)(F.ws + WS_WD), MTOK, DM, DFF}; pg8::StaticOrder S; S.init(MTOK, DM, F.G, F.bid);
        pg8::EpiResF32 E{F.out, F.out, DM};
        pg8::gemm_phase<pg8::EpiResF32, pg8::StaticOrder, true, true>(F.lds, g, S, E);
    } SEAM(9);
    if (IN(10)) { p10_final(F); }
#undef IN
#undef SEAM
}

extern "C" void kernel_launch(void* const* d_in, const int* in_sizes, int n_in, void* d_out, int out_size, void* d_ws, size_t ws_size, hipStream_t stream) {
    static int grid = 0;
    if (grid == 0) {
        if (n_in != 20 || in_sizes[0] != MTOK * DM || out_size != MTOK * DM || ws_size < WS_END) {
            fprintf(stderr, "kernel_launch: unexpected shapes (n_in %d, in0 %d, out %d, ws %zu < %zu); nothing launched\n", n_in, n_in > 0 ? in_sizes[0] : -1, out_size, ws_size, (size_t)WS_END); grid = -1; return; }
        int dev = 0, cus = 0, per_cu = 0;
        if (hipGetDevice(&dev) != hipSuccess || hipDeviceGetAttribute(&cus, hipDeviceAttributeMultiprocessorCount, dev) != hipSuccess) { grid = -1; return; }
        if (hipFuncSetAttribute((const void*)hybrid_fwd, hipFuncAttributeMaxDynamicSharedMemorySize, LDS_BYTES) != hipSuccess) { fprintf(stderr, "kernel_launch: hipFuncSetAttribute failed\n"); grid = -1; return; }
        if (hipOccupancyMaxActiveBlocksPerMultiprocessor(&per_cu, (const void*)hybrid_fwd, 512, LDS_BYTES) != hipSuccess || per_cu < 1) { fprintf(stderr, "kernel_launch: occupancy query says %d blocks per CU\n", per_cu); per_cu = 1; }
        (void)hipGetLastError();
        grid = cus * (per_cu > 1 ? 1 : per_cu);
    }
    if (grid < 0) return;
    (void)hipMemsetAsync((char*)d_ws + WS_CTL, 0, CTL_ZERO_BYTES, stream);
    Args a{};
    for (int i = 0; i < 20; ++i) a.in[i] = (const float*)d_in[i];
    a.out = (float*)d_out; a.ws = (unsigned char*)d_ws;
#if MK_N_LAUNCHES == 1
    a.ph_lo = 0; a.ph_hi = N_PHASES;
    void* kargs[] = {&a};
    hipError_t e = hipLaunchCooperativeKernel((const void*)hybrid_fwd, dim3(grid), dim3(512), kargs, LDS_BYTES, stream);
    if (e != hipSuccess) fprintf(stderr, "kernel_launch: cooperative launch failed: %s (grid %d)\n", hipGetErrorString(e), grid);
#else
    for (int p = 0; p < N_PHASES; ++p) { a.ph_lo = p; a.ph_hi = p + 1; hipLaunchKernelGGL(hybrid_fwd, dim3(grid), dim3(512), LDS_BYTES, stream, a); }
#endif
}
```

```cpp
#include <hip/hip_runtime.h>
#include <hip/hip_cooperative_groups.h>
#include <cstdio>
#include <cstdint>
namespace cg = cooperative_groups;
#define MK_N_LAUNCHES 1
#define REPEAT_MASK 0
namespace pg8 {
#define PG8_LAS __attribute__((address_space(3)))
typedef unsigned short bf16_t;
typedef short bf16x8 __attribute__((ext_vector_type(8)));
typedef float f32x4 __attribute__((ext_vector_type(4)));
typedef unsigned u32x4 __attribute__((ext_vector_type(4)));
constexpr int BM = 256, BK = 64, HALF = 128, HTB = HALF * BK * 2  , STAGE_BYTES = 8 * HTB, NXCD = 8, WGM = 8;

__host__ __device__ __forceinline__ int lds_byte(int r, int c) { const int st = (r >> 4) * 2 + (c >> 5), rr = r & 15, cc = c & 31, ob = rr * 64 + cc * 2; return st * 1024 + (ob ^ (((ob >> 9) & 1) << 5)); }
__host__ __device__ __forceinline__ void stage_rc(int b, int& R, int& C) { const int st = b / 1024, sb = b % 1024, swz = sb ^ (((sb >> 9) & 1) << 5); R = (st >> 1) * 16 + swz / 64; C = (st & 1) * 32 + (swz % 64) / 2; }
__host__ __device__ __forceinline__ int perm32(int rho) { const int n = rho >> 4, i = rho & 15; return 8 * (i >> 2) + 4 * n + (i & 3); }

struct Unit { int pm, pn; };
struct Gemm { const bf16_t* A; const bf16_t* Bt; int M, N, K; };

struct StaticOrder {
    int nM, nN, nwg, G, c;
    __host__ __device__ void init(int M, int N, int G_, int c_) { nM = M / BM; nN = N / BM; nwg = nM * nN; G = G_; c = c_; }
    __host__ __device__ bool next(int i, Unit& u) const {
        const long L = (long)i * G + c; if (L >= nwg) return false;
        int wgid = (int)L; { const int q = nwg / NXCD, r = nwg % NXCD, xcd = wgid % NXCD, off = wgid / NXCD; wgid = (xcd < r ? xcd * (q + 1) : r * (q + 1) + (xcd - r) * q) + off; }
        const int nig = WGM * nN, gid = wgid / nig, fm = gid * WGM, gsz = (nM - fm) < WGM ? (nM - fm) : WGM;
        u.pm = fm + ((wgid % nig) % gsz); u.pn = (wgid % nig) / gsz; return true;
    }
    __device__ __forceinline__ void a_ready(const Unit&) const {}
    __device__ __forceinline__ void done(const Unit&) const {}
};

__device__ __forceinline__ unsigned cvt_pk_bf16(float lo, float hi) { unsigned r; asm volatile("v_cvt_pk_bf16_f32 %0, %1, %2" : "=v"(r) : "v"(lo), "v"(hi)); return r; }
__device__ __forceinline__ float bf_lo(unsigned w) { return __uint_as_float(w << 16); }
__device__ __forceinline__ float bf_hi(unsigned w) { return __uint_as_float(w & 0xffff0000u); }
__device__ __forceinline__ float sigmoidf_(float x) { return 1.0f / (1.0f + __expf(-x)); }

struct EpiBf16Plain {
    static constexpr bool PERM = true, AFTER_DRAIN = false;
    bf16_t* O; int ldc;
    __device__ __forceinline__ void operator()(const f32x4 (&acc)[2][2][4][2], const Unit& u, int wr, int wc, int fr, int fq) const {
        const int row0 = u.pm * BM + wr * 64 + fr; const int col0 = u.pn * BM + wc * 32 + 8 * fq;
#pragma unroll
        for (int ai = 0; ai < 2; ++ai)
#pragma unroll
            for (int m = 0; m < 4; ++m) { bf16_t* rowp = O + (size_t)(row0 + ai * HALF + m * 16) * ldc + col0;
#pragma unroll
                for (int bj = 0; bj < 2; ++bj) { const f32x4 v0 = acc[ai][bj][m][0], v1 = acc[ai][bj][m][1];
                    u32x4 w; w.x = cvt_pk_bf16(v0[0], v0[1]); w.y = cvt_pk_bf16(v0[2], v0[3]); w.z = cvt_pk_bf16(v1[0], v1[1]); w.w = cvt_pk_bf16(v1[2], v1[3]);
                    *(u32x4*)(rowp + bj * HALF) = w; } }
    }
};
template <bool ADD> struct EpiGate {
    static constexpr bool PERM = true, AFTER_DRAIN = false;
    bf16_t* O; const bf16_t* G; int ldo, ldg;
    __device__ __forceinline__ void operator()(const f32x4 (&acc)[2][2][4][2], const Unit& u, int wr, int wc, int fr, int fq) const {
        const int row0 = u.pm * BM + wr * 64 + fr; const int col0 = u.pn * BM + wc * 32 + 8 * fq;
#pragma unroll
        for (int ai = 0; ai < 2; ++ai)
#pragma unroll
            for (int m = 0; m < 4; ++m) { const size_t row = (size_t)(row0 + ai * HALF + m * 16);
#pragma unroll
                for (int bj = 0; bj < 2; ++bj) { const f32x4 v0 = acc[ai][bj][m][0], v1 = acc[ai][bj][m][1];
                    const u32x4 gw = *(const u32x4*)(G + row * ldg + col0 + bj * HALF);
                    float r[8];
                    r[0] = sigmoidf_(bf_lo(gw.x)) * v0[0]; r[1] = sigmoidf_(bf_hi(gw.x)) * v0[1]; r[2] = sigmoidf_(bf_lo(gw.y)) * v0[2]; r[3] = sigmoidf_(bf_hi(gw.y)) * v0[3];
                    r[4] = sigmoidf_(bf_lo(gw.z)) * v1[0]; r[5] = sigmoidf_(bf_hi(gw.z)) * v1[1]; r[6] = sigmoidf_(bf_lo(gw.w)) * v1[2]; r[7] = sigmoidf_(bf_hi(gw.w)) * v1[3];
                    bf16_t* op = O + row * ldo + col0 + bj * HALF;
                    if (ADD) { const u32x4 pw = *(const u32x4*)op;
                        r[0] += bf_lo(pw.x); r[1] += bf_hi(pw.x); r[2] += bf_lo(pw.y); r[3] += bf_hi(pw.y); r[4] += bf_lo(pw.z); r[5] += bf_hi(pw.z); r[6] += bf_lo(pw.w); r[7] += bf_hi(pw.w); }
                    u32x4 w; w.x = cvt_pk_bf16(r[0], r[1]); w.y = cvt_pk_bf16(r[2], r[3]); w.z = cvt_pk_bf16(r[4], r[5]); w.w = cvt_pk_bf16(r[6], r[7]);
                    *(u32x4*)op = w; } }
    }
};
struct EpiSwiGLU {
    static constexpr bool PERM = true, AFTER_DRAIN = false;
    bf16_t* O; int ldo;
    __device__ __forceinline__ void operator()(const f32x4 (&acc)[2][2][4][2], const Unit& u, int wr, int wc, int fr, int fq) const {
        const int row0 = u.pm * BM + wr * 64 + fr; const int col0 = u.pn * HALF + wc * 32 + 8 * fq;
#pragma unroll
        for (int ai = 0; ai < 2; ++ai)
#pragma unroll
            for (int m = 0; m < 4; ++m) { const size_t row = (size_t)(row0 + ai * HALF + m * 16);
                const f32x4 g0 = acc[ai][0][m][0], g1 = acc[ai][0][m][1], u0 = acc[ai][1][m][0], u1 = acc[ai][1][m][1];
                float r[8];
#pragma unroll
                for (int e = 0; e < 4; ++e) { r[e] = g0[e] * sigmoidf_(g0[e]) * u0[e]; r[4 + e] = g1[e] * sigmoidf_(g1[e]) * u1[e]; }
                u32x4 w; w.x = cvt_pk_bf16(r[0], r[1]); w.y = cvt_pk_bf16(r[2], r[3]); w.z = cvt_pk_bf16(r[4], r[5]); w.w = cvt_pk_bf16(r[6], r[7]);
                *(u32x4*)(O + row * ldo + col0) = w; }
    }
};
struct EpiResF32 {
    static constexpr bool PERM = false, AFTER_DRAIN = false;
    const float* base; float* out; int ldc;
    __device__ __forceinline__ void operator()(const f32x4 (&acc)[2][2][4][2], const Unit& u, int wr, int wc, int fr, int fq) const {
        const int row0 = u.pm * BM + wr * 64 + fr, col0 = u.pn * BM + wc * 32 + 4 * fq;
#pragma unroll
        for (int ai = 0; ai < 2; ++ai)
#pragma unroll
            for (int m = 0; m < 4; ++m) { const size_t off = (size_t)(row0 + ai * HALF + m * 16) * ldc + col0;
#pragma unroll
                for (int bj = 0; bj < 2; ++bj)
#pragma unroll
                    for (int n = 0; n < 2; ++n) { const f32x4 bs = *(const f32x4*)(base + off + bj * HALF + n * 16); *(f32x4*)(out + off + bj * HALF + n * 16) = bs + acc[ai][bj][m][n]; } }
    }
};
template <class Epi, class Sched, bool ALIGN_EPI = false, bool SP2 = false>
__device__ __forceinline__ void gemm_phase(PG8_LAS unsigned char* lds, const Gemm g, const Sched& S, const Epi& E) {
    const int tid = threadIdx.x, wid = __builtin_amdgcn_readfirstlane(tid >> 6), lane = tid & 63, wr = wid >> 2, wc = wid & 3, fr = lane & 15, fq = lane >> 4;
    const int K = g.K, nt = K / BK;
    unsigned voffA[2], voffB[2];
#pragma unroll
    for (int i = 0; i < 2; ++i) { int R, C; stage_rc(tid * 16 + i * 8192, R, C); const int Rb = Epi::PERM ? ((R & ~31) + perm32(R & 31)) : R;
        voffA[i] = (unsigned)(R * K + C) * 2u; voffB[i] = (unsigned)(Rb * K + C) * 2u; }
    const size_t kstep = (size_t)(BK * 2);
    const size_t hstep = (size_t)HALF * K * 2;
    const size_t tstep = 2 * hstep;
    const unsigned ldsw = (unsigned)wid * 1024u;
    const int aoff = lds_byte(wr * 64 + fr, fq * 8), boff = lds_byte(wc * 32 + fr, fq * 8);
#define PG8_SA(b, h) (((b) * 2 + (h)) * HTB)
#define PG8_SB(b, h) ((4 + (b) * 2 + (h)) * HTB)
#define PG8_STAGE(bufoff, gbase, voff) do { _Pragma("unroll") for (int _i = 0; _i < 2; ++_i) \
        __builtin_amdgcn_global_load_lds((const unsigned*)((const char*)(gbase) + (voff)[_i]), (PG8_LAS unsigned*)(lds + (bufoff) + ldsw + _i * 8192), 16, 0, 0); } while (0)
#define PG8_LDA(dst, b, h) do { _Pragma("unroll") for (int m = 0; m < 4; ++m) _Pragma("unroll") for (int k = 0; k < 2; ++k) dst[m][k] = *(const PG8_LAS bf16x8*)(lds + PG8_SA(b, h) + aoff + m * 2048 + k * 1024); } while (0)
#define PG8_LDB(dst, b, h) do { _Pragma("unroll") for (int n = 0; n < 2; ++n) _Pragma("unroll") for (int k = 0; k < 2; ++k) dst[n][k] = *(const PG8_LAS bf16x8*)(lds + PG8_SB(b, h) + boff + n * 2048 + k * 1024); } while (0)
#define PG8_MMA(ai, bj, At, Bt) do { __builtin_amdgcn_s_setprio(1); _Pragma("unroll") for (int m = 0; m < 4; ++m) _Pragma("unroll") for (int n = 0; n < 2; ++n) _Pragma("unroll") for (int k = 0; k < 2; ++k) \
        acc[ai][bj][m][n] = __builtin_amdgcn_mfma_f32_16x16x32_bf16(Bt[n][k], At[m][k], acc[ai][bj][m][n], 0, 0, 0); __builtin_amdgcn_s_setprio(0); } while (0)
#define PG8_WAIT_V(n) asm volatile("s_waitcnt vmcnt(" #n ")" ::: "memory")
#define PG8_WAIT_L(n) asm volatile("s_waitcnt lgkmcnt(" #n ")" ::: "memory")
#define PG8_BAR __builtin_amdgcn_s_barrier()
#define PG8_SCHED __builtin_amdgcn_sched_barrier(0)
    Unit cur, nxt; int ui = 0;
    if (!S.next(0, cur)) return;
    f32x4 acc[2][2][4][2];
#pragma unroll
    for (int a = 0; a < 2; ++a)
#pragma unroll
        for (int b = 0; b < 2; ++b)
#pragma unroll
            for (int m = 0; m < 4; ++m)
#pragma unroll
                for (int n = 0; n < 2; ++n) acc[a][b][m][n] = (f32x4){0.f, 0.f, 0.f, 0.f};
    bf16x8 At[4][2], B0[2][2], B1[2][2];
    const char* cA = (const char*)g.A + (size_t)cur.pm * tstep; const char* cB = (const char*)g.Bt + (size_t)cur.pn * tstep;
    S.a_ready(cur);
    if constexpr (SP2) {
        PG8_STAGE(PG8_SB(0, 0), cB, voffB); PG8_STAGE(PG8_SB(0, 1), cB + hstep, voffB); PG8_STAGE(PG8_SA(0, 0), cA, voffA); PG8_STAGE(PG8_SA(0, 1), cA + hstep, voffA);
        if (wr == 1) PG8_BAR;
        PG8_WAIT_V(2); PG8_BAR;
        PG8_STAGE(PG8_SB(1, 0), cB + kstep, voffB); PG8_STAGE(PG8_SA(1, 0), cA + kstep, voffA); PG8_STAGE(PG8_SB(1, 1), cB + hstep + kstep, voffB);
        PG8_WAIT_V(6); PG8_BAR;
    } else {
        PG8_STAGE(PG8_SB(0, 0), cB, voffB); PG8_STAGE(PG8_SA(0, 0), cA, voffA); PG8_STAGE(PG8_SB(0, 1), cB + hstep, voffB); PG8_STAGE(PG8_SA(0, 1), cA + hstep, voffA);
        if (wr == 1) PG8_BAR;
        PG8_WAIT_V(4); PG8_BAR;
        PG8_STAGE(PG8_SB(1, 0), cB + kstep, voffB); PG8_STAGE(PG8_SA(1, 0), cA + kstep, voffA); PG8_STAGE(PG8_SB(1, 1), cB + hstep + kstep, voffB);
        PG8_WAIT_V(6); PG8_BAR;
    }
    for (;;) {
        const bool has_next = S.next(ui + 1, nxt);
        const char* nA = has_next ? (const char*)g.A + (size_t)nxt.pm * tstep : cA; const char* nB = has_next ? (const char*)g.Bt + (size_t)nxt.pn * tstep : cB;
        for (int t = 0; t < nt; t += 2) {
            const bool last = (t == nt - 2);
            const char* a1 = cA + (size_t)(t + 1) * kstep;
            const char* a2 = last ? nA : cA + (size_t)(t + 2) * kstep; const char* b2 = last ? nB : cB + (size_t)(t + 2) * kstep;
            const char* a3 = a2 + kstep; const char* b3 = b2 + kstep;
            if (last && has_next) S.a_ready(nxt);
            if constexpr (SP2) {
            PG8_LDB(B0, 0, 0); PG8_LDB(B1, 0, 1); PG8_SCHED; PG8_LDA(At, 0, 0); PG8_STAGE(PG8_SA(1, 1), a1 + hstep, voffA);
            PG8_WAIT_V(8); PG8_WAIT_L(0); PG8_BAR; PG8_MMA(0, 0, At, B0); PG8_MMA(0, 1, At, B1); PG8_BAR; PG8_SCHED;
            PG8_LDA(At, 0, 1); PG8_STAGE(PG8_SB(0, 0), b2, voffB); PG8_STAGE(PG8_SB(0, 1), b2 + hstep, voffB); PG8_STAGE(PG8_SA(0, 0), a2, voffA);
            PG8_WAIT_V(8); PG8_WAIT_L(0); PG8_BAR; PG8_MMA(1, 0, At, B0); PG8_MMA(1, 1, At, B1); PG8_BAR; PG8_SCHED;
            PG8_LDB(B0, 1, 0); PG8_LDB(B1, 1, 1); PG8_SCHED; PG8_LDA(At, 1, 0); PG8_STAGE(PG8_SA(0, 1), a2 + hstep, voffA);
            PG8_WAIT_V(8); PG8_WAIT_L(0); PG8_BAR; PG8_MMA(0, 0, At, B0); PG8_MMA(0, 1, At, B1); PG8_BAR; PG8_SCHED;
            PG8_LDA(At, 1, 1); PG8_STAGE(PG8_SB(1, 0), b3, voffB); PG8_STAGE(PG8_SB(1, 1), b3 + hstep, voffB); PG8_STAGE(PG8_SA(1, 0), a3, voffA);
            PG8_WAIT_V(8); PG8_WAIT_L(0); PG8_BAR; PG8_MMA(1, 0, At, B0); PG8_MMA(1, 1, At, B1); PG8_BAR; PG8_SCHED;
            } else {
            PG8_LDB(B0, 0, 0); PG8_SCHED; PG8_LDA(At, 0, 0); PG8_STAGE(PG8_SA(1, 1), a1 + hstep, voffA);
            PG8_WAIT_L(8); PG8_BAR; PG8_WAIT_L(0); PG8_MMA(0, 0, At, B0); PG8_BAR; PG8_SCHED;
            PG8_LDB(B1, 0, 1); PG8_STAGE(PG8_SB(0, 0), b2, voffB);
            PG8_BAR; PG8_WAIT_L(0); PG8_MMA(0, 1, At, B1); PG8_BAR;
            PG8_LDA(At, 0, 1); PG8_STAGE(PG8_SA(0, 0), a2, voffA);
            PG8_BAR; PG8_WAIT_L(0); PG8_MMA(1, 0, At, B0); PG8_BAR; PG8_SCHED;
            PG8_STAGE(PG8_SB(0, 1), b2 + hstep, voffB);
            PG8_WAIT_V(6); PG8_BAR; PG8_MMA(1, 1, At, B1); PG8_BAR;
            PG8_LDB(B0, 1, 0); PG8_SCHED; PG8_LDA(At, 1, 0); PG8_STAGE(PG8_SA(0, 1), a2 + hstep, voffA);
            PG8_WAIT_L(8); PG8_BAR; PG8_WAIT_L(0); PG8_MMA(0, 0, At, B0); PG8_BAR; PG8_SCHED;
            PG8_LDB(B1, 1, 1); PG8_STAGE(PG8_SB(1, 0), b3, voffB);
            PG8_BAR; PG8_WAIT_L(0); PG8_MMA(0, 1, At, B1); PG8_BAR;
            PG8_LDA(At, 1, 1); PG8_STAGE(PG8_SA(1, 0), a3, voffA);
            PG8_BAR; PG8_WAIT_L(0); PG8_MMA(1, 0, At, B0); PG8_BAR; PG8_SCHED;
            PG8_STAGE(PG8_SB(1, 1), b3 + hstep, voffB);
            PG8_WAIT_V(6); PG8_BAR; PG8_MMA(1, 1, At, B1); PG8_BAR;
            }
        }
        if constexpr (ALIGN_EPI) { if (wr == 0) PG8_BAR; }
        if constexpr (!Epi::AFTER_DRAIN) { E(acc, cur, wr, wc, fr, fq); S.done(cur); }
        if (!has_next) break;
#pragma unroll
        for (int a = 0; a < 2; ++a)
#pragma unroll
            for (int b = 0; b < 2; ++b)
#pragma unroll
                for (int m = 0; m < 4; ++m)
#pragma unroll
                    for (int n = 0; n < 2; ++n) acc[a][b][m][n] = (f32x4){0.f, 0.f, 0.f, 0.f};
        cur = nxt; cA = nA; cB = nB; ++ui;
        if constexpr (ALIGN_EPI) { if (wr == 1) PG8_BAR; }
    }
    PG8_WAIT_V(0);
    if constexpr (!ALIGN_EPI) { if (wr == 0) PG8_BAR; }
    PG8_BAR;
    if constexpr (Epi::AFTER_DRAIN) { E.fused(acc, cur, wr, wc, fr, fq, lds, wid, lane); S.done(cur); }
#undef PG8_SA
#undef PG8_SB
#undef PG8_STAGE
#undef PG8_LDA
#undef PG8_LDB
#undef PG8_MMA
#undef PG8_WAIT_V
#undef PG8_WAIT_L
#undef PG8_BAR
#undef PG8_SCHED
}
}

constexpr int NB = 4, SEQ = 2048, DM = 2048, MTOK = NB * SEQ;
constexpr int INW = 15424, DFF = 5632;
constexpr int ZW = 15616;
constexpr int ZGQ = 0, ZGK = 1024, ZGV = 2048, ZGR = 4096, ZNQ = 6144, ZNKV = 8192, ZMG = 11264, ZGLR = 15360, ZNG = 15376;
constexpr float RMS_EPS = 1e-6f;
constexpr size_t MiB = 1u << 20;
constexpr size_t WS_CTL = 0, CTL_ZERO_BYTES = 1 * MiB;
constexpr size_t WS_BIAS1 = 4096;
constexpr size_t WS_WINT = 1 * MiB, WS_WPG = 62 * MiB, WS_WPN = 70 * MiB, WS_WOUT = 78 * MiB, WS_W1T = 86 * MiB, WS_W2T = 90 * MiB;
constexpr size_t WS_KC = 91 * MiB, WS_VCT = 91 * MiB + 512 * 1024, WS_DECAY = 92 * MiB, WS_VTS = 93 * MiB, WS_VTW = 101 * MiB, WS_ATT = 109 * MiB;
constexpr size_t WS_QD = 113 * MiB, WS_KET = 129 * MiB, WS_MERGED = 113 * MiB  ;
constexpr size_t WS_BUFA = 145 * MiB  , WS_ON = 145 * MiB, WS_BUFB = 177 * MiB  , WS_Z = 209 * MiB;
constexpr size_t WS_WGU = 209 * MiB, WS_WD = 253 * MiB, WS_ACT = 275 * MiB  ;
constexpr size_t WS_END = 453 * MiB;
constexpr int LDS_BYTES = 147456;

#define LAS __attribute__((address_space(3)))
#define DI __device__ __forceinline__
typedef unsigned short bf16;
typedef unsigned v4u __attribute__((ext_vector_type(4)));
typedef unsigned v2u __attribute__((ext_vector_type(2)));
typedef float f32x4 __attribute__((ext_vector_type(4)));
typedef float f32x16 __attribute__((ext_vector_type(16)));
typedef short bf16x8 __attribute__((ext_vector_type(8)));
typedef float f32x2_t __attribute__((ext_vector_type(2)));
typedef __bf16 bf16x2_t __attribute__((ext_vector_type(2)));
#define MFMA32(a, b, c) __builtin_amdgcn_mfma_f32_32x32x16_bf16((a), (b), (c), 0, 0, 0)
#define MFMA16(a, b, c) __builtin_amdgcn_mfma_f32_16x16x32_bf16((a), (b), (c), 0, 0, 0)
#define LDS_WAIT() asm volatile("s_waitcnt lgkmcnt(0)" ::: "memory")
#define BAR_LDS() do { asm volatile("s_waitcnt lgkmcnt(0)" ::: "memory"); __builtin_amdgcn_s_barrier(); asm volatile("" ::: "memory"); } while (0)

DI unsigned f2bf(float f) { unsigned u = __builtin_bit_cast(unsigned, f); return (u + 0x7fffu + ((u >> 16) & 1u)) >> 16; }
DI unsigned pk2(float lo, float hi) { f32x2_t v = {lo, hi}; bf16x2_t b = __builtin_convertvector(v, bf16x2_t); return __builtin_bit_cast(unsigned, b); }
DI float bf2f(bf16 b) { return __uint_as_float(((unsigned)b) << 16); }
DI float blo(unsigned w) { return __uint_as_float(w << 16); }
DI float bhi(unsigned w) { return __uint_as_float(w & 0xffff0000u); }
DI float sigm(float x) { return 1.0f / (1.0f + __expf(-x)); }
DI float wave_sum(float v) {
#pragma unroll
    for (int o = 1; o < 64; o <<= 1) v += __shfl_xor(v, o);
    return v;
}
DI bf16x8 pack8(float a0, float a1, float a2, float a3, float a4, float a5, float a6, float a7) {
    v4u p; p.x = pk2(a0, a1); p.y = pk2(a2, a3); p.z = pk2(a4, a5); p.w = pk2(a6, a7); return __builtin_bit_cast(bf16x8, p);
}

struct Args {
    const float* in[20]; float* out; unsigned char* ws; int ph_lo, ph_hi;
};
struct Frame {
    LAS unsigned char* lds; int tid, lane, wave, G, bid;
    const float* x; const float* g_mix; const float* w_in; const float* w_gla_gate; const float* b_gla_gate; const float* g_gla_out;
    const float* pe_k; const float* w_ck1; const float* w_ck2; const float* pe_v; const float* w_cv1; const float* w_cv2;
    const float* w_pg; const float* w_pn; const float* w_out; const float* g_ffn; const float* w_fg; const float* w_fu; const float* w_fd; const float* g_final;
    float* out; unsigned char* ws;
};

struct MapId { DI int operator()(int n) const { return n; } };
struct MapOff { int off; DI int operator()(int n) const { return n + off; } };
struct MapWin { DI int operator()(int n) const {
    if (n < 6144) return n; if (n < 6160) return ZGLR + (n - 6144); if (n < 8208) return ZNQ + (n - 6160);
    if (n < 11280) return ZNKV + (n - 8208); if (n < 11328) return ZNG + (n - 11280); return ZMG + (n - 11328); } };
struct MapGU { int up; DI int operator()(int n) const { return (n >> 7) * 256 + up * 128 + (n & 127); } };

template <class Map>
DI void transpose_item(const float* __restrict__ W, int N, bf16* __restrict__ WT, int Kp, LAS float* scr, int item, int lane, const Map map) {
    const int nblk = N / 32, kb = item / nblk, nb = item - kb * nblk, k0 = 64 * kb, n0 = 32 * nb;
    float tv[32];
#pragma unroll
    for (int i = 0; i < 32; ++i) { const int kk = 2 * i + (lane >> 5); tv[i] = W[(size_t)(k0 + kk) * N + n0 + (lane & 31)]; }
#pragma unroll
    for (int i = 0; i < 32; ++i) { const int kk = 2 * i + (lane >> 5); scr[kk * 33 + (lane & 31)] = tv[i]; }
    LDS_WAIT();
    const int c = lane & 7;
#pragma unroll
    for (int j = 0; j < 4; ++j) { const int n = (lane >> 3) + 8 * j; const LAS float* s = scr + (8 * c) * 33 + n;
        v4u o; o.x = pk2(s[0 * 33], s[1 * 33]); o.y = pk2(s[2 * 33], s[3 * 33]); o.z = pk2(s[4 * 33], s[5 * 33]); o.w = pk2(s[6 * 33], s[7 * 33]);
        *(v4u*)(WT + (size_t)map(n0 + n) * Kp + k0 + 8 * c) = o; }
    LDS_WAIT();
}
template <bool TO_BF16>
DI void rms_row(const float* __restrict__ xrow, const float* __restrict__ g, void* orow, int lane) {
    const f32x4* xr = (const f32x4*)xrow + lane; const f32x4* gr = (const f32x4*)g + lane;
    f32x4 v[8]; float s = 0.f;
#pragma unroll
    for (int j = 0; j < 8; ++j) { v[j] = xr[64 * j]; s += (v[j].x * v[j].x + v[j].y * v[j].y) + (v[j].z * v[j].z + v[j].w * v[j].w); }
    const float rs = rsqrtf(wave_sum(s) * (1.f / DM) + RMS_EPS);
#pragma unroll
    for (int j = 0; j < 8; ++j) { const f32x4 gg = gr[64 * j]; const f32x4 o = v[j] * rs * gg;
        if (TO_BF16) { v2u w; w.x = pk2(o.x, o.y); w.y = pk2(o.z, o.w); ((v2u*)orow)[lane + 64 * j] = w; }
        else ((f32x4*)orow)[lane + 64 * j] = o; }
}

DI void p0_prologue(Frame& F, bool with_bias) {
    LAS float* scr = (LAS float*)(F.lds + F.wave * 8448);
    const int gw = F.bid * 8 + F.wave, NGW = F.G * 8;
    bf16* WINT = (bf16*)(F.ws + WS_WINT); bf16* WPG = (bf16*)(F.ws + WS_WPG); bf16* WPN = (bf16*)(F.ws + WS_WPN); bf16* WOUT = (bf16*)(F.ws + WS_WOUT);
    bf16* W1T = (bf16*)(F.ws + WS_W1T); bf16* W2T = (bf16*)(F.ws + WS_W2T);
    constexpr int I_IN = (DM / 64) * (INW / 32), I_P = (DM / 64) * (DM / 32), I_C1 = (4096 / 64) * (256 / 32), I_C2 = (256 / 64) * (128 / 32);
    constexpr int NITEMS = I_IN + 3 * I_P + 2 * I_C1 + 2 * I_C2;
    for (int it = gw; it < NITEMS; it += NGW) {
        int r = it;
        if (r < I_IN) { transpose_item(F.w_in, INW, WINT, DM, scr, r, F.lane, MapWin{}); continue; } r -= I_IN;
        if (r < I_P) { transpose_item(F.w_pg, DM, WPG, DM, scr, r, F.lane, MapId{}); continue; } r -= I_P;
        if (r < I_P) { transpose_item(F.w_pn, DM, WPN, DM, scr, r, F.lane, MapId{}); continue; } r -= I_P;
        if (r < I_P) { transpose_item(F.w_out, DM, WOUT, DM, scr, r, F.lane, MapId{}); continue; } r -= I_P;
        if (r < I_C1) { transpose_item(F.w_ck1, 256, W1T, 4096, scr, r, F.lane, MapId{}); continue; } r -= I_C1;
        if (r < I_C1) { transpose_item(F.w_cv1, 256, W1T, 4096, scr, r, F.lane, MapOff{256}); continue; } r -= I_C1;
        if (r < I_C2) { transpose_item(F.w_ck2, 128, W2T, 256, scr, r, F.lane, MapId{}); continue; } r -= I_C2;
        transpose_item(F.w_cv2, 128, W2T, 256, scr, r, F.lane, MapOff{128});
    }
    bf16* H = (bf16*)(F.ws + WS_BUFA);
    for (int m = gw; m < MTOK; m += NGW) rms_row<true>(F.x + (size_t)m * DM, F.g_mix, H + (size_t)m * DM, F.lane);
    float* bias1 = (float*)(F.ws + WS_BIAS1);
    if (with_bias) for (int it = gw; it < 128; it += NGW) {
        const int which = it >> 6, kc = it & 63; const float* pe = which ? F.pe_v : F.pe_k; const float* w1 = which ? F.w_cv1 : F.w_ck1;
        float a[4] = {0.f, 0.f, 0.f, 0.f};
        for (int kk = kc * 64; kk < kc * 64 + 64; ++kk) { const float p = pe[kk];
#pragma unroll
            for (int q = 0; q < 4; ++q) a[q] += p * w1[(size_t)kk * 256 + F.lane + 64 * q]; }
#pragma unroll
        for (int q = 0; q < 4; ++q) atomicAdd(bias1 + which * 256 + F.lane + 64 * q, a[q]);
    }
}
DI void p7_norm_ffnw(Frame& F) {
    LAS float* scr = (LAS float*)(F.lds + F.wave * 8448);
    const int gw = F.bid * 8 + F.wave, NGW = F.G * 8;
    bf16* WGU = (bf16*)(F.ws + WS_WGU); bf16* WD = (bf16*)(F.ws + WS_WD);
    constexpr int I_G = (DM / 64) * (DFF / 32), I_D = (DFF / 64) * (DM / 32);
    for (int it = gw; it < 2 * I_G + I_D; it += NGW) {
        int r = it;
        if (r < I_G) { transpose_item(F.w_fg, DFF, WGU, DM, scr, r, F.lane, MapGU{0}); continue; } r -= I_G;
        if (r < I_G) { transpose_item(F.w_fu, DFF, WGU, DM, scr, r, F.lane, MapGU{1}); continue; } r -= I_G;
        transpose_item(F.w_fd, DM, WD, DFF, scr, r, F.lane, MapId{});
    }
    bf16* H2 = (bf16*)(F.ws + WS_BUFB);
    for (int m = gw; m < MTOK; m += NGW) rms_row<true>(F.out + (size_t)m * DM, F.g_ffn, H2 + (size_t)m * DM, F.lane);
}
DI void p10_final(Frame& F) {
    const int gw = F.bid * 8 + F.wave, NGW = F.G * 8;
    for (int m = gw; m < MTOK; m += NGW) rms_row<false>(F.out + (size_t)m * DM, F.g_final, F.out + (size_t)m * DM, F.lane);
}

DI void g1_item(Frame& F, int item) {
    const bf16* Z = (const bf16*)(F.ws + WS_Z);
    bf16* QD = (bf16*)(F.ws + WS_QD); bf16* KET = (bf16*)(F.ws + WS_KET); bf16* ATT = (bf16*)(F.ws + WS_ATT); float* DECAY = (float*)(F.ws + WS_DECAY);
    const int bh = item >> 5, c = item & 31, b = bh >> 2, h = bh & 3;
    const size_t t0 = (size_t)b * SEQ + c * 64;
    LAS float* glr_s = (LAS float*)(F.lds);
    LAS float* tot_s = (LAS float*)(F.lds + 4096);
    LAS bf16* qd_s = (LAS bf16*)(F.lds + 8192);
    LAS bf16* kd_s = (LAS bf16*)(F.lds + 8192 + 33792);
    const int tid = F.tid, dk = tid & 255, half = tid >> 8;
    for (int e = tid; e < 1024; e += 512) { const int tok = e >> 4, r = e & 15; glr_s[e] = bf2f(Z[(t0 + tok) * ZW + ZGLR + r]); }
    float wg[16];
#pragma unroll
    for (int r = 0; r < 16; ++r) wg[r] = F.w_gla_gate[r * 1024 + h * 256 + dk];
    const float bg = F.b_gla_gate[h * 256 + dk];
    __syncthreads();
    float bc[32]; float run = 0.f;
#pragma unroll
    for (int i = 0; i < 32; ++i) { const int tok = half * 32 + i; float xg = bg;
        const LAS f32x4* gp = (const LAS f32x4*)(glr_s + tok * 16);
#pragma unroll
        for (int r4 = 0; r4 < 4; ++r4) { const f32x4 gv = gp[r4]; xg += gv.x * wg[4 * r4] + gv.y * wg[4 * r4 + 1] + gv.z * wg[4 * r4 + 2] + gv.w * wg[4 * r4 + 3]; }
        const float ls = fminf(xg, 0.f) - __logf(1.0f + __expf(-fabsf(xg)));
        run += ls * 0.0625f; bc[i] = run; }
    tot_s[half * 256 + dk] = run;
    __syncthreads();
    const float tot0 = tot_s[dk], tot1 = tot_s[256 + dk]; const float blast = tot0 + tot1, boff = half ? tot0 : 0.f;
    unsigned kep[16];
#pragma unroll
    for (int i = 0; i < 32; i += 2) { float ke2[2];
#pragma unroll
        for (int e = 0; e < 2; ++e) { const int tok = half * 32 + i + e; const float bb = bc[i + e] + boff;
            const float q = bf2f(Z[(t0 + tok) * ZW + ZGQ + h * 256 + dk]), k = bf2f(Z[(t0 + tok) * ZW + ZGK + h * 256 + dk]);
            const float qd = q * 0.0625f * __expf(bb), kd = k * __expf(-bb); ke2[e] = k * __expf(blast - bb);
            const bf16 qb = (bf16)f2bf(qd); qd_s[tok * 264 + dk] = qb; kd_s[tok * 264 + dk] = (bf16)f2bf(kd); QD[(t0 + tok) * 1024 + h * 256 + dk] = qb; }
        kep[i >> 1] = pk2(ke2[0], ke2[1]); }
    { v4u* kp = (v4u*)(KET + ((size_t)item * 256 + dk) * 64 + half * 32);
#pragma unroll
      for (int q = 0; q < 4; ++q) { v4u w; w.x = kep[4 * q]; w.y = kep[4 * q + 1]; w.z = kep[4 * q + 2]; w.w = kep[4 * q + 3]; kp[q] = w; } }
    if (half == 0) DECAY[(size_t)item * 256 + dk] = __expf(blast);
    __syncthreads();
    const int w = F.wave, fr = F.lane & 15, fq = F.lane >> 4, mt = w >> 1;
#pragma unroll
    for (int nn = 0; nn < 2; ++nn) { const int nt = (w & 1) * 2 + nn; f32x4 acc = {0.f, 0.f, 0.f, 0.f};
        if (nt <= mt) {
#pragma unroll
            for (int s = 0; s < 8; ++s) { const bf16x8 a = *(const LAS bf16x8*)(qd_s + (16 * mt + fr) * 264 + 32 * s + 8 * fq); const bf16x8 bb = *(const LAS bf16x8*)(kd_s + (16 * nt + fr) * 264 + 32 * s + 8 * fq);
                acc = MFMA16(a, bb, acc); } }
#pragma unroll
        for (int j = 0; j < 4; ++j) { const int row = 16 * mt + 4 * fq + j, col = 16 * nt + fr; const float v = (col <= row) ? acc[j] : 0.f;
            ATT[(size_t)item * 4096 + row * 64 + col] = (bf16)f2bf(v); } }
    __syncthreads();
}

DI void n1_item(Frame& F, int item) {
    const bf16* Z = (const bf16*)(F.ws + WS_Z);
    const bf16* W1T = (const bf16*)(F.ws + WS_W1T); const bf16* W2T = (const bf16*)(F.ws + WS_W2T); const float* bias1 = (const float*)(F.ws + WS_BIAS1);
    bf16* KC = (bf16*)(F.ws + WS_KC); bf16* VCT = (bf16*)(F.ws + WS_VCT);
    const int which = item >> 6, b = (item >> 4) & 3, hk = (item >> 2) & 3, j = item & 3;
    const int w = F.wave, r = F.lane & 31, hh = F.lane >> 5;
    LAS bf16* hid = (LAS bf16*)(F.lds);
    int crow_ = 32 * j + r; if (crow_ > 126) crow_ = 126;
    const bf16* ap = Z + ((size_t)b * SEQ + 16 * crow_) * ZW + ZNKV + which * 512 + hk * 128 + 8 * hh;
    const bf16* bp = W1T + ((size_t)which * 256 + 32 * w + r) * 4096 + 8 * hh;
    f32x16 acc; for (int i = 0; i < 16; ++i) acc[i] = 0.f;
    bf16x8 fa[2][8], fb[2][8];
#pragma unroll
    for (int s = 0; s < 8; ++s) { fa[0][s] = *(const bf16x8*)(ap + 16 * s); fb[0][s] = *(const bf16x8*)(bp + 16 * s); }
#pragma unroll 1
    for (int tk = 0; tk < 32; tk += 2) {
#pragma unroll
        for (int s = 0; s < 8; ++s) { fa[1][s] = *(const bf16x8*)(ap + (size_t)(tk + 1) * ZW + 16 * s); fb[1][s] = *(const bf16x8*)(bp + (tk + 1) * 128 + 16 * s); }
#pragma unroll
        for (int s = 0; s < 8; ++s) acc = MFMA32(fa[0][s], fb[0][s], acc);
        const int t2 = (tk + 2 < 32) ? tk + 2 : 0;
#pragma unroll
        for (int s = 0; s < 8; ++s) { fa[0][s] = *(const bf16x8*)(ap + (size_t)t2 * ZW + 16 * s); fb[0][s] = *(const bf16x8*)(bp + t2 * 128 + 16 * s); }
#pragma unroll
        for (int s = 0; s < 8; ++s) acc = MFMA32(fa[1][s], fb[1][s], acc);
    }
    { const float bs = bias1[which * 256 + 32 * w + r];
#pragma unroll
      for (int i = 0; i < 16; ++i) { const int row = (i & 3) + 8 * (i >> 2) + 4 * hh; const float v = acc[i] + bs; hid[row * 264 + 32 * w + r] = (bf16)f2bf(v * sigm(v)); } }
    __syncthreads();
    if (w < 4) {
        f32x16 o; for (int i = 0; i < 16; ++i) o[i] = 0.f;
        const bf16* b2 = W2T + ((size_t)which * 128 + 32 * w + r) * 256 + 8 * hh;
#pragma unroll
        for (int s = 0; s < 16; ++s) { const bf16x8 a = *(const LAS bf16x8*)(hid + r * 264 + 16 * s + 8 * hh); const bf16x8 bb = *(const bf16x8*)(b2 + 16 * s); o = MFMA32(a, bb, o); }
        const int d = 32 * w + r;
        if (which == 0) {
#pragma unroll
            for (int i = 0; i < 16; ++i) { const int cc = 32 * j + (i & 3) + 8 * (i >> 2) + 4 * hh; KC[(((size_t)b * 4 + hk) * 128 + cc) * 128 + d] = (bf16)f2bf(o[i]); }
        } else {
#pragma unroll
            for (int a4 = 0; a4 < 4; ++a4) { v2u wv; wv.x = pk2(o[4 * a4], o[4 * a4 + 1]); wv.y = pk2(o[4 * a4 + 2], o[4 * a4 + 3]);
                *(v2u*)(VCT + (((size_t)b * 4 + hk) * 128 + d) * 128 + 32 * j + 8 * a4 + 4 * hh) = wv; }
        }
    }
    __syncthreads();
}
DI void vt_item(Frame& F, int item) {
    const bf16* Z = (const bf16*)(F.ws + WS_Z);
    const int dhalf = item & 1, tile = (item >> 1) & 31, hk = (item >> 6) & 3, b = (item >> 8) & 3, which = item >> 10;
    bf16* VT = (bf16*)(F.ws + (which ? WS_VTW : WS_VTS));
    LAS bf16* scr = (LAS bf16*)(F.lds + F.wave * 8448);
    int lane = F.lane; asm volatile("" : "+v"(lane));
    const bf16* src = Z + ((size_t)b * SEQ + tile * 64) * ZW + ZNKV + (3 + 2 * which) * 512 + hk * 128 + dhalf * 64;
#pragma unroll
    for (int p = 0; p < 8; ++p) { const int tok = 8 * p + (lane >> 3), d8 = (lane & 7) * 8; const v4u v = *(const v4u*)(src + (size_t)tok * ZW + d8);
        LAS unsigned* dst = (LAS unsigned*)(scr + tok * 66 + d8); dst[0] = v.x; dst[1] = v.y; dst[2] = v.z; dst[3] = v.w; }
    LDS_WAIT();
#pragma unroll
    for (int p = 0; p < 8; ++p) { const int d = 8 * p + (lane >> 3), t8 = (lane & 7) * 8; unsigned short e[8];
#pragma unroll
        for (int q = 0; q < 8; ++q) e[q] = scr[(t8 + q) * 66 + d];
        v4u o; o.x = e[0] | ((unsigned)e[1] << 16); o.y = e[2] | ((unsigned)e[3] << 16); o.z = e[4] | ((unsigned)e[5] << 16); o.w = e[6] | ((unsigned)e[7] << 16);
        *(v4u*)(VT + (((size_t)b * 4 + hk) * 128 + dhalf * 64 + d) * SEQ + tile * 64 + t8) = o; }
    LDS_WAIT();
}
DI void p2_prep(Frame& F) {
    const int gw = F.bid * 8 + F.wave;
    if (F.G == 256) {
        if (F.bid < 128) { n1_item(F, F.bid); __syncthreads(); for (int it = gw; it < 2048; it += 1024) vt_item(F, it); }
        else { for (int k = 0; k < 4; ++k) g1_item(F, (F.bid - 128) * 4 + k); }
    } else {
        for (int it = F.bid; it < 128 + 512; it += F.G) { if (it < 128) n1_item(F, it); else g1_item(F, it - 128); }
        __syncthreads();
        for (int it = gw; it < 2048; it += F.G * 8) vt_item(F, it);
    }
}

template <int NT>
DI void g2_item(Frame& F, int item) {
    constexpr int DV = 32 * NT, NJ = 16 / NT, ST_BYTES = DV * 264 * 2;
    const bf16* Z = (const bf16*)(F.ws + WS_Z);
    const bf16* QD = (const bf16*)(F.ws + WS_QD); const bf16* KET = (const bf16*)(F.ws + WS_KET); const bf16* ATT = (const bf16*)(F.ws + WS_ATT); const float* DECAY = (const float*)(F.ws + WS_DECAY);
    float* O = F.out;
    const int bh = item / NJ, js = item % NJ, b = bh >> 2, h = bh & 3;
    LAS bf16* ST = (LAS bf16*)(F.lds);
    LAS bf16* VT = (LAS bf16*)(F.lds + ST_BYTES);
    int tid = F.tid; asm volatile("" : "+v"(tid));
    const int w = F.wave, fr = tid & 15, fq = (tid >> 4) & 3, mt = w >> 1, nt0 = (w & 1) * NT;
    for (int e = tid; e < ST_BYTES / 4; e += 512) ((LAS unsigned*)ST)[e] = 0u;
    f32x4 Sacc[2][2 * NT];
#pragma unroll
    for (int a = 0; a < 2; ++a)
#pragma unroll
        for (int c2 = 0; c2 < 2 * NT; ++c2) Sacc[a][c2] = (f32x4){0.f, 0.f, 0.f, 0.f};
    const int vtok = tid >> 3, vd4 = (tid & 7) * 4 * NT;
    const size_t vcol = ZGV + h * 512 + DV * js;
    v2u vv_n[NT]; bf16x8 aatt_n[2], aqd_n[8], aket_n[2][2];
#define G2_LOAD(cc) do { const size_t itemc_ = (size_t)bh * 32 + (cc), t0_ = (size_t)b * SEQ + (cc) * 64; \
        _Pragma("unroll") for (int q = 0; q < NT; ++q) vv_n[q] = *(const v2u*)(Z + (t0_ + vtok) * ZW + vcol + vd4 + 4 * q); \
        _Pragma("unroll") for (int s = 0; s < 2; ++s) aatt_n[s] = *(const bf16x8*)(ATT + itemc_ * 4096 + (16 * mt + fr) * 64 + 32 * s + 8 * fq); \
        _Pragma("unroll") for (int s = 0; s < 8; ++s) aqd_n[s] = *(const bf16x8*)(QD + (t0_ + 16 * mt + fr) * 1024 + h * 256 + 32 * s + 8 * fq); \
        _Pragma("unroll") for (int mi = 0; mi < 2; ++mi) { \
            _Pragma("unroll") for (int s = 0; s < 2; ++s) aket_n[mi][s] = *(const bf16x8*)(KET + (itemc_ * 256 + 32 * w + 16 * mi + fr) * 64 + 32 * s + 8 * fq); \
            } } while (0)
    G2_LOAD(0);
    for (int c = 0; c < 32; ++c) {
        const size_t t0 = (size_t)b * SEQ + c * 64;
        v2u vv[NT];
#pragma unroll
        for (int q = 0; q < NT; ++q) vv[q] = vv_n[q];
        bf16x8 aatt[2], aqd[8], aket[2][2]; f32x4 dec[2];
#pragma unroll
        for (int s = 0; s < 2; ++s) aatt[s] = aatt_n[s];
#pragma unroll
        for (int s = 0; s < 8; ++s) aqd[s] = aqd_n[s];
#pragma unroll
        for (int mi = 0; mi < 2; ++mi) { aket[mi][0] = aket_n[mi][0]; aket[mi][1] = aket_n[mi][1];
            dec[mi] = *(const f32x4*)(DECAY + ((size_t)bh * 32 + c) * 256 + 32 * w + 16 * mi + 4 * fq); }
        if (c + 1 < 32) G2_LOAD(c + 1);
#pragma unroll
        for (int q = 0; q < NT; ++q) {
            VT[(vd4 + 4 * q + 0) * 72 + vtok] = (bf16)(vv[q].x & 0xffffu); VT[(vd4 + 4 * q + 1) * 72 + vtok] = (bf16)(vv[q].x >> 16);
            VT[(vd4 + 4 * q + 2) * 72 + vtok] = (bf16)(vv[q].y & 0xffffu); VT[(vd4 + 4 * q + 3) * 72 + vtok] = (bf16)(vv[q].y >> 16); }
        BAR_LDS();
        {
            bf16x8 bvo[NT][2], bs[8];
#pragma unroll
            for (int q = 0; q < NT; ++q)
#pragma unroll
                for (int s = 0; s < 2; ++s) bvo[q][s] = *(const LAS bf16x8*)(VT + (16 * (nt0 + q) + fr) * 72 + 32 * s + 8 * fq);
#pragma unroll
            for (int s = 0; s < 8; ++s) bs[s] = *(const LAS bf16x8*)(ST + (16 * nt0 + fr) * 264 + 32 * s + 8 * fq);
            __builtin_amdgcn_sched_barrier(0);
#pragma unroll
            for (int q = 0; q < NT; ++q) {
                f32x4 oa = {0.f, 0.f, 0.f, 0.f}, ob = {0.f, 0.f, 0.f, 0.f};
                oa = MFMA16(aatt[0], bvo[q][0], oa); ob = MFMA16(aatt[1], bvo[q][1], ob);
#pragma unroll
                for (int s = 0; s < 8; s += 2) { oa = MFMA16(aqd[s], bs[s], oa); ob = MFMA16(aqd[s + 1], bs[s + 1], ob); }
                __builtin_amdgcn_sched_barrier(0);
                if (q + 1 < NT) {
#pragma unroll
                    for (int s = 0; s < 8; ++s) bs[s] = *(const LAS bf16x8*)(ST + (16 * (nt0 + q + 1) + fr) * 264 + 32 * s + 8 * fq);
                }
                const f32x4 o = oa + ob;
#pragma unroll
                for (int jj = 0; jj < 4; ++jj) O[(t0 + 16 * mt + 4 * fq + jj) * 2048 + h * 512 + DV * js + 16 * (nt0 + q) + fr] = o[jj];
                __builtin_amdgcn_sched_barrier(0);
            }
        }
        {
            bf16x8 bv[2 * NT][2];
#pragma unroll
            for (int ni = 0; ni < 2 * NT; ++ni)
#pragma unroll
                for (int s = 0; s < 2; ++s) bv[ni][s] = *(const LAS bf16x8*)(VT + (16 * ni + fr) * 72 + 32 * s + 8 * fq);
            __builtin_amdgcn_sched_barrier(0);
#pragma unroll
            for (int mi = 0; mi < 2; ++mi)
#pragma unroll
                for (int ni = 0; ni < 2 * NT; ++ni) { f32x4 acc = Sacc[mi][ni] * dec[mi];
                    acc = MFMA16(aket[mi][0], bv[ni][0], acc); acc = MFMA16(aket[mi][1], bv[ni][1], acc); Sacc[mi][ni] = acc; }
        }
        BAR_LDS();
#pragma unroll
        for (int mi = 0; mi < 2; ++mi)
#pragma unroll
            for (int ni = 0; ni < 2 * NT; ++ni) { v2u wv; wv.x = pk2(Sacc[mi][ni][0], Sacc[mi][ni][1]); wv.y = pk2(Sacc[mi][ni][2], Sacc[mi][ni][3]);
                *(LAS v2u*)(ST + (16 * ni + fr) * 264 + 32 * w + 16 * mi + 4 * fq) = wv; }
    }
    BAR_LDS();
}
#undef G2_LOAD

DI void gla_out_row(Frame& F, int rowh) {
    const bf16* Z = (const bf16*)(F.ws + WS_Z); bf16* OG = (bf16*)(F.ws + WS_BUFB);
    const int t = rowh >> 2, h = rowh & 3, lane = F.lane;
    const f32x4* op = (const f32x4*)(F.out + (size_t)t * 2048 + h * 512) + lane;
    const f32x4 a = op[0], bq = op[64];
    float s = (a.x * a.x + a.y * a.y) + (a.z * a.z + a.w * a.w) + (bq.x * bq.x + bq.y * bq.y) + (bq.z * bq.z + bq.w * bq.w);
    const float rs = rsqrtf(wave_sum(s) * (1.f / 512.f) + RMS_EPS);
#pragma unroll
    for (int q = 0; q < 2; ++q) { const f32x4 v = q ? bq : a; const f32x4 g = ((const f32x4*)F.g_gla_out)[lane + 64 * q];
        const v2u rw = *(const v2u*)(Z + (size_t)t * ZW + ZGR + h * 512 + 4 * lane + 256 * q);
        const float r0 = blo(rw.x), r1 = bhi(rw.x), r2 = blo(rw.y), r3 = bhi(rw.y);
        v2u w; w.x = pk2(v.x * rs * g.x * (r0 * sigm(r0)), v.y * rs * g.y * (r1 * sigm(r1))); w.y = pk2(v.z * rs * g.z * (r2 * sigm(r2)), v.w * rs * g.w * (r3 * sigm(r3)));
        *(v2u*)(OG + (size_t)t * 2048 + h * 512 + 4 * lane + 256 * q) = w; }
}
DI int pi_key(int r) { return (r & ~12) | ((r & 4) << 1) | ((r & 8) >> 1); }

constexpr int KB_PITCH = 272, VB_PITCH = 144, KB_BYTES = 64 * KB_PITCH, KV_BUF = KB_BYTES + 128 * VB_PITCH;
constexpr int NSA_X = 2 * KV_BUF;
constexpr int NSA_IMPR = KV_BUF  , NSA_MSK = NSA_X + 69632, NSA_END = NSA_MSK + 256;
static_assert(NSA_END <= LDS_BYTES, "NSA LDS map");
struct TileRegs { v4u k[2], v[2]; };
DI void tile_gload(TileRegs& R, const bf16* kg, size_t kpitch, const bf16* vg, size_t vpitch, int tid) {
#pragma unroll
    for (int j = 0; j < 2; ++j) { const int c = tid + 512 * j;
        R.k[j] = *(const v4u*)(kg + (size_t)(c >> 4) * kpitch + (c & 15) * 8); R.v[j] = *(const v4u*)(vg + (size_t)(c >> 3) * vpitch + (c & 7) * 8); }
}
DI void tile_sstore(const TileRegs& R, LAS unsigned char* buf, int tid) {
#pragma unroll
    for (int j = 0; j < 2; ++j) { const int c = tid + 512 * j;
        *(LAS v4u*)(buf + (c >> 4) * KB_PITCH + (c & 15) * 16) = R.k[j]; *(LAS v4u*)(buf + KB_BYTES + (c >> 3) * VB_PITCH + (c & 7) * 16) = R.v[j]; }
}
#define QK_LOADG(g, bsel) do { fa[bsel][0] = *(const LAS bf16x8*)(kb + 64 * (g)); fa[bsel][1] = *(const LAS bf16x8*)(kb + 32 * KB_PITCH + 64 * (g)); \
        fa[bsel][2] = *(const LAS bf16x8*)(kb + 64 * (g) + 32); fa[bsel][3] = *(const LAS bf16x8*)(kb + 32 * KB_PITCH + 64 * (g) + 32); } while (0)
DI void qk_lds(f32x16& x0, f32x16& x1, const LAS unsigned char* kb, const bf16x8 (&qf)[8]) {
    bf16x8 fa[2][4];
    QK_LOADG(0, 0);
#pragma unroll
    for (int i = 0; i < 16; ++i) { x0[i] = 0.f; x1[i] = 0.f; }
#pragma unroll
    for (int g = 0; g < 4; ++g) {
        if (g < 3) QK_LOADG(g + 1, (g + 1) & 1);
        __builtin_amdgcn_sched_barrier(0);
        x0 = MFMA32(fa[g & 1][0], qf[2 * g], x0); x1 = MFMA32(fa[g & 1][1], qf[2 * g], x1);
        x0 = MFMA32(fa[g & 1][2], qf[2 * g + 1], x0); x1 = MFMA32(fa[g & 1][3], qf[2 * g + 1], x1);
        __builtin_amdgcn_sched_barrier(0);
    }
}
#define PV_LOADG(idx, bsel) do { _Pragma("unroll") for (int dt_ = 0; dt_ < 4; ++dt_) fv[bsel][dt_] = *(const LAS bf16x8*)(vb + (32 * dt_) * VB_PITCH + (32 * ((idx) >> 1) + 16 * ((idx) & 1)) * 2); } while (0)
DI void pv_prefetch(bf16x8 (&fv)[2][4], const LAS unsigned char* vb) { PV_LOADG(0, 0); }
DI void pv_lds(f32x16 (&o)[4], const f32x16& p0, const f32x16& p1, const LAS unsigned char* vb, bf16x8 (&fv)[2][4]) {
#pragma unroll
    for (int idx = 0; idx < 4; ++idx) { const int mt = idx >> 1, s2 = idx & 1; const f32x16& p = mt ? p1 : p0;
        if (idx < 3) PV_LOADG(idx + 1, (idx + 1) & 1);
        const bf16x8 pf = pack8(p[8 * s2], p[8 * s2 + 1], p[8 * s2 + 2], p[8 * s2 + 3], p[8 * s2 + 4], p[8 * s2 + 5], p[8 * s2 + 6], p[8 * s2 + 7]);
        __builtin_amdgcn_sched_barrier(0);
#pragma unroll
        for (int dt = 0; dt < 4; ++dt) o[dt] = MFMA32(fv[idx & 1][dt], pf, o[dt]);
        __builtin_amdgcn_sched_barrier(0);
    }
}
DI void softmax_step(f32x16& x0, f32x16& x1, float& m, float& l, f32x16 (&o)[4], bool rowok, float CS) {
    float mx = fmaxf(x0[0], x1[0]);
#pragma unroll
    for (int i = 1; i < 16; ++i) mx = fmaxf(mx, fmaxf(x0[i], x1[i]));
    mx = rowok ? mx : -INFINITY;
    mx = fmaxf(mx, __shfl_xor(mx, 32));
    const float mnew = fmaxf(m, mx);
    const bool need = (mnew - m) > 62.0f;
    if (__any(need)) {
        const float m2 = need ? mnew : m; const float alpha = __builtin_amdgcn_exp2f((m - m2) * CS); m = m2; l *= alpha;
#pragma unroll
        for (int dt = 0; dt < 4; ++dt) o[dt] = o[dt] * alpha;
    }
    const float negmc = rowok ? -m * CS : -INFINITY;
    float ps0 = 0.f, ps1 = 0.f;
#pragma unroll
    for (int i = 0; i < 16; ++i) { x0[i] = __builtin_amdgcn_exp2f(__builtin_fmaf(x0[i], CS, negmc)); x1[i] = __builtin_amdgcn_exp2f(__builtin_fmaf(x1[i], CS, negmc)); ps0 += x0[i]; ps1 += x1[i]; }
    l += ps0 + ps1;
}

DI void nsa_item(Frame& F, int item) {
    const bf16* Z = (const bf16*)(F.ws + WS_Z);
    const bf16* KC = (const bf16*)(F.ws + WS_KC); const bf16* VCT = (const bf16*)(F.ws + WS_VCT); const bf16* VTS = (const bf16*)(F.ws + WS_VTS); const bf16* VTW = (const bf16*)(F.ws + WS_VTW);
    bf16* ON = (bf16*)(F.ws + WS_ON);
    const int qt = item & 31, hk = (item >> 5) & 3, b = item >> 7;
    int tid = F.tid; asm volatile("" : "+v"(tid));
    const int w = F.wave, lane = tid & 63, r = lane & 31, hh = lane >> 5, g = w >> 1, th = w & 1;
    const int head = hk * 4 + g, tl = 32 * th + r  , t = 64 * qt + tl;
    const size_t trow = (size_t)b * SEQ + t;
    LAS unsigned char* buf0 = F.lds; LAS unsigned char* buf1 = F.lds + KV_BUF;
    LAS float* part = (LAS float*)(F.lds + NSA_X);
    LAS unsigned* oacc = (LAS unsigned*)(F.lds + NSA_X);
    LAS float* impr = (LAS float*)(F.lds + NSA_IMPR);
    LAS unsigned* msk = (LAS unsigned*)(F.lds + NSA_MSK);
    constexpr float CS = 0.08838834764831845f * 1.4426950408889634f;
    int kboff = pi_key(r) * KB_PITCH + 16 * hh, vboff = KB_BYTES + r * VB_PITCH + 16 * hh;
    LAS unsigned* oacc_l = oacc + w * 2048 + lane;
    asm volatile("" : "+v"(kboff), "+v"(vboff), "+v"(oacc_l));
    const int nsel = qt + 1, wlo = qt > 8 ? qt - 8 : 0, ntile = nsel + (qt - wlo + 1);
    const bf16* ksel = Z + (size_t)b * SEQ * ZW + ZNKV + 2 * 512 + hk * 128; const bf16* kwin = ksel + 2 * 512;
    const bf16* vsel = VTS + ((size_t)b * 4 + hk) * 128 * SEQ; const bf16* vwin = VTW + ((size_t)b * 4 + hk) * 128 * SEQ;
    TileRegs R;
    {
        const bf16* kc = KC + ((size_t)b * 4 + hk) * 128 * 128; const bf16* vc = VCT + ((size_t)b * 4 + hk) * 128 * 128;
        TileRegs R1; tile_gload(R, kc, 128, vc, 128, tid); tile_gload(R1, kc + 64 * 128, 128, vc + 64, 128, tid);
        for (int e = tid; e < 17408; e += 512) part[e] = 0.f;
        if (tid < 64) msk[tid] = 0u;
        tile_sstore(R, buf0, tid); tile_sstore(R1, buf1, tid);
    }
    bf16x8 qf[8];
    { const bf16* qp = Z + trow * ZW + ZNQ + head * 128 + 8 * hh;
#pragma unroll
      for (int s = 0; s < 8; ++s) qf[s] = *(const bf16x8*)(qp + 16 * s); }
    const float gate_c = sigm(bf2f(Z[trow * ZW + ZNG + head])), gate_s = sigm(bf2f(Z[trow * ZW + ZNG + 16 + head])), gate_w = sigm(bf2f(Z[trow * ZW + ZNG + 32 + head]));
    tile_gload(R, ksel, ZW, vsel, SEQ, tid);
    f32x16 o[4];
#pragma unroll
    for (int dt = 0; dt < 4; ++dt)
#pragma unroll
        for (int i = 0; i < 16; ++i) o[dt][i] = 0.f;
    BAR_LDS();
    {
        const int cmax = (t - 31) >> 4;
        float mx = -1e30f, ps = 0.f;
#pragma unroll 1
        for (int T = 0; T < 2; ++T) { f32x16 x0, x1; qk_lds(x0, x1, (T ? buf1 : buf0) + kboff, qf); float mm = -1e30f;
#pragma unroll
            for (int i = 0; i < 16; ++i) { const int cb = 64 * T + 16 * (i >> 3) + 8 * hh + (i & 7);
                x0[i] = (cb <= cmax) ? x0[i] * CS : -INFINITY; x1[i] = (cb + 32 <= cmax) ? x1[i] * CS : -INFINITY; mm = fmaxf(mm, fmaxf(x0[i], x1[i])); }
            mm = fmaxf(mm, __shfl_xor(mm, 32));
            const float mnew = fmaxf(mx, mm); float s = 0.f;
#pragma unroll
            for (int i = 0; i < 16; ++i) s += exp2f(x0[i] - mnew) + exp2f(x1[i] - mnew);
            ps = ps * exp2f(mx - mnew) + s; mx = mnew; }
        ps += __shfl_xor(ps, 32);
        const float inv = ps > 0.f ? 1.0f / ps : 0.f;
        LAS float* prow = part + ((size_t)(g * 64 + tl) * 34) * 2;
        asm volatile("" : "+v"(prow));
#pragma unroll 1
        for (int T = 0; T < 2; ++T) { f32x16 x0, x1; qk_lds(x0, x1, (T ? buf1 : buf0) + kboff, qf);
#pragma unroll
            for (int i = 0; i < 16; ++i) { const int cb = 64 * T + 16 * (i >> 3) + 8 * hh + (i & 7);
                const float s0 = (cb <= cmax) ? x0[i] * CS : -INFINITY, s1 = (cb + 32 <= cmax) ? x1[i] * CS : -INFINITY; x0[i] = exp2f(s0 - mx) * inv; x1[i] = exp2f(s1 - mx) * inv; }
#pragma unroll
            for (int mt = 0; mt < 2; ++mt)
#pragma unroll
                for (int s2 = 0; s2 < 2; ++s2) { const f32x16& p = mt ? x1 : x0;
                    const int n0 = 16 * T + 8 * mt + 4 * s2 + 2 * hh;
                    const float A = (p[8 * s2] + p[8 * s2 + 1]) + (p[8 * s2 + 2] + 0.5f * p[8 * s2 + 3]);
                    const float Bv = (0.5f * p[8 * s2 + 3] + p[8 * s2 + 4]) + (p[8 * s2 + 5] + p[8 * s2 + 6]) + 0.5f * p[8 * s2 + 7];
                    const float Cv = 0.5f * p[8 * s2 + 7];
                    prow[(n0) * 2] = A; prow[(n0 + 1) * 2] = Bv; prow[(n0 + 2) * 2 + 1] = Cv; }
            { bf16x8 fv[2][4]; pv_prefetch(fv, (T ? buf1 : buf0) + vboff); pv_lds(o, x0, x1, (T ? buf1 : buf0) + vboff, fv); } }
#pragma unroll
        for (int dt = 0; dt < 4; ++dt) o[dt] = o[dt] * gate_c;
    }
    BAR_LDS();
    tile_sstore(R, buf0, tid);
#pragma unroll
    for (int k4 = 0; k4 < 4; ++k4) { const int e = tid + 512 * k4, tok = e >> 5, n = e & 31; float s = 0.f;
#pragma unroll
        for (int gg = 0; gg < 4; ++gg) { const LAS float* pp = part + ((size_t)(gg * 64 + tok) * 34 + n) * 2; s += pp[0] + pp[1]; }
        impr[tok * 33 + n] = s; }
    BAR_LDS();
    if (qt < 16) { if (tid < 64) msk[tid] = (2u << qt) - 1u; }
    else {
#pragma unroll
        for (int k4 = 0; k4 < 4; ++k4) { const int e = tid + 512 * k4, tok = e >> 5, n = e & 31;
            if (n == 0) __hip_atomic_fetch_or(&msk[tok], 1u | (1u << qt) | (1u << (qt - 1)), __ATOMIC_RELAXED, __HIP_MEMORY_SCOPE_WORKGROUP);
            else if (n <= qt - 2) { const float v = impr[tok * 33 + n]; int rank = 0;
                for (int m2 = 1; m2 <= qt - 2; ++m2) { const float u = impr[tok * 33 + m2]; rank += (u > v || (u == v && m2 < n)) ? 1 : 0; }
                if (rank < 13) __hip_atomic_fetch_or(&msk[tok], 1u << n, __ATOMIC_RELAXED, __HIP_MEMORY_SCOPE_WORKGROUP); } }
    }
    BAR_LDS();
    const unsigned mymask = msk[tl];
#pragma unroll
    for (int dt = 0; dt < 4; ++dt)
#pragma unroll
        for (int i = 0; i < 16; i += 2) oacc_l[(dt * 8 + (i >> 1)) * 64] = pk2(o[dt][i], o[dt][i + 1]);
#pragma unroll
    for (int dt = 0; dt < 4; ++dt)
#pragma unroll
        for (int i = 0; i < 16; ++i) o[dt][i] = 0.f;
    float m = -1e30f, l = 0.f;
    for (int i = 0; i < ntile; ++i) {
        if (i + 1 < ntile) { const int i1 = i + 1; const bool br = i1 >= nsel; const int n1 = br ? wlo + (i1 - nsel) : i1;
            tile_gload(R, (br ? kwin : ksel) + (size_t)(64 * n1) * ZW, ZW, (br ? vwin : vsel) + 64 * n1, SEQ, tid); }
        if (i == nsel) {
            l += __shfl_xor(l, 32);
            const float f = l > 0.f ? gate_s / l : 0.f;
#pragma unroll
            for (int dt = 0; dt < 4; ++dt)
#pragma unroll
                for (int i2 = 0; i2 < 16; i2 += 2) { LAS unsigned* ap = oacc_l + (dt * 8 + (i2 >> 1)) * 64; const unsigned pw = *ap;
                    *ap = pk2(blo(pw) + f * o[dt][i2], bhi(pw) + f * o[dt][i2 + 1]); o[dt][i2] = 0.f; o[dt][i2 + 1] = 0.f; }
            m = -1e30f; l = 0.f;
        }
        const bool win = i >= nsel; const int n = win ? wlo + (i - nsel) : i;
        LAS unsigned char* bufc = (i & 1) ? buf1 : buf0;
        f32x16 x0, x1; qk_lds(x0, x1, bufc + kboff, qf);
        const bool rowok = win ? true : (((mymask >> n) & 1u) != 0u);
        if (n == qt || (win && n == qt - 8)) {
            const int lim = t - 64 * n, lo_lim = win ? lim - 512 : -100000;
#pragma unroll
            for (int i2 = 0; i2 < 16; ++i2) { const int kk = 16 * (i2 >> 3) + 8 * hh + (i2 & 7);
                x0[i2] = (kk <= lim && kk > lo_lim) ? x0[i2] : -INFINITY; x1[i2] = (kk + 32 <= lim && kk + 32 > lo_lim) ? x1[i2] : -INFINITY; }
        }
        bf16x8 fv[2][4]; pv_prefetch(fv, bufc + vboff);
        softmax_step(x0, x1, m, l, o, rowok, CS);
        pv_lds(o, x0, x1, bufc + vboff, fv);
        if (i + 1 < ntile) tile_sstore(R, (i & 1) ? buf0 : buf1, tid);
        BAR_LDS();
    }
    {
        l += __shfl_xor(l, 32);
        const float f = l > 0.f ? gate_w / l : 0.f;
        bf16* op = ON + trow * 2048 + head * 128 + 4 * hh;
#pragma unroll
        for (int dt = 0; dt < 4; ++dt)
#pragma unroll
            for (int a4 = 0; a4 < 4; ++a4) { const unsigned p0 = oacc_l[(dt * 8 + 2 * a4) * 64], p1 = oacc_l[(dt * 8 + 2 * a4 + 1) * 64];
                v2u wv; wv.x = pk2(blo(p0) + f * o[dt][4 * a4], bhi(p0) + f * o[dt][4 * a4 + 1]); wv.y = pk2(blo(p1) + f * o[dt][4 * a4 + 2], bhi(p1) + f * o[dt][4 * a4 + 3]);
                *(v2u*)(op + 32 * dt + 8 * a4) = wv; }
    }
    BAR_LDS();
}
DI int queue_next(Frame& F, unsigned* ctr) {
    LAS int* slot = (LAS int*)(F.lds + LDS_BYTES - 128);
    if (F.tid == 0) *slot = (int)atomicAdd(ctr, 1u);
    BAR_LDS(); const int v = *slot; BAR_LDS();
    return v;
}
DI void p3_scan_nsa(Frame& F, int rep) {
    for (int it = F.bid; it < 128; it += F.G) g2_item<2>(F, it);
    unsigned* ctr = (unsigned*)(F.ws + WS_CTL + 8192) + 64 * rep;
#pragma unroll 1
    for (;;) { const int it = queue_next(F, ctr); if (it >= 512) break; nsa_item(F, (it & 15) * 32 + (31 - (it >> 4))); }
}
DI void p4_gla_out(Frame& F) {
    const int gw = F.bid * 8 + F.wave, NGW = F.G * 8;
    for (int rh = gw; rh < MTOK * 4; rh += NGW) gla_out_row(F, rh);
}

#define XB_TMO      128
#define XB_XCNT(j)  (256  + 64 * (j))
#define XB_XSUB(j)  (1280 + 64 * (j))
#define XB_XGEN(j)  (2304 + 64 * (j))
#define XB_TOP      3328
#define XB_TOPGEN   3392
#define XCD_BAR_WORDS 3456
#define XB_SPIN_CAP (1u << 18)

__device__ __forceinline__ unsigned xb_ld(unsigned* p)              { return __hip_atomic_load(p, __ATOMIC_RELAXED, __HIP_MEMORY_SCOPE_AGENT); }
__device__ __forceinline__ unsigned xb_add(unsigned* p, unsigned v) { return __hip_atomic_fetch_add(p, v, __ATOMIC_RELAXED, __HIP_MEMORY_SCOPE_AGENT); }
__device__ __forceinline__ unsigned xb_xcc_id() { return (unsigned)__builtin_amdgcn_s_getreg((3 << 11) | 20) & 0xFu; }
#define XB_SPIN(cond, bar) do { unsigned _sp = 0; while (cond) { __builtin_amdgcn_s_sleep(1); \
    if ((++_sp & 255u) == 0u) { if (xb_ld(&(bar)[XB_TMO])) break; if (_sp > XB_SPIN_CAP) { atomicAdd(&(bar)[XB_TMO], 1u); break; } } } } while (0)
struct XcdBarrier {
    unsigned* bar; unsigned x;
    volatile LAS unsigned* st;
};

__device__ __forceinline__ XcdBarrier xcd_barrier_post(unsigned* bar, volatile LAS unsigned* st) {
    XcdBarrier b; b.bar = bar; b.x = xb_xcc_id(); b.st = st;
    if (threadIdx.x == 0) (void)xb_add(&bar[XB_XCNT(b.x)], 1u);
    return b;
}
__device__ __forceinline__ void xcd_barrier_complete(unsigned* bar, unsigned x, unsigned& nloc, unsigned& nx) {
    const unsigned G = gridDim.x * gridDim.y * gridDim.z;
    unsigned sum, cnt, mine, sp = 0u;
    for (;;) {
        sum = 0u; cnt = 0u; mine = 0u;
#pragma unroll
        for (unsigned j = 0; j < 16; ++j) { const unsigned c = xb_ld(&bar[XB_XCNT(j)]); sum += c; cnt += (c > 0u) ? 1u : 0u; mine = (j == x) ? c : mine; }
        if (sum == G) break;
        __builtin_amdgcn_s_sleep(1);
        if ((++sp & 255u) == 0u) { if (xb_ld(&bar[XB_TMO])) break; if (sp > XB_SPIN_CAP) { atomicAdd(&bar[XB_TMO], 1u); break; } }
    }
    nloc = mine > 0u ? mine : 1u; nx = cnt > 0u ? cnt : 1u;
}

__device__ __forceinline__ void xcd_barrier(const XcdBarrier& b) {
    asm volatile("s_waitcnt vmcnt(0)" ::: "memory");
    __syncthreads();
    if (threadIdx.x == 0) {
        unsigned* bar = b.bar;
        __builtin_amdgcn_s_waitcnt(0);
        unsigned nloc = b.st[0], nx = b.st[1];
        if (nloc == 0u) { xcd_barrier_complete(bar, b.x, nloc, nx); b.st[0] = nloc; b.st[1] = nx; }
        const unsigned old = xb_add(&bar[XB_XSUB(b.x)], 1u);
        const unsigned gen = old / nloc;
        if (old + 1u == (gen + 1u) * nloc) {
            __builtin_amdgcn_fence(__ATOMIC_RELEASE, "agent");
            asm volatile("s_waitcnt vmcnt(0)" ::: "memory");
            const unsigned og = xb_add(&bar[XB_TOP], 1u);
            const unsigned tg = og / nx;
            if (og + 1u == (tg + 1u) * nx) xb_add(&bar[XB_TOPGEN], 1u);
            else XB_SPIN(xb_ld(&bar[XB_TOPGEN]) == tg, bar);
            __builtin_amdgcn_fence(__ATOMIC_ACQUIRE, "agent");
            xb_add(&bar[XB_XGEN(b.x)], 1u);
            asm volatile("s_waitcnt vmcnt(0)" ::: "memory");
        } else {
            XB_SPIN(xb_ld(&bar[XB_XGEN(b.x)]) == gen, bar);
            __builtin_amdgcn_fence(__ATOMIC_ACQUIRE, "agent");
            asm volatile("s_waitcnt vmcnt(0)" ::: "memory");
        }
    }
    __syncthreads();
}

#ifndef MK_N_LAUNCHES
#define MK_N_LAUNCHES 1
#endif
constexpr int N_PHASES = 11;
__global__ void __launch_bounds__(512, 2) hybrid_fwd(Args args) {
    extern __shared__ __attribute__((aligned(16))) unsigned char lds_raw[];
    Frame F;
    F.lds = (LAS unsigned char*)lds_raw;
    F.tid = threadIdx.x; F.lane = F.tid & 63; F.wave = __builtin_amdgcn_readfirstlane(F.tid >> 6); F.G = gridDim.x; F.bid = blockIdx.x;
    F.x = args.in[0]; F.g_mix = args.in[1]; F.w_in = args.in[2]; F.w_gla_gate = args.in[3]; F.b_gla_gate = args.in[4]; F.g_gla_out = args.in[5];
    F.pe_k = args.in[6]; F.w_ck1 = args.in[7]; F.w_ck2 = args.in[8]; F.pe_v = args.in[9]; F.w_cv1 = args.in[10]; F.w_cv2 = args.in[11];
    F.w_pg = args.in[12]; F.w_pn = args.in[13]; F.w_out = args.in[14]; F.g_ffn = args.in[15]; F.w_fg = args.in[16]; F.w_fu = args.in[17]; F.w_fd = args.in[18]; F.g_final = args.in[19];
    F.out = args.out; F.ws = args.ws;
    const int lo = args.ph_lo, hi = args.ph_hi;
    volatile LAS unsigned* bst = (volatile LAS unsigned*)(F.lds + LDS_BYTES - 64);
    if (F.tid < 16) bst[F.tid] = 0u;
    __syncthreads();
    XcdBarrier xbar = xcd_barrier_post((unsigned*)(F.ws + WS_CTL + 65536), bst);
    if (lo < 0) cg::this_grid().sync();
    typedef pg8::bf16_t pb;
#ifndef PH_MASK
#define PH_MASK 0x7ff
#endif
#define IN(k) (((PH_MASK >> (k)) & 1) && lo <= (k) && (k) < hi)
#ifndef REPEAT_MASK
#define REPEAT_MASK 0
#endif
#define NREP(k) (1 + ((REPEAT_MASK >> (k)) & 1))
#define SEAM(k) do { if (IN(k) && IN((k) + 1)) xcd_barrier(xbar); } while (0)
    if (IN(0)) { for (int rep = 0; rep < NREP(0); ++rep) p0_prologue(F, rep == 0); } SEAM(0);
    if (IN(1)) for (int rep = 0; rep < NREP(1); ++rep) {
        pg8::Gemm g{(const pb*)(F.ws + WS_BUFA), (const pb*)(F.ws + WS_WINT), MTOK, ZW, DM}; pg8::StaticOrder S; S.init(MTOK, ZW, F.G, F.bid);
        pg8::EpiBf16Plain E{(pb*)(F.ws + WS_Z), ZW};
        pg8::gemm_phase<pg8::EpiBf16Plain, pg8::StaticOrder, true, true>(F.lds, g, S, E);
    } SEAM(1);
    if (IN(2)) { for (int rep = 0; rep < NREP(2); ++rep) p2_prep(F); } SEAM(2);
    if (IN(3)) { for (int rep = 0; rep < NREP(3); ++rep) p3_scan_nsa(F, rep); } SEAM(3);
    if (IN(4)) { p4_gla_out(F); } SEAM(4);
    if (IN(5)) {
        { pg8::Gemm g{(const pb*)(F.ws + WS_BUFB), (const pb*)(F.ws + WS_WPG), MTOK, DM, DM}; pg8::StaticOrder S; S.init(MTOK, DM, F.G, F.bid);
          pg8::EpiGate<false> E{(pb*)(F.ws + WS_MERGED), (const pb*)(F.ws + WS_Z) + ZMG, DM, ZW};
          pg8::gemm_phase<pg8::EpiGate<false>, pg8::StaticOrder, true, true>(F.lds, g, S, E); }
        { pg8::Gemm g{(const pb*)(F.ws + WS_ON), (const pb*)(F.ws + WS_WPN), MTOK, DM, DM}; pg8::StaticOrder S; S.init(MTOK, DM, F.G, F.bid);
          pg8::EpiGate<true> E{(pb*)(F.ws + WS_MERGED), (const pb*)(F.ws + WS_Z) + ZMG + 2048, DM, ZW};
          pg8::gemm_phase<pg8::EpiGate<true>, pg8::StaticOrder, true, true>(F.lds, g, S, E); }
    } SEAM(5);
    if (IN(6)) {
        pg8::Gemm g{(const pb*)(F.ws + WS_MERGED), (const pb*)(F.ws + WS_WOUT), MTOK, DM, DM}; pg8::StaticOrder S; S.init(MTOK, DM, F.G, F.bid);
        pg8::EpiResF32 E{F.x, F.out, DM};
        pg8::gemm_phase<pg8::EpiResF32, pg8::StaticOrder, true, true>(F.lds, g, S, E);
    } SEAM(6);
    if (IN(7)) { for (int rep = 0; rep < NREP(7); ++rep) p7_norm_ffnw(F); } SEAM(7);
    if (IN(8)) for (int rep = 0; rep < NREP(8); ++rep) {
        pg8::Gemm g{(const pb*)(F.ws + WS_BUFB), (const pb*)(F.ws + WS_WGU), MTOK, 2 * DFF, DM}; pg8::StaticOrder S; S.init(MTOK, 2 * DFF, F.G, F.bid);
        pg8::EpiSwiGLU E{(pb*)(F.ws + WS_ACT), DFF};
        pg8::gemm_phase<pg8::EpiSwiGLU, pg8::StaticOrder, true, true>(F.lds, g, S, E);
    } SEAM(8);
    if (IN(9)) {
        pg8::Gemm g{(const pb*)(F.ws + WS_ACT), (const pb*)(F.ws + WS_WD), MTOK, DM, DFF}; pg8::StaticOrder S; S.init(MTOK, DM, F.G, F.bid);
        pg8::EpiResF32 E{F.out, F.out, DM};
        pg8::gemm_phase<pg8::EpiResF32, pg8::StaticOrder, true, true>(F.lds, g, S, E);
    } SEAM(9);
    if (IN(10)) { p10_final(F); }
#undef IN
#undef SEAM
}

extern "C" void kernel_launch(void* const* d_in, const int* in_sizes, int n_in, void* d_out, int out_size, void* d_ws, size_t ws_size, hipStream_t stream) {
    static int grid = 0;
    if (grid == 0) {
        if (n_in != 20 || in_sizes[0] != MTOK * DM || out_size != MTOK * DM || ws_size < WS_END) {
            fprintf(stderr, "kernel_launch: unexpected shapes (n_in %d, in0 %d, out %d, ws %zu < %zu); nothing launched\n", n_in, n_in > 0 ? in_sizes[0] : -1, out_size, ws_size, (size_t)WS_END); grid = -1; return; }
        int dev = 0, cus = 0, per_cu = 0;
        if (hipGetDevice(&dev) != hipSuccess || hipDeviceGetAttribute(&cus, hipDeviceAttributeMultiprocessorCount, dev) != hipSuccess) { grid = -1; return; }
        if (hipFuncSetAttribute((const void*)hybrid_fwd, hipFuncAttributeMaxDynamicSharedMemorySize, LDS_BYTES) != hipSuccess) { fprintf(stderr, "kernel_launch: hipFuncSetAttribute failed\n"); grid = -1; return; }
        if (hipOccupancyMaxActiveBlocksPerMultiprocessor(&per_cu, (const void*)hybrid_fwd, 512, LDS_BYTES) != hipSuccess || per_cu < 1) { fprintf(stderr, "kernel_launch: occupancy query says %d blocks per CU\n", per_cu); per_cu = 1; }
        (void)hipGetLastError();
        grid = cus * (per_cu > 1 ? 1 : per_cu);
    }
    if (grid < 0) return;
    (void)hipMemsetAsync((char*)d_ws + WS_CTL, 0, CTL_ZERO_BYTES, stream);
    Args a{};
    for (int i = 0; i < 20; ++i) a.in[i] = (const float*)d_in[i];
    a.out = (float*)d_out; a.ws = (unsigned char*)d_ws;
#if MK_N_LAUNCHES == 1
    a.ph_lo = 0; a.ph_hi = N_PHASES;
    void* kargs[] = {&a};
    hipError_t e = hipLaunchCooperativeKernel((const void*)hybrid_fwd, dim3(grid), dim3(512), kargs, LDS_BYTES, stream);
    if (e != hipSuccess) fprintf(stderr, "kernel_launch: cooperative launch failed: %s (grid %d)\n", hipGetErrorString(e), grid);
#else
    for (int p = 0; p < N_PHASES; ++p) { a.ph_lo = p; a.ph_hi = p + 1; hipLaunchKernelGGL(hybrid_fwd, dim3(grid), dim3(512), LDS_BYTES, stream, a); }
#endif
}
```
